# Optimizing an MI355X kernel written in HIP

```python
import jax, jax.numpy as jnp
from jax import lax
import numpy as np


D_MODEL = 1024
BATCH = 2
SEQ = 16384
DEPTH = 4

N_A_LAYERS = DEPTH // 2
N_B_LAYERS = DEPTH - N_A_LAYERS
HGRN_EXPAND = 128
HGRN_HEADS = D_MODEL // HGRN_EXPAND
HGRN_DK = HGRN_EXPAND
HGRN_DV = D_MODEL // HGRN_HEADS
HGRN_D_KEY = HGRN_HEADS * HGRN_DK
HGRN_D_VAL = HGRN_HEADS * HGRN_DV
HGRN_CHUNK = 64
NSA_HEADS = 16
NSA_KV_HEADS = 4
NSA_GROUP = NSA_HEADS // NSA_KV_HEADS
NSA_HEAD_DIM = D_MODEL // NSA_HEADS
NSA_Q_WIDTH = NSA_HEADS * NSA_HEAD_DIM
N_BRANCH = 3
CMP_BLOCK = 32
CMP_STRIDE = 16
CMP_HIDDEN = 256
SEL_BLOCK = 64
N_SELECT = 16
WINDOW = 512
Q_BLOCK = 128
ROPE_THETA = 10000.0
FFN_HIDDEN = -(-8 * D_MODEL // (3 * 256)) * 256
EPS = 1e-6
NEG_INF = -1e30
FORCE_SCORE = 1e9

kernel_name = 'yoco_hgrn2_nsa_hybrid'


def rms_norm(x, gain):
    x32 = x.astype(jnp.float32)
    y = x32 * lax.rsqrt(jnp.mean(x32 * x32, axis=-1, keepdims=True) + EPS)
    return (y * gain.astype(jnp.float32)).astype(x.dtype)


def modulate(x, gain, shift, scale):
    return rms_norm(x, gain) * (1 + scale[:, None, :]) + shift[:, None, :]


def rope_tables(seq, dim):
    inv_freq = 1.0 / (ROPE_THETA ** (jnp.arange(0, dim, 2, dtype=jnp.float32) / dim))
    ang = jnp.arange(seq, dtype=jnp.float32)[:, None] * inv_freq[None, :]
    return jnp.cos(ang), jnp.sin(ang)


def apply_rope(x, cos, sin):
    x1, x2 = jnp.split(x, 2, axis=-1)
    cs = cos[None, :, None, :].astype(x.dtype)
    sn = sin[None, :, None, :].astype(x.dtype)
    return jnp.concatenate([x1 * cs - x2 * sn, x2 * cs + x1 * sn], axis=-1)


def masked_softmax(s, mask):
    p = jax.nn.softmax(jnp.where(mask, s.astype(jnp.float32), NEG_INF), axis=-1)
    return jnp.where(mask, p, 0.0)


def swiglu(h, w_in, w_out):
    a, b = jnp.split(h @ w_in, 2, axis=-1)
    return (jax.nn.silu(a) * b) @ w_out


def hgrn2_mixer(h, w_in, lower_bound, out_norm, w_out, first_layer):
    B, S, _ = h.shape
    q, f, i, g = jnp.split(h @ w_in, [HGRN_D_KEY, 2 * HGRN_D_KEY, 2 * HGRN_D_KEY + HGRN_D_VAL], axis=-1)
    q = jax.nn.silu(q)
    f32 = f.astype(jnp.float32)
    if first_layer:
        log_f = jax.nn.log_sigmoid(f32)
    else:
        lb = lower_bound.astype(jnp.float32)
        log_f = jnp.log(lb + (1.0 - lb) * jax.nn.sigmoid(f32))
    k = -jnp.expm1(log_f)
    nc = S // HGRN_CHUNK

    def to_chunks(t, d):
        return t.astype(jnp.float32).reshape(B, nc, HGRN_CHUNK, HGRN_HEADS, d).transpose(1, 0, 3, 2, 4)

    qc, kc, gc = to_chunks(q, HGRN_DK), to_chunks(k, HGRN_DK), to_chunks(log_f, HGRN_DK)
    vc = to_chunks(i, HGRN_DV)
    causal = jnp.tril(jnp.ones((HGRN_CHUNK, HGRN_CHUNK), dtype=bool))[:, :, None]

    def step(state, inp):
        q_, k_, v_, g_ = inp
        G = jnp.cumsum(g_, axis=2)
        o_inter = jnp.einsum('bhtk,bhkv->bhtv', q_ * jnp.exp(G), state)
        diff = G[:, :, :, None, :] - G[:, :, None, :, :]
        decay = jnp.where(causal, jnp.exp(jnp.where(causal, diff, 0.0)), 0.0)
        attn = jnp.einsum('bhtk,bhsk,bhtsk->bhts', q_, k_, decay)
        o_intra = jnp.einsum('bhts,bhsv->bhtv', attn, v_)
        G_last = G[:, :, -1:, :]
        new_state = jnp.exp(G_last[:, :, 0, :])[..., None] * state + jnp.einsum(
            'bhsk,bhsv->bhkv', k_ * jnp.exp(G_last - G), v_)
        return new_state, o_inter + o_intra

    s0 = jnp.zeros((B, HGRN_HEADS, HGRN_DK, HGRN_DV), jnp.float32)
    _, o = lax.scan(step, s0, (qc, kc, vc, gc))
    o = o.transpose(1, 0, 3, 2, 4).reshape(B, S, HGRN_HEADS, HGRN_DV)
    o = rms_norm(o, out_norm) * jax.nn.silu(g.reshape(B, S, HGRN_HEADS, HGRN_DV).astype(jnp.float32))
    return o.reshape(B, S, HGRN_D_VAL).astype(h.dtype) @ w_out


def nsa_shared_kv(h, w_kv, k_norm, cmp_pos, cmp_w1, cmp_w2, cos, sin):
    B, S, _ = h.shape
    kv = (h @ w_kv).reshape(B, S, 2 * N_BRANCH, NSA_KV_HEADS, NSA_HEAD_DIM)
    k_cmp, v_cmp, k_sel, v_sel, k_win, v_win = [kv[:, :, j] for j in range(2 * N_BRANCH)]
    n_sub = CMP_BLOCK // CMP_STRIDE
    n_cmp = S // CMP_STRIDE - n_sub + 1

    def compress(t, pos, w1, w2):
        r = t.reshape(B, S // CMP_STRIDE, CMP_STRIDE, NSA_KV_HEADS, NSA_HEAD_DIM)
        blocks = jnp.concatenate([r[:, j:j + n_cmp] for j in range(n_sub)], axis=2)
        blocks = blocks + pos[None, None, :, None, :]
        flat = blocks.transpose(0, 1, 3, 2, 4).reshape(B, n_cmp, NSA_KV_HEADS, CMP_BLOCK * NSA_HEAD_DIM)
        return jax.nn.silu(flat @ w1) @ w2

    kc = rms_norm(compress(k_cmp, cmp_pos[0], cmp_w1[0], cmp_w2[0]), k_norm[0])
    vc = compress(v_cmp, cmp_pos[1], cmp_w1[1], cmp_w2[1])
    n_sel = S // SEL_BLOCK
    ks = apply_rope(rms_norm(k_sel, k_norm[1]), cos, sin)
    ks_blocks = ks.reshape(B, n_sel, SEL_BLOCK, NSA_KV_HEADS, NSA_HEAD_DIM).transpose(0, 3, 1, 2, 4)
    vs_blocks = v_sel.reshape(B, n_sel, SEL_BLOCK, NSA_KV_HEADS, NSA_HEAD_DIM).transpose(0, 3, 1, 2, 4)
    kw = apply_rope(rms_norm(k_win, k_norm[2]), cos, sin)
    pad = ((0, 0), (WINDOW, 0), (0, 0), (0, 0))
    return (kc, vc, ks_blocks, vs_blocks, jnp.pad(kw, pad), jnp.pad(v_win, pad))


def nsa_mixer(h, w_q, q_norm, w_out, shared, cos, sin):
    B, S, _ = h.shape
    kc, vc, ks_blocks, vs_blocks, kw_pad, vw_pad = shared
    proj = h @ w_q
    q = rms_norm(proj[..., :NSA_Q_WIDTH].reshape(B, S, NSA_HEADS, NSA_HEAD_DIM), q_norm)
    gates = jax.nn.sigmoid(proj[..., NSA_Q_WIDTH:].astype(jnp.float32)).reshape(B, S, N_BRANCH, NSA_HEADS)
    q_rope = apply_rope(q, cos, sin)
    n_cmp = kc.shape[1]
    n_sel = ks_blocks.shape[2]
    n_top = min(N_SELECT, n_sel)
    cmp_end = jnp.arange(n_cmp) * CMP_STRIDE + CMP_BLOCK - 1
    sel_start = jnp.arange(n_sel) * SEL_BLOCK
    cs = np.arange(n_cmp) * CMP_STRIDE
    ss = np.arange(n_sel) * SEL_BLOCK
    overlap = jnp.asarray(((cs[:, None] < ss[None, :] + SEL_BLOCK) &
                           (cs[:, None] + CMP_BLOCK > ss[None, :])).astype(np.float32))
    scale = NSA_HEAD_DIM ** -0.5
    nb = S // Q_BLOCK
    bi = jnp.arange(B)[:, None, None, None]
    hi = jnp.arange(NSA_KV_HEADS)[None, :, None, None]
    blk_pos = jnp.arange(SEL_BLOCK)

    def blockify(t):
        return t.reshape(B, nb, Q_BLOCK, *t.shape[2:]).swapaxes(0, 1)

    def attend(args):
        blk, qp, qr, g = args
        t = blk * Q_BLOCK + jnp.arange(Q_BLOCK)
        qp = qp.reshape(B, Q_BLOCK, NSA_KV_HEADS, NSA_GROUP, NSA_HEAD_DIM)
        qr = qr.reshape(B, Q_BLOCK, NSA_KV_HEADS, NSA_GROUP, NSA_HEAD_DIM)
        s_c = jnp.einsum('bqhgd,bchd->bhgqc', qp, kc) * scale
        p_c = masked_softmax(s_c, cmp_end[None, :] <= t[:, None])
        o_c = jnp.einsum('bhgqc,bchd->bqhgd', p_c.astype(vc.dtype), vc)
        imp = jnp.einsum('bhgqc,cj->bhqj', p_c, overlap)
        cur = t // SEL_BLOCK
        j = jnp.arange(n_sel)[None, :]
        forced = (j == 0) | (j == cur[:, None]) | (j == cur[:, None] - 1)
        valid_blk = sel_start[None, :] <= t[:, None]
        imp = jnp.where(forced & valid_blk, FORCE_SCORE, jnp.where(valid_blk, imp, -1.0))
        top_val, top_idx = lax.top_k(imp, n_top)
        ks_g = ks_blocks[bi, hi, top_idx].reshape(B, NSA_KV_HEADS, Q_BLOCK, n_top * SEL_BLOCK, NSA_HEAD_DIM)
        vs_g = vs_blocks[bi, hi, top_idx].reshape(B, NSA_KV_HEADS, Q_BLOCK, n_top * SEL_BLOCK, NSA_HEAD_DIM)
        kpos = (top_idx[..., None] * SEL_BLOCK + blk_pos).reshape(B, NSA_KV_HEADS, Q_BLOCK, n_top * SEL_BLOCK)
        m_s = jnp.repeat(top_val >= 0, SEL_BLOCK, axis=-1) & (kpos <= t[None, None, :, None])
        s_s = jnp.einsum('bqhgd,bhqkd->bhgqk', qr, ks_g) * scale
        p_s = masked_softmax(s_s, m_s[:, :, None])
        o_s = jnp.einsum('bhgqk,bhqkd->bqhgd', p_s.astype(vs_g.dtype), vs_g)
        kw = lax.dynamic_slice_in_dim(kw_pad, blk * Q_BLOCK, Q_BLOCK + WINDOW, axis=1)
        vw = lax.dynamic_slice_in_dim(vw_pad, blk * Q_BLOCK, Q_BLOCK + WINDOW, axis=1)
        kpos_w = blk * Q_BLOCK - WINDOW + jnp.arange(Q_BLOCK + WINDOW)
        m_w = ((kpos_w[None, :] <= t[:, None]) & (kpos_w[None, :] > t[:, None] - WINDOW)
               & (kpos_w[None, :] >= 0))
        s_w = jnp.einsum('bqhgd,bkhd->bhgqk', qr, kw) * scale
        p_w = masked_softmax(s_w, m_w)
        o_w = jnp.einsum('bhgqk,bkhd->bqhgd', p_w.astype(vw.dtype), vw)
        g = g.reshape(B, Q_BLOCK, N_BRANCH, NSA_KV_HEADS, NSA_GROUP)[..., None]
        o = g[:, :, 0] * o_c + g[:, :, 1] * o_s + g[:, :, 2] * o_w
        return o.reshape(B, Q_BLOCK, NSA_Q_WIDTH).astype(h.dtype)

    out = lax.map(attend, (jnp.arange(nb), blockify(q), blockify(q_rope), blockify(gates)))
    return out.swapaxes(0, 1).reshape(B, S, NSA_Q_WIDTH) @ w_out


def setup_inputs(seed: int = 0) -> dict:
    key = jax.random.key(seed)
    ks = jax.random.split(key, 24)
    D = D_MODEL

    def nrm(k, shape, scale):
        return jax.random.normal(k, shape, jnp.float32) * scale

    def gain(k, shape):
        return 1.0 + nrm(k, shape, 0.02)

    return {
        'x': nrm(ks[0], (BATCH, SEQ, D), 1.0),
        'c': nrm(ks[1], (BATCH, D), 1.0),
        'ada_w': nrm(ks[2], (2 * DEPTH, D, 3 * D), 0.5 * D ** -0.5),
        'ada_b': nrm(ks[3], (2 * DEPTH, 3 * D), 0.02),
        'norm_mix': gain(ks[4], (DEPTH, D)),
        'norm_ffn': gain(ks[5], (DEPTH, D)),
        'hgrn_w_in': nrm(ks[6], (N_A_LAYERS, D, 2 * HGRN_D_KEY + 2 * HGRN_D_VAL), D ** -0.5),
        'hgrn_lower_bounds': nrm(ks[7], (N_A_LAYERS, HGRN_D_KEY), 0.5),
        'hgrn_out_norm': gain(ks[8], (N_A_LAYERS, HGRN_DV)),
        'hgrn_w_out': nrm(ks[9], (N_A_LAYERS, HGRN_D_VAL, D), HGRN_D_VAL ** -0.5),
        'kv_ada_w': nrm(ks[10], (D, 2 * D), 0.5 * D ** -0.5),
        'kv_ada_b': nrm(ks[11], (2 * D,), 0.02),
        'kv_norm': gain(ks[12], (D,)),
        'nsa_w_kv': nrm(ks[13], (D, 2 * N_BRANCH * NSA_KV_HEADS * NSA_HEAD_DIM), D ** -0.5),
        'nsa_k_norm': gain(ks[14], (N_BRANCH, NSA_HEAD_DIM)),
        'cmp_pos': nrm(ks[15], (2, CMP_BLOCK, NSA_HEAD_DIM), 0.1),
        'cmp_w1': nrm(ks[16], (2, CMP_BLOCK * NSA_HEAD_DIM, CMP_HIDDEN), (CMP_BLOCK * NSA_HEAD_DIM) ** -0.5),
        'cmp_w2': nrm(ks[17], (2, CMP_HIDDEN, NSA_HEAD_DIM), CMP_HIDDEN ** -0.5),
        'nsa_w_q': nrm(ks[18], (N_B_LAYERS, D, NSA_Q_WIDTH + N_BRANCH * NSA_HEADS), D ** -0.5),
        'nsa_q_norm': gain(ks[19], (N_B_LAYERS, NSA_HEAD_DIM)),
        'nsa_w_out': nrm(ks[20], (N_B_LAYERS, NSA_Q_WIDTH, D), NSA_Q_WIDTH ** -0.5),
        'ffn_w_in': nrm(ks[21], (DEPTH, D, 2 * FFN_HIDDEN), D ** -0.5),
        'ffn_w_out': nrm(ks[22], (DEPTH, FFN_HIDDEN, D), FFN_HIDDEN ** -0.5),
    }


def reference(x, c, ada_w, ada_b, norm_mix, norm_ffn, hgrn_w_in, hgrn_lower_bounds, hgrn_out_norm,
              hgrn_w_out, kv_ada_w, kv_ada_b, kv_norm, nsa_w_kv, nsa_k_norm, cmp_pos, cmp_w1, cmp_w2,
              nsa_w_q, nsa_q_norm, nsa_w_out, ffn_w_in, ffn_w_out):
    B, S, _ = x.shape
    cos, sin = rope_tables(S, NSA_HEAD_DIM)
    c_act = jax.nn.silu(c)
    mods = jnp.einsum('bd,lde->lbe', c_act, ada_w) + ada_b[:, None, :]
    lb = jax.nn.softmax(hgrn_lower_bounds.astype(jnp.float32), axis=0)
    lb = jnp.cumsum(lb, axis=0) - lb[0]
    shared = None
    for layer in range(DEPTH):
        shift, scale, gate = jnp.split(mods[2 * layer], 3, axis=-1)
        h = modulate(x, norm_mix[layer], shift, scale)
        if layer < N_A_LAYERS:
            y = hgrn2_mixer(h, hgrn_w_in[layer], lb[layer], hgrn_out_norm[layer], hgrn_w_out[layer], layer == 0)
        else:
            if layer == N_A_LAYERS:
                kv_shift, kv_scale = jnp.split(c_act @ kv_ada_w + kv_ada_b, 2, axis=-1)
                shared = nsa_shared_kv(modulate(x, kv_norm, kv_shift, kv_scale), nsa_w_kv, nsa_k_norm,
                                       cmp_pos, cmp_w1, cmp_w2, cos, sin)
            bl = layer - N_A_LAYERS
            y = nsa_mixer(h, nsa_w_q[bl], nsa_q_norm[bl], nsa_w_out[bl], shared, cos, sin)
        x = x + gate[:, None, :] * y
        shift, scale, gate = jnp.split(mods[2 * layer + 1], 3, axis=-1)
        h = modulate(x, norm_ffn[layer], shift, scale)
        x = x + gate[:, None, :] * swiglu(h, ffn_w_in[layer], ffn_w_out[layer])
    return x
```

```cpp
#include <hip/hip_runtime.h>
#include <hip/hip_cooperative_groups.h>
#include <cstdio>
#include <cstdint>
namespace cg = cooperative_groups;
__device__ __forceinline__ int opaque_tid(int wid) { int l; asm volatile("v_mbcnt_lo_u32_b32 %0, -1, 0\n\tv_mbcnt_hi_u32_b32 %0, -1, %0" : "=v"(l)); int w = wid; asm volatile("" : "+s"(w)); return (w << 6) | l; }
namespace pg8 {
#define PG8_LAS __attribute__((address_space(3)))
typedef unsigned short bf16_t;
typedef short bf16x8 __attribute__((ext_vector_type(8)));
typedef float f32x4 __attribute__((ext_vector_type(4)));
typedef unsigned u32x4 __attribute__((ext_vector_type(4)));
constexpr int BM = 256, BK = 64, HALF = 128, HTB = HALF * BK * 2  , STAGE_BYTES = 8 * HTB, NXCD = 8, WGM = 8;

__host__ __device__ __forceinline__ int lds_byte(int r, int c) { const int st = (r >> 4) * 2 + (c >> 5), rr = r & 15, cc = c & 31, ob = rr * 64 + cc * 2; return st * 1024 + (ob ^ (((ob >> 9) & 1) << 5)); }
__host__ __device__ __forceinline__ void stage_rc(int b, int& R, int& C) { const int st = b / 1024, sb = b % 1024, swz = sb ^ (((sb >> 9) & 1) << 5); R = (st >> 1) * 16 + swz / 64; C = (st & 1) * 32 + (swz % 64) / 2; }
__host__ __device__ __forceinline__ int perm32(int rho) { const int n = rho >> 4, i = rho & 15; return 8 * (i >> 2) + 4 * n + (i & 3); }

struct Unit { int pm, pn; };
struct Gemm { const bf16_t* A; const bf16_t* Bt; int M, N, K, lda; };

struct StaticOrder {
    int nM, nN, nwg, G, c;
    __host__ __device__ void init(int M, int N, int G_, int c_) { nM = M / BM; nN = N / BM; nwg = nM * nN; G = G_; c = c_; }
    __host__ __device__ bool next(int i, Unit& u) const {
        const long L = (long)i * G + c; if (c < 0 || L >= nwg) return false;
        int wgid = (int)L; { const int q = nwg / NXCD, r = nwg % NXCD, xcd = wgid % NXCD, off = wgid / NXCD; wgid = (xcd < r ? xcd * (q + 1) : r * (q + 1) + (xcd - r) * q) + off; }
        const int nig = WGM * nN, gid = wgid / nig, fm = gid * WGM, gsz = (nM - fm) < WGM ? (nM - fm) : WGM;
        u.pm = fm + ((wgid % nig) % gsz); u.pn = (wgid % nig) / gsz; return true;
    }
    __device__ __forceinline__ void a_ready(const Unit&) const {}
    __device__ __forceinline__ void done(const Unit&) const {}
};

typedef float f32x2c __attribute__((ext_vector_type(2))); typedef __bf16 bf16x2c __attribute__((ext_vector_type(2)));
__device__ __forceinline__ unsigned cvt_pk_bf16(float lo, float hi) { f32x2c v = {lo, hi}; bf16x2c b = __builtin_convertvector(v, bf16x2c); return __builtin_bit_cast(unsigned, b); }
typedef float f32x2 __attribute__((ext_vector_type(2)));
template <class Epi, class Sched, bool ALIGN_EPI = false, bool SP2 = false>
__device__ __forceinline__ void gemm_phase(PG8_LAS unsigned char* lds, const Gemm g, const Sched& S, const Epi& E, int wid_) {
    const int tid = opaque_tid(wid_), wid = __builtin_amdgcn_readfirstlane(tid >> 6), lane = tid & 63, wr = wid >> 2, wc = wid & 3, fr = lane & 15, fq = lane >> 4;
    const int K = g.K, nt = K / BK;
    unsigned voffA, voffB;
    { int R, C; stage_rc(tid * 16, R, C); const int Rb = Epi::PERM ? ((R & ~31) + perm32(R & 31)) : R;
      voffA = (unsigned)(R * g.lda + C) * 2u; voffB = (unsigned)(Rb * K + C) * 2u; }
    const size_t stepA = (size_t)64 * g.lda * 2, stepB = (size_t)64 * K * 2;
    const size_t kstep = (size_t)(BK * 2);
    const size_t hstepA = (size_t)HALF * g.lda * 2, hstepB = (size_t)HALF * K * 2;
    const size_t tstepA = 2 * hstepA, tstepB = 2 * hstepB;
    const unsigned ldsw = (unsigned)wid * 1024u;
    const int aoff = lds_byte(wr * 64 + fr, fq * 8), boff = lds_byte(wc * 32 + fr, fq * 8);
#define PG8_SA(b, h) (((b) * 2 + (h)) * HTB)
#define PG8_SB(b, h) ((4 + (b) * 2 + (h)) * HTB)
#define PG8_STAGE(bufoff, gbase, voff, rstep) do { _Pragma("unroll") for (int _i = 0; _i < 2; ++_i) \
        __builtin_amdgcn_global_load_lds((const unsigned*)((const char*)(gbase) + (size_t)_i * (rstep) + (voff)), (PG8_LAS unsigned*)(lds + (bufoff) + ldsw + _i * 8192), 16, 0, 0); } while (0)
#define PG8_LDA(dst, b, h) do { _Pragma("unroll") for (int m = 0; m < 4; ++m) _Pragma("unroll") for (int k = 0; k < 2; ++k) dst[m][k] = *(const PG8_LAS bf16x8*)(lds + PG8_SA(b, h) + aoff + m * 2048 + k * 1024); } while (0)
#define PG8_LDB(dst, b, h) do { _Pragma("unroll") for (int n = 0; n < 2; ++n) _Pragma("unroll") for (int k = 0; k < 2; ++k) dst[n][k] = *(const PG8_LAS bf16x8*)(lds + PG8_SB(b, h) + boff + n * 2048 + k * 1024); } while (0)
#define PG8_MMA(ai, bj, At, Bt) do { __builtin_amdgcn_s_setprio(1); _Pragma("unroll") for (int m = 0; m < 4; ++m) _Pragma("unroll") for (int n = 0; n < 2; ++n) _Pragma("unroll") for (int k = 0; k < 2; ++k) \
        acc[ai][bj][m][n] = __builtin_amdgcn_mfma_f32_16x16x32_bf16(Bt[n][k], At[m][k], acc[ai][bj][m][n], 0, 0, 0); __builtin_amdgcn_s_setprio(0); } while (0)
#define PG8_WAIT_V(n) asm volatile("s_waitcnt vmcnt(" #n ")" ::: "memory")
#define PG8_WAIT_L(n) asm volatile("s_waitcnt lgkmcnt(" #n ")" ::: "memory")
#define PG8_BAR __builtin_amdgcn_s_barrier()
#define PG8_SCHED __builtin_amdgcn_sched_barrier(0)
    Unit cur, nxt; int ui = 0;
    if (!S.next(0, cur)) return;
    f32x4 acc[2][2][4][2];
#pragma unroll
    for (int a = 0; a < 2; ++a)
#pragma unroll
        for (int b = 0; b < 2; ++b)
#pragma unroll
            for (int m = 0; m < 4; ++m)
#pragma unroll
                for (int n = 0; n < 2; ++n) acc[a][b][m][n] = (f32x4){0.f, 0.f, 0.f, 0.f};
    bf16x8 At[4][2], B0[2][2], B1[2][2];
    const char* cA = (const char*)g.A + (size_t)cur.pm * tstepA; const char* cB = (const char*)g.Bt + (size_t)cur.pn * tstepB;
    S.a_ready(cur);
    if constexpr (SP2) {
        PG8_STAGE(PG8_SB(0, 0), cB, voffB, stepB); PG8_STAGE(PG8_SB(0, 1), cB + hstepB, voffB, stepB); PG8_STAGE(PG8_SA(0, 0), cA, voffA, stepA); PG8_STAGE(PG8_SA(0, 1), cA + hstepA, voffA, stepA);
        if (wr == 1) PG8_BAR;
        PG8_WAIT_V(2); PG8_BAR;
        PG8_STAGE(PG8_SB(1, 0), cB + kstep, voffB, stepB); PG8_STAGE(PG8_SA(1, 0), cA + kstep, voffA, stepA); PG8_STAGE(PG8_SB(1, 1), cB + hstepB + kstep, voffB, stepB);
        PG8_WAIT_V(6); PG8_BAR;
    } else {
        PG8_STAGE(PG8_SB(0, 0), cB, voffB, stepB); PG8_STAGE(PG8_SA(0, 0), cA, voffA, stepA); PG8_STAGE(PG8_SB(0, 1), cB + hstepB, voffB, stepB); PG8_STAGE(PG8_SA(0, 1), cA + hstepA, voffA, stepA);
        if (wr == 1) PG8_BAR;
        PG8_WAIT_V(4); PG8_BAR;
        PG8_STAGE(PG8_SB(1, 0), cB + kstep, voffB, stepB); PG8_STAGE(PG8_SA(1, 0), cA + kstep, voffA, stepA); PG8_STAGE(PG8_SB(1, 1), cB + hstepB + kstep, voffB, stepB);
        PG8_WAIT_V(6); PG8_BAR;
    }
    for (;;) {
        const bool has_next = S.next(ui + 1, nxt);
        const char* nA = has_next ? (const char*)g.A + (size_t)nxt.pm * tstepA : cA; const char* nB = has_next ? (const char*)g.Bt + (size_t)nxt.pn * tstepB : cB;
        for (int t = 0; t < nt; t += 2) {
            const bool last = (t == nt - 2);
            const char* a1 = cA + (size_t)(t + 1) * kstep;
            const char* a2 = last ? nA : cA + (size_t)(t + 2) * kstep; const char* b2 = last ? nB : cB + (size_t)(t + 2) * kstep;
            const char* a3 = a2 + kstep; const char* b3 = b2 + kstep;
            if (last && has_next) S.a_ready(nxt);
            if constexpr (SP2) {
            PG8_LDB(B0, 0, 0); PG8_LDB(B1, 0, 1); PG8_SCHED; PG8_LDA(At, 0, 0); PG8_STAGE(PG8_SA(1, 1), a1 + hstepA, voffA, stepA);
            PG8_WAIT_V(8); PG8_WAIT_L(0); PG8_BAR; PG8_MMA(0, 0, At, B0); PG8_MMA(0, 1, At, B1); PG8_BAR; PG8_SCHED;
            PG8_LDA(At, 0, 1); PG8_STAGE(PG8_SB(0, 0), b2, voffB, stepB); PG8_STAGE(PG8_SB(0, 1), b2 + hstepB, voffB, stepB); PG8_STAGE(PG8_SA(0, 0), a2, voffA, stepA);
            PG8_WAIT_V(8); PG8_WAIT_L(0); PG8_BAR; PG8_MMA(1, 0, At, B0); PG8_MMA(1, 1, At, B1); PG8_BAR; PG8_SCHED;
            PG8_LDB(B0, 1, 0); PG8_LDB(B1, 1, 1); PG8_SCHED; PG8_LDA(At, 1, 0); PG8_STAGE(PG8_SA(0, 1), a2 + hstepA, voffA, stepA);
            PG8_WAIT_V(8); PG8_WAIT_L(0); PG8_BAR; PG8_MMA(0, 0, At, B0); PG8_MMA(0, 1, At, B1); PG8_BAR; PG8_SCHED;
            PG8_LDA(At, 1, 1); PG8_STAGE(PG8_SB(1, 0), b3, voffB, stepB); PG8_STAGE(PG8_SB(1, 1), b3 + hstepB, voffB, stepB); PG8_STAGE(PG8_SA(1, 0), a3, voffA, stepA);
            PG8_WAIT_V(8); PG8_WAIT_L(0); PG8_BAR; PG8_MMA(1, 0, At, B0); PG8_MMA(1, 1, At, B1); PG8_BAR; PG8_SCHED;
            } else {
            PG8_LDB(B0, 0, 0); PG8_SCHED; PG8_LDA(At, 0, 0); PG8_STAGE(PG8_SA(1, 1), a1 + hstepA, voffA, stepA);
            PG8_WAIT_L(8); PG8_BAR; PG8_WAIT_L(0); PG8_MMA(0, 0, At, B0); PG8_BAR; PG8_SCHED;
            PG8_LDB(B1, 0, 1); PG8_STAGE(PG8_SB(0, 0), b2, voffB, stepB);
            PG8_BAR; PG8_WAIT_L(0); PG8_MMA(0, 1, At, B1); PG8_BAR;
            PG8_LDA(At, 0, 1); PG8_STAGE(PG8_SA(0, 0), a2, voffA, stepA);
            PG8_BAR; PG8_WAIT_L(0); PG8_MMA(1, 0, At, B0); PG8_BAR; PG8_SCHED;
            PG8_STAGE(PG8_SB(0, 1), b2 + hstepB, voffB, stepB);
            PG8_WAIT_V(6); PG8_BAR; PG8_MMA(1, 1, At, B1); PG8_BAR;
            PG8_LDB(B0, 1, 0); PG8_SCHED; PG8_LDA(At, 1, 0); PG8_STAGE(PG8_SA(0, 1), a2 + hstepA, voffA, stepA);
            PG8_WAIT_L(8); PG8_BAR; PG8_WAIT_L(0); PG8_MMA(0, 0, At, B0); PG8_BAR; PG8_SCHED;
            PG8_LDB(B1, 1, 1); PG8_STAGE(PG8_SB(1, 0), b3, voffB, stepB);
            PG8_BAR; PG8_WAIT_L(0); PG8_MMA(0, 1, At, B1); PG8_BAR;
            PG8_LDA(At, 1, 1); PG8_STAGE(PG8_SA(1, 0), a3, voffA, stepA);
            PG8_BAR; PG8_WAIT_L(0); PG8_MMA(1, 0, At, B0); PG8_BAR; PG8_SCHED;
            PG8_STAGE(PG8_SB(1, 1), b3 + hstepB, voffB, stepB);
            PG8_WAIT_V(6); PG8_BAR; PG8_MMA(1, 1, At, B1); PG8_BAR;
            }
        }
        if constexpr (ALIGN_EPI) { if (wr == 0) PG8_BAR; }
        if constexpr (!Epi::AFTER_DRAIN) { E(acc, cur, wr, wc, fr, fq); S.done(cur); }
        if (!has_next) break;
#pragma unroll
        for (int a = 0; a < 2; ++a)
#pragma unroll
            for (int b = 0; b < 2; ++b)
#pragma unroll
                for (int m = 0; m < 4; ++m)
#pragma unroll
                    for (int n = 0; n < 2; ++n) acc[a][b][m][n] = (f32x4){0.f, 0.f, 0.f, 0.f};
        cur = nxt; cA = nA; cB = nB; ++ui;
        if constexpr (ALIGN_EPI) { if (wr == 1) PG8_BAR; }
    }
    PG8_WAIT_V(0);
    if constexpr (!ALIGN_EPI) { if (wr == 0) PG8_BAR; }
    PG8_BAR;
    if constexpr (Epi::AFTER_DRAIN) { E.fused(acc, cur, wr, wc, fr, fq, lds, wid, lane); S.done(cur); }
#undef PG8_SA
#undef PG8_SB
#undef PG8_STAGE
#undef PG8_LDA
#undef PG8_LDB
#undef PG8_MMA
#undef PG8_WAIT_V
#undef PG8_WAIT_L
#undef PG8_BAR
#undef PG8_SCHED
}
}

#define LAS __attribute__((address_space(3)))
using pg8::bf16_t; using pg8::f32x4; using pg8::u32x4; using pg8::cvt_pk_bf16; using pg8::Unit; using pg8::bf16x8;
typedef unsigned u32x2 __attribute__((ext_vector_type(2)));
typedef float f32x2v __attribute__((ext_vector_type(2)));
constexpr int NB = 2, SEQ = 16384, DM = 1024, MR = NB * SEQ, FFH = 2816, NTHR = 512;
constexpr size_t MiB = 1u << 20;
constexpr size_t WS_MODS = 0, WS_KVMODS = 256 * 1024, WS_SS = 1 * MiB, WS_BIAS = 2 * MiB, WS_CS = 3 * MiB;
constexpr size_t WS_WHIN = 8 * MiB, WS_WHOUT = 24 * MiB, WS_WFIN = 28 * MiB, WS_WFOUT = 72 * MiB, WS_WQ = 94 * MiB, WS_WKV = 99 * MiB, WS_WAO = 102 * MiB, WS_WC1 = 106 * MiB, WS_WC2 = 108 * MiB;
constexpr size_t WS_XB = 112 * MiB, WS_R = 176 * MiB;
constexpr size_t WS_HB = WS_R, WS_OB = 432 * MiB, WS_HID = WS_R, WS_Q = WS_R, WS_QR = 240 * MiB, WS_AO = 304 * MiB, WS_XB2 = 352 * MiB, WS_GATES = 370 * MiB, WS_SELM = 376 * MiB, WS_SLOC = 496 * MiB, WS_DSEG = 2 * MiB + 512 * 1024, WS_BAR = 768 * 1024;
constexpr size_t WS_KC = 406 * MiB, WS_VC = 407 * MiB, WS_CHID = 408 * MiB, WS_KV = 416 * MiB;
constexpr size_t WS_END = 512 * MiB;
constexpr int BO_HIN = 0, BO_FIN = 16384, BO_Q = BO_FIN + 45056, BO_KV = BO_Q + 5120, BO_C1 = BO_KV + 3072, BO_GM = BO_C1 + 512;
constexpr int LDS_BYTES = 147456;

struct Params { const float* in[23]; float* out; unsigned char* ws; };
typedef const __attribute__((address_space(4))) Params* PK;
__device__ __forceinline__ PK fresh_pk() { PK k = (PK)__builtin_amdgcn_kernarg_segment_ptr(); asm volatile("" : "+s"(k)); return k; }

__device__ __forceinline__ float bf2f(unsigned short v) { return __uint_as_float(((unsigned)v) << 16); }
__device__ __forceinline__ float bflo(unsigned w) { return __uint_as_float(w << 16); }
__device__ __forceinline__ float bfhi(unsigned w) { return __uint_as_float(w & 0xffff0000u); }
__device__ __forceinline__ float fsigmoid(float v) { return __builtin_amdgcn_rcpf(1.f + __expf(-v)); }
__device__ __forceinline__ float fsilu(float v) { return v * fsigmoid(v); }
__device__ __forceinline__ float wave_sum(float v) {
#pragma unroll
    for (int o = 32; o >= 1; o >>= 1) v += __shfl_xor(v, o);
    return v; }
__device__ __forceinline__ float wave_max(float v) {
#pragma unroll
    for (int o = 32; o >= 1; o >>= 1) v = fmaxf(v, __shfl_xor(v, o));
    return v; }

__device__ __forceinline__ int opaque_lane() { int l; asm volatile("v_mbcnt_lo_u32_b32 %0, -1, 0\n\tv_mbcnt_hi_u32_b32 %0, -1, %0" : "=v"(l)); return l; }
__device__ __forceinline__ float shx(float v, int lane, int mask) { return __int_as_float(__builtin_amdgcn_ds_bpermute((lane ^ mask) << 2, __float_as_int(v))); }
__device__ __forceinline__ bf16_t f2bf(float v) { return (bf16_t)(cvt_pk_bf16(v, 0.f) & 0xffffu); }

struct TJob { const float* W; bf16_t* Wt; int K, Nsrc, Npad, kind, ntiles; };
__device__ __forceinline__ int map_col(int kind, int r) {
    if (kind == 0) return r;
    const int tile = r >> 8, w = r & 255;
    if (kind == 1) { const int j = tile * 128 + (w & 127); return (w < 128) ? j : FFH + j; }
    const int bj = w >> 7, wc = (w >> 5) & 3, jj = w & 31;
    if (kind == 2) { if (r < 1024) return tile * 256 + wc * 64 + bj * 32 + jj; const int g = r - 1024; return g < 48 ? 1024 + g : -1; }
    if (kind == 4) return tile * 256 + wc * 64 + bj * 32 + jj;
    return (wc == 0) ? bj * 32 + jj : -1;
}
__device__ __forceinline__ void get_tjob(PK p, int j, TJob& o) {
    unsigned char* ws = p->ws;
    if (j < 2) { o.W = p->in[6] + (size_t)j * 1024 * 4096; o.Wt = (bf16_t*)(ws + WS_WHIN) + (size_t)j * 4096 * 1024; o.K = 1024; o.Nsrc = 4096; o.Npad = 4096; o.kind = 0; }
    else if (j < 4) { const int l = j - 2; o.W = p->in[9] + (size_t)l * 1024 * 1024; o.Wt = (bf16_t*)(ws + WS_WHOUT) + (size_t)l * 1024 * 1024; o.K = 1024; o.Nsrc = 1024; o.Npad = 1024; o.kind = 0; }
    else if (j < 8) { const int l = j - 4; o.W = p->in[21] + (size_t)l * 1024 * 5632; o.Wt = (bf16_t*)(ws + WS_WFIN) + (size_t)l * 5632 * 1024; o.K = 1024; o.Nsrc = 5632; o.Npad = 5632; o.kind = 1; }
    else if (j < 12) { const int l = j - 8; o.W = p->in[22] + (size_t)l * 2816 * 1024; o.Wt = (bf16_t*)(ws + WS_WFOUT) + (size_t)l * 1024 * 2816; o.K = 2816; o.Nsrc = 1024; o.Npad = 1024; o.kind = 0; }
    else if (j < 14) { const int l = j - 12; o.W = p->in[18] + (size_t)l * 1024 * 1072; o.Wt = (bf16_t*)(ws + WS_WQ) + (size_t)l * 1280 * 1024; o.K = 1024; o.Nsrc = 1072; o.Npad = 1280; o.kind = 2; }
    else if (j == 14) { o.W = p->in[13]; o.Wt = (bf16_t*)(ws + WS_WKV); o.K = 1024; o.Nsrc = 1536; o.Npad = 1536; o.kind = 4; }
    else if (j < 17) { const int l = j - 15; o.W = p->in[20] + (size_t)l * 1024 * 1024; o.Wt = (bf16_t*)(ws + WS_WAO) + (size_t)l * 1024 * 1024; o.K = 1024; o.Nsrc = 1024; o.Npad = 1024; o.kind = 0; }
    else if (j < 19) { const int l = j - 17; o.W = p->in[16] + (size_t)l * 2048 * 256; o.Wt = (bf16_t*)(ws + WS_WC1) + (size_t)l * 256 * 2048; o.K = 2048; o.Nsrc = 256; o.Npad = 256; o.kind = 0; }
    else { const int l = j - 19; o.W = p->in[17] + (size_t)l * 256 * 64; o.Wt = (bf16_t*)(ws + WS_WC2) + (size_t)l * 256 * 256; o.K = 256; o.Nsrc = 64; o.Npad = 256; o.kind = 3; }
    o.ntiles = (o.K / 64) * (o.Npad / 64);
}
__device__ __forceinline__ void transpose_tiles(const TJob& J, int tile0, int tile1, LAS float* scr, int tid) {
    const int nrt = J.Npad / 64; const int rl = tid & 63, kl = tid >> 6; const int rr = tid >> 3, kc = tid & 7;
    float va[8], vb[8];
    { const int kt = tile0 / nrt, rt = tile0 % nrt; const int sc = map_col(J.kind, rt * 64 + rl);
#pragma unroll
      for (int i = 0; i < 8; ++i) va[i] = sc >= 0 ? J.W[(size_t)(kt * 64 + kl + 8 * i) * J.Nsrc + sc] : 0.f; }
    if (tile1 >= 0) { const int kt = tile1 / nrt, rt = tile1 % nrt; const int sc = map_col(J.kind, rt * 64 + rl);
#pragma unroll
      for (int i = 0; i < 8; ++i) vb[i] = sc >= 0 ? J.W[(size_t)(kt * 64 + kl + 8 * i) * J.Nsrc + sc] : 0.f; }
#pragma unroll
    for (int i = 0; i < 8; ++i) scr[(kl + 8 * i) * 65 + rl] = va[i];
    if (tile1 >= 0) {
#pragma unroll
        for (int i = 0; i < 8; ++i) scr[4160 + (kl + 8 * i) * 65 + rl] = vb[i]; }
    __syncthreads();
#pragma unroll
    for (int t = 0; t < 2; ++t) { const int tile = t ? tile1 : tile0; if (tile < 0) continue;
        const int kt = tile / nrt, rt = tile % nrt;
        LAS const float* sp = scr + t * 4160 + (kc * 8) * 65 + rr;
        u32x4 o; o.x = cvt_pk_bf16(sp[0], sp[65]); o.y = cvt_pk_bf16(sp[130], sp[195]); o.z = cvt_pk_bf16(sp[260], sp[325]); o.w = cvt_pk_bf16(sp[390], sp[455]);
        *(u32x4*)(J.Wt + (size_t)(rt * 64 + rr) * J.K + kt * 64 + kc * 8) = o; }
    __syncthreads();
}

__device__ __forceinline__ void phase0(PK p, LAS unsigned char* ldsb, int wid_s) {
    const int tid = opaque_tid(wid_s), G = gridDim.x;
    float* mods = (float*)(p->ws + WS_MODS); float* kvmods = (float*)(p->ws + WS_KVMODS); float* SS = (float*)(p->ws + WS_SS);
    for (int i = blockIdx.x * NTHR + tid; i < 8 * MR; i += G * NTHR) SS[i] = 0.f;
    LAS float* ca = (LAS float*)ldsb; LAS float* red = ca + 2048;
    for (int i = tid; i < 2048; i += NTHR) ca[i] = fsilu(p->in[1][i]);
    __syncthreads();
    for (int item = blockIdx.x; item < 208; item += G) {
        const float* W; const float* bias; float* out; int ld, col0, ostride;
        if (item < 192) { const int l = item / 24, cb = item % 24; W = p->in[2] + (size_t)l * 1024 * 3072; ld = 3072; col0 = cb * 128; bias = p->in[3] + l * 3072; out = mods + l * 6144; ostride = 3072; }
        else { W = p->in[10]; ld = 2048; col0 = (item - 192) * 128; bias = p->in[11]; out = kvmods; ostride = 2048; }
        const int ks = tid >> 7, cl = tid & 127;
        float a0 = 0.f, a1 = 0.f;
        const float* wp = W + (size_t)(ks * 256) * ld + col0 + cl;
#pragma unroll 8
        for (int k = 0; k < 256; ++k) { const float w = wp[(size_t)k * ld]; a0 += ca[ks * 256 + k] * w; a1 += ca[1024 + ks * 256 + k] * w; }
        red[(ks * 128 + cl) * 2] = a0; red[(ks * 128 + cl) * 2 + 1] = a1;
        __syncthreads();
        if (ks == 0) { float s0 = 0.f, s1 = 0.f;
#pragma unroll
            for (int q = 0; q < 4; ++q) { s0 += red[(q * 128 + cl) * 2]; s1 += red[(q * 128 + cl) * 2 + 1]; }
            const float bv = bias[col0 + cl]; out[col0 + cl] = s0 + bv; out[ostride + col0 + cl] = s1 + bv; }
        __syncthreads();
    }
    f32x2v* cs = (f32x2v*)(p->ws + WS_CS);
    for (int i = blockIdx.x * NTHR + tid; i < SEQ * 32; i += G * NTHR) {
        const int t = i >> 5, d = i & 31;
        const float e = (float)(2 * d) / 64.f; const float invf = 1.0f / exp2f(e * 13.287712379549449f);
        const float ang = (float)t * invf;
        double r = (double)ang * 0.15915494309189535; r -= rint(r);
        const float rf = (float)r;
        cs[i] = (f32x2v){__builtin_amdgcn_cosf(rf), __builtin_amdgcn_sinf(rf)};
    }
    LAS float* scr = (LAS float*)ldsb + 4096;
    int base = 0;
#pragma unroll 1
    for (int j = 0; j < 21; ++j) { TJob J; get_tjob(p, j, J);
        int first = ((int)blockIdx.x - base) % G; if (first < 0) first += G;
        for (int tile = first; tile < J.ntiles; tile += 2 * G) transpose_tiles(J, tile, (tile + G < J.ntiles) ? tile + G : -1, scr, tid);
        base += J.ntiles; }
}

__device__ __forceinline__ void phase1(PK p, LAS unsigned char* ldsb, int wid_s) {
    const int tid = opaque_tid(wid_s), G = gridDim.x, lane = tid & 63, wave = tid >> 6;
    const float* mods = (const float*)(p->ws + WS_MODS); const float* kvmods = (const float*)(p->ws + WS_KVMODS); float* BIAS = (float*)(p->ws + WS_BIAS);
    for (int gr = blockIdx.x * 8 + wave; gr < 35328; gr += G * 8) {
        const bf16_t* wr; const float* s0; const float* s1; float* out; int K, ostride; int r = gr;
        if (r < 8192) { const int l = r >> 12; r &= 4095; wr = (const bf16_t*)(p->ws + WS_WHIN) + ((size_t)l * 4096 + r) * 1024; K = 1024; s0 = mods + (2 * l) * 6144; s1 = s0 + 3072; out = BIAS + BO_HIN + l * 8192 + r; ostride = 4096; }
        else if ((r -= 8192) < 22528) { const int l = r / 5632; r -= l * 5632; wr = (const bf16_t*)(p->ws + WS_WFIN) + ((size_t)l * 5632 + r) * 1024; K = 1024; s0 = mods + (2 * l + 1) * 6144; s1 = s0 + 3072; out = BIAS + BO_FIN + l * 11264 + r; ostride = 5632; }
        else if ((r -= 22528) < 2560) { const int l = r / 1280; r -= l * 1280; wr = (const bf16_t*)(p->ws + WS_WQ) + ((size_t)l * 1280 + r) * 1024; K = 1024; s0 = mods + (2 * (l + 2)) * 6144; s1 = s0 + 3072; out = BIAS + BO_Q + l * 2560 + r; ostride = 1280; }
        else if ((r -= 2560) < 1536) { wr = (const bf16_t*)(p->ws + WS_WKV) + (size_t)r * 1024; K = 1024; s0 = kvmods; s1 = kvmods + 2048; out = BIAS + BO_KV + r; ostride = 1536; }
        else { r -= 1536; const int l = r >> 8; r &= 255; wr = (const bf16_t*)(p->ws + WS_WC1) + ((size_t)l * 256 + r) * 2048; K = 2048; s0 = p->in[15] + l * 2048; s1 = s0; out = BIAS + BO_C1 + l * 256 + r; ostride = 0; }
        float a0 = 0.f, a1 = 0.f;
        for (int k = lane * 8; k < K; k += 512) { const u32x4 w = *(const u32x4*)(wr + k);
            const f32x4 x0 = *(const f32x4*)(s0 + k), x1 = *(const f32x4*)(s0 + k + 4), y0 = *(const f32x4*)(s1 + k), y1 = *(const f32x4*)(s1 + k + 4);
            const float wf[8] = {bflo(w.x), bfhi(w.x), bflo(w.y), bfhi(w.y), bflo(w.z), bfhi(w.z), bflo(w.w), bfhi(w.w)};
            a0 += (x0.x * wf[0] + x0.y * wf[1]) + (x0.z * wf[2] + x0.w * wf[3]) + (x1.x * wf[4] + x1.y * wf[5]) + (x1.z * wf[6] + x1.w * wf[7]);
            a1 += (y0.x * wf[0] + y0.y * wf[1]) + (y0.z * wf[2] + y0.w * wf[3]) + (y1.x * wf[4] + y1.y * wf[5]) + (y1.z * wf[6] + y1.w * wf[7]); }
        a0 = wave_sum(a0); a1 = wave_sum(a1);
        if (lane == 0) { out[0] = a0; if (ostride) out[ostride] = a1; }
    }
    for (int i = blockIdx.x * NTHR + tid; i < 9 * 2048; i += G * NTHR) { const int l2 = i >> 11, b = (i >> 10) & 1, k = i & 1023;
        float g, sc; if (l2 < 8) { g = ((l2 & 1) ? p->in[5] : p->in[4])[(l2 >> 1) * 1024 + k]; sc = mods[l2 * 6144 + b * 3072 + 1024 + k]; } else { g = p->in[12][k]; sc = kvmods[b * 2048 + 1024 + k]; }
        BIAS[BO_GM + i] = g * (1.0f + sc); }
    const float* x = p->in[0]; bf16_t* XB = (bf16_t*)(p->ws + WS_XB); float* SS0 = (float*)(p->ws + WS_SS);
    const float* ng = p->in[4]; const float* scl = mods + 1024;
    for (int row = blockIdx.x * 8 + wave; row < MR; row += G * 8) {
        const int b = row >> 14; f32x4 v[4]; float ss = 0.f;
#pragma unroll
        for (int j = 0; j < 4; ++j) { v[j] = *(const f32x4*)(x + (size_t)row * DM + j * 256 + lane * 4); ss += (v[j].x * v[j].x + v[j].y * v[j].y) + (v[j].z * v[j].z + v[j].w * v[j].w); }
        ss = wave_sum(ss); if (lane == 0) SS0[row] = ss;
#pragma unroll
        for (int j = 0; j < 4; ++j) { const int col = j * 256 + lane * 4; const f32x4 g = *(const f32x4*)(ng + col); const f32x4 s = *(const f32x4*)(scl + b * 3072 + col);
            const f32x4 o = v[j] * (g * (s + 1.0f)); u32x2 w; w.x = cvt_pk_bf16(o.x, o.y); w.y = cvt_pk_bf16(o.z, o.w); *(u32x2*)(XB + (size_t)row * DM + col) = w; }
    }
}

#define EPI_ROWS(ai, m) (u.pm * 256 + (ai) * 128 + wr * 64 + (m) * 16 + fr)
__device__ __forceinline__ float rstd_of(const float* ss, int row) { return rsqrtf(ss[row] * (1.0f / 1024.0f) + 1e-6f); }

struct EpiHin {
    static constexpr bool PERM = true, AFTER_DRAIN = false;
    bf16_t* HB; const float* ss; const float* bias;
    __device__ __forceinline__ void operator()(const f32x4 (&acc)[2][2][4][2], const Unit& u, int wr, int wc, int fr_, int fq_) const {
        const int lane_ = opaque_lane(), fr = lane_ & 15, fq = lane_ >> 4;
        const int seg = u.pn >> 2; const bool act = (seg == 0) || (seg == 3);
#pragma unroll
        for (int ai = 0; ai < 2; ++ai)
#pragma unroll
            for (int m = 0; m < 4; ++m) { asm volatile("" ::: "memory"); const int row = EPI_ROWS(ai, m), b = row >> 14; const float rs = rstd_of(ss, row);
#pragma unroll
                for (int bj = 0; bj < 2; ++bj) { const int c0 = u.pn * 256 + bj * 128 + wc * 32 + fq * 8;
                    f32x4 v0 = acc[ai][bj][m][0] * rs + *(const f32x4*)(bias + b * 4096 + c0), v1 = acc[ai][bj][m][1] * rs + *(const f32x4*)(bias + b * 4096 + c0 + 4);
                    if (act) { v0 = (f32x4){fsilu(v0.x), fsilu(v0.y), fsilu(v0.z), fsilu(v0.w)}; v1 = (f32x4){fsilu(v1.x), fsilu(v1.y), fsilu(v1.z), fsilu(v1.w)}; }
                    u32x4 w; w.x = cvt_pk_bf16(v0.x, v0.y); w.y = cvt_pk_bf16(v0.z, v0.w); w.z = cvt_pk_bf16(v1.x, v1.y); w.w = cvt_pk_bf16(v1.z, v1.w);
                    *(u32x4*)(HB + (size_t)row * 4096 + c0) = w; } }
    }
};
struct EpiFin {
    static constexpr bool PERM = true, AFTER_DRAIN = false;
    bf16_t* HID; const float* ss; const float* bias;
    __device__ __forceinline__ void operator()(const f32x4 (&acc)[2][2][4][2], const Unit& u, int wr, int wc, int fr_, int fq_) const {
        const int lane_ = opaque_lane(), fr = lane_ & 15, fq = lane_ >> 4;
        const int ca = u.pn * 256 + wc * 32 + fq * 8, cb = ca + 128, co = u.pn * 128 + wc * 32 + fq * 8;
#pragma unroll
        for (int ai = 0; ai < 2; ++ai)
#pragma unroll
            for (int m = 0; m < 4; ++m) { asm volatile("" ::: "memory"); const int row = EPI_ROWS(ai, m), b = row >> 14; const float rs = rstd_of(ss, row);
                const f32x4 a0 = acc[ai][0][m][0] * rs + *(const f32x4*)(bias + b * 5632 + ca), a1 = acc[ai][0][m][1] * rs + *(const f32x4*)(bias + b * 5632 + ca + 4);
                const f32x4 b0 = acc[ai][1][m][0] * rs + *(const f32x4*)(bias + b * 5632 + cb), b1 = acc[ai][1][m][1] * rs + *(const f32x4*)(bias + b * 5632 + cb + 4);
                u32x4 w; w.x = cvt_pk_bf16(fsilu(a0.x) * b0.x, fsilu(a0.y) * b0.y); w.y = cvt_pk_bf16(fsilu(a0.z) * b0.z, fsilu(a0.w) * b0.w);
                w.z = cvt_pk_bf16(fsilu(a1.x) * b1.x, fsilu(a1.y) * b1.y); w.w = cvt_pk_bf16(fsilu(a1.z) * b1.z, fsilu(a1.w) * b1.w);
                *(u32x4*)(HID + (size_t)row * FFH + co) = w; }
    }
};
template <bool XB2> struct EpiRes {
    static constexpr bool PERM = true, AFTER_DRAIN = false;
    const float* xold; float* xout; const float* gate;
    float* ssout; bf16_t* xb; const float* gm1;
    bf16_t* xb2; const float* gm2;
    __device__ __forceinline__ void operator()(const f32x4 (&acc)[2][2][4][2], const Unit& u, int wr, int wc, int fr_, int fq_) const {
        const int lane_ = opaque_lane(), fr = lane_ & 15, fq = lane_ >> 4;
#pragma unroll
        for (int ai = 0; ai < 2; ++ai)
#pragma unroll
            for (int m = 0; m < 4; ++m) { const int row = EPI_ROWS(ai, m), b = row >> 14; float sq = 0.f;
#pragma unroll
                for (int bj = 0; bj < 2; ++bj)
#pragma unroll
                    for (int n = 0; n < 2; ++n) { asm volatile("" ::: "memory");
                        const int c0 = u.pn * 256 + bj * 128 + wc * 32 + fq * 8 + n * 4; const size_t off = (size_t)row * DM + c0;
                        const f32x4 x0 = *(const f32x4*)(xold + off) + *(const f32x4*)(gate + b * 3072 + c0) * acc[ai][bj][m][n];
                        *(f32x4*)(xout + off) = x0;
                        sq += (x0.x * x0.x + x0.y * x0.y) + (x0.z * x0.z + x0.w * x0.w);
                        { const f32x4 o0 = x0 * *(const f32x4*)(gm1 + b * 1024 + c0); u32x2 w; w.x = cvt_pk_bf16(o0.x, o0.y); w.y = cvt_pk_bf16(o0.z, o0.w); *(u32x2*)(xb + off) = w; }
                        if (XB2) { const f32x4 o0 = x0 * *(const f32x4*)(gm2 + b * 1024 + c0); u32x2 w; w.x = cvt_pk_bf16(o0.x, o0.y); w.y = cvt_pk_bf16(o0.z, o0.w); *(u32x2*)(xb2 + off) = w; } }
                sq += shx(sq, lane_, 16); sq += shx(sq, lane_, 32);
                if (fq == 0) atomicAdd(ssout + row, sq); }
    }
};
__device__ __forceinline__ void head_norm(float (&v0)[8], float (&v1)[8], const float* gain, int fq, int lane_) {
    float s = 0.f;
#pragma unroll
    for (int i = 0; i < 8; ++i) s += v0[i] * v0[i] + v1[i] * v1[i];
    s += shx(s, lane_, 16); s += shx(s, lane_, 32);
    const float r = rsqrtf(s * (1.0f / 64.0f) + 1e-6f);
#pragma unroll
    for (int i = 0; i < 8; ++i) { v0[i] = v0[i] * r * gain[fq * 8 + i]; v1[i] = v1[i] * r * gain[32 + fq * 8 + i]; }
}
__device__ __forceinline__ void store8(bf16_t* p, const float (&v)[8]) { u32x4 w; w.x = cvt_pk_bf16(v[0], v[1]); w.y = cvt_pk_bf16(v[2], v[3]); w.z = cvt_pk_bf16(v[4], v[5]); w.w = cvt_pk_bf16(v[6], v[7]); *(u32x4*)p = w; }
__device__ __forceinline__ void rope8(const float (&v0)[8], const float (&v1)[8], const f32x2v* cs, int t, int fq, float (&r0)[8], float (&r1)[8]) {
#pragma unroll
    for (int i = 0; i < 8; ++i) { const f32x2v c = cs[t * 32 + fq * 8 + i]; r0[i] = v0[i] * c.x - v1[i] * c.y; r1[i] = v1[i] * c.x + v0[i] * c.y; }
}
struct EpiQ {
    static constexpr bool PERM = true, AFTER_DRAIN = false;
    bf16_t* Q; bf16_t* QR; float* GATES; const float* ss; const float* bias; const float* qn; const f32x2v* cs;
    __device__ __forceinline__ void operator()(const f32x4 (&acc)[2][2][4][2], const Unit& u, int wr, int wc, int fr_, int fq_) const {
        const int lane_ = opaque_lane(), fr = lane_ & 15, fq = lane_ >> 4;
#pragma unroll
        for (int ai = 0; ai < 2; ++ai)
#pragma unroll
            for (int m = 0; m < 4; ++m) { asm volatile("" ::: "memory"); const int row = EPI_ROWS(ai, m), b = row >> 14, t = row & (SEQ - 1); const float rs = rstd_of(ss, row);
                const float* bp = bias + b * 1280 + u.pn * 256 + wc * 32 + fq * 8;
                float v0[8], v1[8];
#pragma unroll
                for (int i = 0; i < 8; ++i) { v0[i] = acc[ai][0][m][i >> 2][i & 3] * rs + bp[i]; v1[i] = acc[ai][1][m][i >> 2][i & 3] * rs + bp[128 + i]; }
                if (u.pn < 4) { const int hd = u.pn * 4 + wc;
                    head_norm(v0, v1, qn, fq, lane_);
#pragma unroll
                    for (int i = 0; i < 8; ++i) { v0[i] *= 0.18033688011112042f; v1[i] *= 0.18033688011112042f; }
                    bf16_t* qp = Q + (size_t)row * DM + hd * 64 + fq * 8; store8(qp, v0); store8(qp + 32, v1);
                    float r0[8], r1[8]; rope8(v0, v1, cs, t, fq, r0, r1);
                    bf16_t* rp = QR + (size_t)row * DM + hd * 64 + fq * 8; store8(rp, r0); store8(rp + 32, r1);
                } else {
                    const int cg = wc * 32 + fq * 8;
#pragma unroll
                    for (int i = 0; i < 8; ++i) if (cg + i < 48) GATES[(size_t)row * 48 + cg + i] = fsigmoid(v0[i]);
                } }
    }
};
struct EpiKV {
    static constexpr bool PERM = true, AFTER_DRAIN = false;
    bf16_t* KV; const float* ss; const float* bias; const float* kn; const f32x2v* cs;
    __device__ __forceinline__ void operator()(const f32x4 (&acc)[2][2][4][2], const Unit& u, int wr, int wc, int fr_, int fq_) const {
        const int lane_ = opaque_lane(), fr = lane_ & 15, fq = lane_ >> 4;
        bf16_t* dst = KV + (size_t)u.pn * (8u << 20);
        const bool nr = (u.pn == 2) || (u.pn == 4);
#pragma unroll
        for (int ai = 0; ai < 2; ++ai)
#pragma unroll
            for (int m = 0; m < 4; ++m) { asm volatile("" ::: "memory"); const int row = EPI_ROWS(ai, m), b = row >> 14, t = row & (SEQ - 1); const float rs = rstd_of(ss, row);
                const float* bp = bias + b * 1536 + u.pn * 256 + wc * 32 + fq * 8;
                float v0[8], v1[8];
#pragma unroll
                for (int i = 0; i < 8; ++i) { v0[i] = acc[ai][0][m][i >> 2][i & 3] * rs + bp[i]; v1[i] = acc[ai][1][m][i >> 2][i & 3] * rs + bp[128 + i]; }
                bf16_t* op = dst + ((size_t)(b * 4 + wc) * SEQ + t) * 64 + fq * 8;
                if (nr) { head_norm(v0, v1, kn + (u.pn >> 1) * 64, fq, lane_); float r0[8], r1[8]; rope8(v0, v1, cs, t, fq, r0, r1); store8(op, r0); store8(op + 32, r1); }
                else if (u.pn == 3 || u.pn == 5) {
                    bf16_t* tp = dst + ((size_t)(b * 4 + wc) * 64 + fq * 8) * SEQ + t;
#pragma unroll
                    for (int i = 0; i < 8; ++i) { tp[(size_t)i * SEQ] = f2bf(v0[i]); tp[(size_t)(32 + i) * SEQ] = f2bf(v1[i]); } }
                else { store8(op, v0); store8(op + 32, v1); } }
    }
};
struct EpiC1 {
    static constexpr bool PERM = true, AFTER_DRAIN = false;
    bf16_t* H; const float* bias;
    __device__ __forceinline__ void operator()(const f32x4 (&acc)[2][2][4][2], const Unit& u, int wr, int wc, int fr_, int fq_) const {
        const int lane_ = opaque_lane(), fr = lane_ & 15, fq = lane_ >> 4;
#pragma unroll
        for (int ai = 0; ai < 2; ++ai)
#pragma unroll
            for (int m = 0; m < 4; ++m) { asm volatile("" ::: "memory"); const int row = EPI_ROWS(ai, m);
#pragma unroll
                for (int bj = 0; bj < 2; ++bj) { const int c0 = bj * 128 + wc * 32 + fq * 8; float v[8];
#pragma unroll
                    for (int i = 0; i < 8; ++i) v[i] = fsilu(acc[ai][bj][m][i >> 2][i & 3] + bias[c0 + i]);
                    store8(H + (size_t)row * 256 + c0, v); } }
    }
};
struct EpiC2 {
    static constexpr bool PERM = true, AFTER_DRAIN = false;
    bf16_t* O; const float* kn; int tr;
    __device__ __forceinline__ void operator()(const f32x4 (&acc)[2][2][4][2], const Unit& u, int wr, int wc, int fr_, int fq_) const {
        const int lane_ = opaque_lane(), fr = lane_ & 15, fq = lane_ >> 4;
        if (wc != 0) return;
#pragma unroll
        for (int ai = 0; ai < 2; ++ai)
#pragma unroll
            for (int m = 0; m < 4; ++m) { asm volatile("" ::: "memory"); const int row = EPI_ROWS(ai, m); float v0[8], v1[8];
#pragma unroll
                for (int i = 0; i < 8; ++i) { v0[i] = acc[ai][0][m][i >> 2][i & 3]; v1[i] = acc[ai][1][m][i >> 2][i & 3]; }
                if (kn) head_norm(v0, v1, kn, fq, lane_);
                if (tr) { bf16_t* tp = O + ((size_t)(row >> 10) * 64 + fq * 8) * 1024 + (row & 1023);
#pragma unroll
                    for (int i = 0; i < 8; ++i) { tp[i * 1024] = f2bf(v0[i]); tp[(32 + i) * 1024] = f2bf(v1[i]); } }
                else { bf16_t* op = O + (size_t)row * 64 + fq * 8; store8(op, v0); store8(op + 32, v1); } }
    }
};
#define RUN_GEMM(EpiT, E, Aptr, Btptr, Mv, Nv, Kv, ldav) do { pg8::Gemm g_{(const bf16_t*)(Aptr), (const bf16_t*)(Btptr), (Mv), (Nv), (Kv), (ldav)}; pg8::StaticOrder S_; int g_x_ = (int)gridDim.x, b_x_ = (int)blockIdx.x; asm volatile("" : "+s"(g_x_), "+s"(b_x_)); S_.init((Mv), (Nv), g_x_, b_x_); \
    pg8::gemm_phase<EpiT, pg8::StaticOrder, true, true>(ldsb, g_, S_, (E), wid_s); } while (0)
#define RUN_GEMM_AT(EpiT, E, Aptr, Btptr, Mv, Nv, Kv, ldav, cshift) do { pg8::Gemm g_{(const bf16_t*)(Aptr), (const bf16_t*)(Btptr), (Mv), (Nv), (Kv), (ldav)}; pg8::StaticOrder S_; int g_x_ = (int)gridDim.x, b_x_ = (int)blockIdx.x - (cshift); asm volatile("" : "+s"(g_x_), "+s"(b_x_)); S_.init((Mv), (Nv), g_x_, b_x_); \
    pg8::gemm_phase<EpiT, pg8::StaticOrder, true, true>(ldsb, g_, S_, (E), wid_s); } while (0)

constexpr int HL_G = 0, HL_ATT = 0, HL_OBUF = 9216, HL_QX = 32768, HL_KX = 50176, HL_KXT = 67584, HL_IT = 86016, HL_ST = 104448, HL_VEC = 139264;
template <bool FULL> __device__ __forceinline__ void phase_hgrn(const bf16_t* HB, bf16_t* OG, float* SLOC, float* DSEG, const float* lbraw, const float* onorm, int layer, LAS unsigned char* ldsb, int wid_s) {
    const int tid = opaque_tid(wid_s), lane = tid & 63, wave = __builtin_amdgcn_readfirstlane(tid >> 6);
    const int t1 = tid >> 3, c0 = (tid & 7) * 16;
    const int k2 = tid & 127, tq = tid >> 7;
    const int fi = lane & 15, fkq = lane >> 4;
    LAS float* Gs = (LAS float*)(ldsb + HL_G); LAS float* vec = (LAS float*)(ldsb + HL_VEC);
    LAS float* eg31 = vec, *e2v = vec + 128, *decv = vec + 256, *lbv = vec + 384, *tot = vec + 512;
    for (int unit = blockIdx.x; unit < 256; unit += gridDim.x) {
        const int b = unit >> 7, h = (unit >> 4) & 7, seg = unit & 15;
        if (tid < 128) { float lb = 0.f; if (layer == 1) lb = 1.0f / (1.0f + __expf(lbraw[h * 128 + tid] - lbraw[1024 + h * 128 + tid])); lbv[tid] = lb; }
        f32x4 S[8];
#pragma unroll
        for (int kt = 0; kt < 8; ++kt) S[kt] = (f32x4){0.f, 0.f, 0.f, 0.f};
        if (FULL) {
            for (int sp = 0; sp < seg; ++sp) { const float* sl = SLOC + (size_t)(unit - seg + sp) * 16384; const float* ds = DSEG + (size_t)(unit - seg + sp) * 128;
#pragma unroll
                for (int kt = 0; kt < 8; ++kt)
#pragma unroll
                    for (int r = 0; r < 4; ++r) { const int k = kt * 16 + fkq * 4 + r; S[kt][r] = ds[k] * S[kt][r] + sl[k * 128 + wave * 16 + fi]; } }
        }
        float lseg = 0.f;
        u32x4 pfa, pfb, pia, pib;
        { const bf16_t* h0 = HB + ((size_t)b * SEQ + seg * 1024 + t1) * 4096 + h * 128 + c0;
          pfa = *(const u32x4*)(h0 + 1024); pfb = *(const u32x4*)(h0 + 1024 + 8); pia = *(const u32x4*)(h0 + 2048); pib = *(const u32x4*)(h0 + 2048 + 8);
        }
        __syncthreads();
#pragma unroll 1
        for (int ch = 0; ch < 16; ++ch) {
            const size_t row0 = (size_t)b * SEQ + seg * 1024 + ch * 64;
            const bf16_t* hrow = HB + (row0 + t1) * 4096 + h * 128 + c0;
            const bf16_t* hnext = hrow + (size_t)64 * 4096; const bool more = (ch + 1 < 16);
            float kk[16];
            { const u32x4 fa = pfa, fb = pfb;
              if (more) { pfa = *(const u32x4*)(hnext + 1024); pfb = *(const u32x4*)(hnext + 1024 + 8); }
              const unsigned fw[8] = {fa.x, fa.y, fa.z, fa.w, fb.x, fb.y, fb.z, fb.w};
              float lg[16];
#pragma unroll
              for (int j = 0; j < 16; ++j) { const float f = fmaxf((j & 1) ? bfhi(fw[j >> 1]) : bflo(fw[j >> 1]), -80.f); const float lb = lbv[c0 + j], om = 1.f - lb;
                  const float e = __expf(-f), sg = __builtin_amdgcn_rcpf(1.f + e); kk[j] = om * (e * sg); lg[j] = __logf(lb + om * sg); }
#pragma unroll
              for (int j = 0; j < 16; j += 4) *(LAS f32x4*)(Gs + t1 * 128 + c0 + j) = (f32x4){lg[j], lg[j + 1], lg[j + 2], lg[j + 3]}; }
            __syncthreads();
            { float loc[16]; float run = 0.f;
#pragma unroll
              for (int j = 0; j < 16; ++j) { run += Gs[(tq * 16 + j) * 128 + k2]; loc[j] = run; }
              tot[tq * 128 + k2] = run;
              __syncthreads();
              float off = 0.f;
#pragma unroll
              for (int q = 0; q < 3; ++q) if (q < tq) off += tot[q * 128 + k2];
#pragma unroll
              for (int j = 0; j < 16; ++j) Gs[(tq * 16 + j) * 128 + k2] = loc[j] + off;
              if (!FULL && tq == 3) lseg += loc[15] + off; }
            __syncthreads();
            { float g31[16], gt[16];
#pragma unroll
              for (int j = 0; j < 16; j += 4) { const f32x4 a = *(LAS const f32x4*)(Gs + 31 * 128 + c0 + j), c = *(LAS const f32x4*)(Gs + t1 * 128 + c0 + j);
                  g31[j] = a.x; g31[j + 1] = a.y; g31[j + 2] = a.z; g31[j + 3] = a.w; gt[j] = c.x; gt[j + 1] = c.y; gt[j + 2] = c.z; gt[j + 3] = c.w; }
              float kx[16];
#pragma unroll
              for (int j = 0; j < 16; ++j) kx[j] = kk[j] * __expf(fminf(g31[j] - gt[j], 80.f));
              LAS bf16_t* kxt = (LAS bf16_t*)(ldsb + HL_KXT);
#pragma unroll
              for (int j = 0; j < 16; ++j) kxt[(c0 + j) * 72 + ((((t1 >> 3) ^ (tid & 7)) << 3) | (t1 & 7))] = f2bf(kx[j]);
              { const u32x4 ia = pia, ib = pib; const unsigned iw[8] = {ia.x, ia.y, ia.z, ia.w, ib.x, ib.y, ib.z, ib.w};
                if (more) { pia = *(const u32x4*)(hnext + 2048); pib = *(const u32x4*)(hnext + 2048 + 8); }
                LAS bf16_t* it = (LAS bf16_t*)(ldsb + HL_IT);
#pragma unroll
                for (int j = 0; j < 16; ++j) it[(c0 + j) * 72 + ((((t1 >> 3) ^ (tid & 7)) << 3) | (t1 & 7))] = (bf16_t)((j & 1) ? (iw[j >> 1] >> 16) : (iw[j >> 1] & 0xffffu)); }
              if (t1 == 0) {
#pragma unroll
                  for (int j = 0; j < 16; ++j) { const float g63 = Gs[63 * 128 + c0 + j]; e2v[c0 + j] = __expf(g63 - g31[j]); decv[c0 + j] = __expf(g63); } }
              if (FULL) {
                  const u32x4 qa = *(const u32x4*)(hrow), qb = *(const u32x4*)(hrow + 8); const unsigned qw[8] = {qa.x, qa.y, qa.z, qa.w, qb.x, qb.y, qb.z, qb.w};
                  float qx[16];
#pragma unroll
                  for (int j = 0; j < 16; ++j) qx[j] = ((j & 1) ? bfhi(qw[j >> 1]) : bflo(qw[j >> 1])) * __expf(fminf(gt[j] - g31[j], 80.f));
                  LAS bf16_t* qxp = (LAS bf16_t*)(ldsb + HL_QX) + t1 * 136 + c0; LAS bf16_t* kxp = (LAS bf16_t*)(ldsb + HL_KX) + t1 * 136 + c0;
                  u32x4 w0, w1;
                  w0.x = cvt_pk_bf16(qx[0], qx[1]); w0.y = cvt_pk_bf16(qx[2], qx[3]); w0.z = cvt_pk_bf16(qx[4], qx[5]); w0.w = cvt_pk_bf16(qx[6], qx[7]);
                  w1.x = cvt_pk_bf16(qx[8], qx[9]); w1.y = cvt_pk_bf16(qx[10], qx[11]); w1.z = cvt_pk_bf16(qx[12], qx[13]); w1.w = cvt_pk_bf16(qx[14], qx[15]);
                  *(LAS u32x4*)qxp = w0; *(LAS u32x4*)(qxp + 8) = w1;
                  w0.x = cvt_pk_bf16(kx[0], kx[1]); w0.y = cvt_pk_bf16(kx[2], kx[3]); w0.z = cvt_pk_bf16(kx[4], kx[5]); w0.w = cvt_pk_bf16(kx[6], kx[7]);
                  w1.x = cvt_pk_bf16(kx[8], kx[9]); w1.y = cvt_pk_bf16(kx[10], kx[11]); w1.z = cvt_pk_bf16(kx[12], kx[13]); w1.w = cvt_pk_bf16(kx[14], kx[15]);
                  *(LAS u32x4*)kxp = w0; *(LAS u32x4*)(kxp + 8) = w1;
                  LAS bf16_t* stp = (LAS bf16_t*)(ldsb + HL_ST) + (wave * 16 + fi) * 136;
#pragma unroll
                  for (int kt = 0; kt < 8; ++kt) { const int k = kt * 16 + fkq * 4; const f32x4 gg = *(LAS const f32x4*)(Gs + 31 * 128 + k);
                      u32x2 w; w.x = cvt_pk_bf16(S[kt][0] * __expf(gg.x), S[kt][1] * __expf(gg.y)); w.y = cvt_pk_bf16(S[kt][2] * __expf(gg.z), S[kt][3] * __expf(gg.w));
                      *(LAS u32x2*)(stp + k) = w; }
              } }
            __syncthreads();
            if (FULL) {
                { const int tt = wave >> 1; LAS bf16_t* att = (LAS bf16_t*)(ldsb + HL_ATT);
                  const LAS bf16_t* qxa = (const LAS bf16_t*)(ldsb + HL_QX) + (tt * 16 + fi) * 136 + fkq * 8;
#pragma unroll
                  for (int u2 = 0; u2 < 2; ++u2) { const int st = 2 * (wave & 1) + u2; f32x4 acc = (f32x4){0.f, 0.f, 0.f, 0.f};
                      if (st <= tt) { const LAS bf16_t* kxb = (const LAS bf16_t*)(ldsb + HL_KX) + (st * 16 + fi) * 136 + fkq * 8;
#pragma unroll
                          for (int ks = 0; ks < 4; ++ks) acc = __builtin_amdgcn_mfma_f32_16x16x32_bf16(*(const LAS bf16x8*)(qxa + ks * 32), *(const LAS bf16x8*)(kxb + ks * 32), acc, 0, 0, 0);
                          if (st == tt) {
#pragma unroll
                              for (int r = 0; r < 4; ++r) if (fi > fkq * 4 + r) acc[r] = 0.f; } }
#pragma unroll
                      for (int r = 0; r < 4; ++r) att[(tt * 16 + fkq * 4 + r) * 72 + st * 16 + fi] = f2bf(acc[r]); } }
                __syncthreads();
                { LAS bf16_t* obuf = (LAS bf16_t*)(ldsb + HL_OBUF);
                  const LAS bf16_t* stb = (const LAS bf16_t*)(ldsb + HL_ST) + (wave * 16 + fi) * 136 + fkq * 8;
                  const LAS bf16_t* itb = (const LAS bf16_t*)(ldsb + HL_IT) + (wave * 16 + fi) * 72;
                  f32x4 oacc[4];
#pragma unroll
                  for (int tt = 0; tt < 4; ++tt) { f32x4 acc = (f32x4){0.f, 0.f, 0.f, 0.f};
                      const LAS bf16_t* qxa = (const LAS bf16_t*)(ldsb + HL_QX) + (tt * 16 + fi) * 136 + fkq * 8;
                      const LAS bf16_t* ata = (const LAS bf16_t*)(ldsb + HL_ATT) + (tt * 16 + fi) * 72 + fkq * 8;
#pragma unroll
                      for (int ks = 0; ks < 4; ++ks) acc = __builtin_amdgcn_mfma_f32_16x16x32_bf16(*(const LAS bf16x8*)(qxa + ks * 32), *(const LAS bf16x8*)(stb + ks * 32), acc, 0, 0, 0);
#pragma unroll
                      for (int ks = 0; ks < 2; ++ks) acc = __builtin_amdgcn_mfma_f32_16x16x32_bf16(*(const LAS bf16x8*)(ata + ks * 32), *(const LAS bf16x8*)(itb + (((ks * 4 + fkq) ^ (wave & 7)) << 3)), acc, 0, 0, 0);
                      oacc[tt] = acc; }
                  __syncthreads();
#pragma unroll
                  for (int tt = 0; tt < 4; ++tt)
#pragma unroll
                      for (int r = 0; r < 4; ++r) obuf[(tt * 16 + fkq * 4 + r) * 136 + wave * 16 + fi] = f2bf(oacc[tt][r]); }
            }
            { const LAS bf16_t* itb = (const LAS bf16_t*)(ldsb + HL_IT) + (wave * 16 + fi) * 72;
#pragma unroll
              for (int kt = 0; kt < 8; ++kt) { f32x4 acc = (f32x4){0.f, 0.f, 0.f, 0.f};
                  const LAS bf16_t* ka = (const LAS bf16_t*)(ldsb + HL_KXT) + (kt * 16 + fi) * 72;
#pragma unroll
                  for (int ks = 0; ks < 2; ++ks) acc = __builtin_amdgcn_mfma_f32_16x16x32_bf16(*(const LAS bf16x8*)(ka + (((ks * 4 + fkq) ^ (kt & 7)) << 3)), *(const LAS bf16x8*)(itb + (((ks * 4 + fkq) ^ (wave & 7)) << 3)), acc, 0, 0, 0);
                  const f32x4 dv = *(LAS const f32x4*)(decv + kt * 16 + fkq * 4), ev = *(LAS const f32x4*)(e2v + kt * 16 + fkq * 4);
                  S[kt] = dv * S[kt] + ev * acc; } }
            __syncthreads();
            if (FULL) {
                const LAS bf16_t* ob = (const LAS bf16_t*)(ldsb + HL_OBUF) + t1 * 136 + c0;
                const u32x4 oa = *(const LAS u32x4*)ob, ob2 = *(const LAS u32x4*)(ob + 8); const unsigned ow[8] = {oa.x, oa.y, oa.z, oa.w, ob2.x, ob2.y, ob2.z, ob2.w};
                const u32x4 ga = *(const u32x4*)(hrow + 3072), gb = *(const u32x4*)(hrow + 3072 + 8); const unsigned gw[8] = {ga.x, ga.y, ga.z, ga.w, gb.x, gb.y, gb.z, gb.w};
                float o[16]; float ss = 0.f;
#pragma unroll
                for (int j = 0; j < 16; ++j) { o[j] = (j & 1) ? bfhi(ow[j >> 1]) : bflo(ow[j >> 1]); ss += o[j] * o[j]; }
                ss += __shfl_xor(ss, 1); ss += __shfl_xor(ss, 2); ss += __shfl_xor(ss, 4);
                const float rs = rsqrtf(ss * (1.0f / 128.0f) + 1e-6f);
                u32x4 w0, w1; float v[16];
#pragma unroll
                for (int j = 0; j < 16; ++j) v[j] = o[j] * rs * onorm[c0 + j] * ((j & 1) ? bfhi(gw[j >> 1]) : bflo(gw[j >> 1]));
                w0.x = cvt_pk_bf16(v[0], v[1]); w0.y = cvt_pk_bf16(v[2], v[3]); w0.z = cvt_pk_bf16(v[4], v[5]); w0.w = cvt_pk_bf16(v[6], v[7]);
                w1.x = cvt_pk_bf16(v[8], v[9]); w1.y = cvt_pk_bf16(v[10], v[11]); w1.z = cvt_pk_bf16(v[12], v[13]); w1.w = cvt_pk_bf16(v[14], v[15]);
                bf16_t* og = OG + (row0 + t1) * DM + h * 128 + c0; *(u32x4*)og = w0; *(u32x4*)(og + 8) = w1;
                __syncthreads();
            }
        }
        if (!FULL) {
            float* sl = SLOC + (size_t)unit * 16384;
#pragma unroll
            for (int kt = 0; kt < 8; ++kt)
#pragma unroll
                for (int r = 0; r < 4; ++r) sl[(kt * 16 + fkq * 4 + r) * 128 + wave * 16 + fi] = S[kt][r];
            if (tq == 3) DSEG[(size_t)unit * 128 + k2] = __expf(lseg);
        }
    }
}

typedef float f32x16 __attribute__((ext_vector_type(16)));
__device__ __forceinline__ void sel_scores(const bf16_t* kp, const bf16x8 (&qf)[4], f32x16 (&S)[2]) {
#pragma unroll
    for (int h = 0; h < 2; ++h) { bf16x8 kf[4];
#pragma unroll
        for (int s = 0; s < 4; ++s) kf[s] = *(const bf16x8*)(kp + h * 2048 + s * 8);
        S[h] = (f32x16){0.f};
#pragma unroll
        for (int s = 0; s < 4; ++s) S[h] = __builtin_amdgcn_mfma_f32_32x32x16_bf16(kf[s], qf[s], S[h], 0, 0, 0); }
}
__device__ __forceinline__ float row_bound(const bf16x8 (&qf)[4], float gmax) {
    float ss = 0.f;
#pragma unroll
    for (int s = 0; s < 4; ++s)
#pragma unroll
        for (int j = 0; j < 8; ++j) { const float v = bf2f((unsigned short)qf[s][j]); ss += v * v; }
    ss += __shfl_xor(ss, 32);
    return sqrtf(ss) * 8.08f * gmax;
}
__device__ __forceinline__ float dpp_quad_sum(float v) {
    v += __int_as_float(__builtin_amdgcn_update_dpp(0, __float_as_int(v), 0xB1, 0xF, 0xF, true));
    v += __int_as_float(__builtin_amdgcn_update_dpp(0, __float_as_int(v), 0x4E, 0xF, 0xF, true));
    return v; }
__device__ __forceinline__ void phase_sel2(PK p, LAS unsigned char* ldsb, int wid_s) {
    const int tid = opaque_tid(wid_s), lane = tid & 63, wave = __builtin_amdgcn_readfirstlane(tid >> 6);
    const bf16_t* Q = (const bf16_t*)(p->ws + WS_Q); const bf16_t* KC = (const bf16_t*)(p->ws + WS_KC); unsigned* SELM = (unsigned*)(p->ws + WS_SELM);
    LAS float* imp = (LAS float*)(ldsb + wave * 8448);
    const int n = lane & 31, hi = lane >> 5, ql = n >> 2, g = n & 3;
    const int pim = (n & ~12) | ((n & 4) << 1) | ((n & 8) >> 1);
    const float gmax0 = wave_max(fabsf(p->in[14][lane]));
    for (int u = blockIdx.x; u < 2048; u += gridDim.x) {
        const int bh = u >> 8, iu = u & 255, ii = ((iu & 7) << 5) | (iu >> 3)  , qb = (bh & 1) ? 255 - ii : ii, b = bh >> 2, kvh = bh & 3;
        const int tq = qb * 64 + wave * 8 + ql, hd = kvh * 4 + g, row = b * SEQ + tq;
        const int nvq = tq >= 31 ? ((tq - 31) >> 4) + 1 : 0;
        const int tmaxw = qb * 64 + wave * 8 + 7; const int nvmaxw = tmaxw >= 31 ? ((tmaxw - 31) >> 4) + 1 : 0; const int ncb = (nvmaxw + 63) >> 6;
        bf16x8 qf[4];
#pragma unroll
        for (int s = 0; s < 4; ++s) qf[s] = *(const bf16x8*)(Q + (size_t)row * DM + hd * 64 + 32 * hi + 8 * s);
        const bf16_t* kbase = KC + (size_t)bh * 65536 + pim * 64 + 32 * hi;
        for (int i = lane; i < 8 * 264; i += 64) imp[i] = 0.f;
        const float mfix = row_bound(qf, gmax0);
        float l = 0.f;
        for (int blk = 0; blk < ncb; ++blk) { f32x16 S[2]; sel_scores(kbase + (size_t)blk * 4096, qf, S);
            f32x2v ls2 = (f32x2v){0.f, 0.f};
#pragma unroll
            for (int h = 0; h < 2; ++h)
#pragma unroll
                for (int r = 0; r < 16; r += 2) { const int kpos = blk * 64 + 32 * h + 16 * (r >> 3) + 8 * hi + (r & 7);
                    f32x2v pv; pv.x = (kpos < nvq) ? __builtin_amdgcn_exp2f(S[h][r] - mfix) : 0.f; pv.y = (kpos + 1 < nvq) ? __builtin_amdgcn_exp2f(S[h][r + 1] - mfix) : 0.f; ls2 += pv; }
            l += ls2.x + ls2.y; }
        l += __shfl_xor(l, 32);
        const float inv = l > 0.f ? 1.0f / l : 0.f;
        for (int blk = 0; blk < ncb; ++blk) { f32x16 S[2]; sel_scores(kbase + (size_t)blk * 4096, qf, S);
#pragma unroll
            for (int h = 0; h < 2; ++h)
#pragma unroll
                for (int rg = 0; rg < 2; ++rg) { float pv[8];
#pragma unroll
                    for (int e = 0; e < 8; ++e) { const int kpos = blk * 64 + 32 * h + 16 * rg + 8 * hi + e; pv[e] = (kpos < nvq) ? __builtin_amdgcn_exp2f(S[h][8 * rg + e] - mfix) * inv : 0.f; }
                    float s0 = (pv[0] + pv[1]) + (pv[2] + pv[3]), s1 = pv[3] + (pv[4] + pv[5]) + (pv[6] + pv[7]), s2 = pv[7];
                    s0 = dpp_quad_sum(s0); s1 = dpp_quad_sum(s1); s2 = dpp_quad_sum(s2);
                    if (g == 0) { const int j0 = (blk * 64 + 32 * h + 16 * rg + 8 * hi) >> 2; LAS float* ip = imp + ql * 264 + j0;
                        atomicAdd((float*)ip, s0); atomicAdd((float*)(ip + 1), s1); atomicAdd((float*)(ip + 2), s2); } } }
        const int cur = qb;
#pragma unroll 1
        for (int q = 0; q < 8; ++q) {
            unsigned bits[4]; bool valid[4], sel[4];
#pragma unroll
            for (int i2 = 0; i2 < 4; ++i2) { const int j = lane + 64 * i2; valid[i2] = j <= cur; const float im = imp[q * 264 + j];
                const bool forced = (j == 0) || (j == cur) || (j == cur - 1);
                bits[i2] = valid[i2] ? __float_as_uint(forced ? 1e9f : im) : 0u; sel[i2] = valid[i2]; }
            if (cur + 1 > 16) {
                unsigned T = 0u;
#define TK_SEARCH(NI2) for (int bit = 30; bit >= 0; --bit) { const unsigned cand = T | (1u << bit); int cnt = 0; \
                    _Pragma("unroll") for (int i2 = 0; i2 < NI2; ++i2) cnt += __popcll(__ballot(bits[i2] >= cand)); \
                    if (cnt >= 16) T = cand; }
                const int ni2 = (cur >> 6) + 1;
                if (ni2 == 1) { TK_SEARCH(1) } else if (ni2 == 2) { TK_SEARCH(2) } else if (ni2 == 3) { TK_SEARCH(3) } else { TK_SEARCH(4) }
#undef TK_SEARCH
                int cgt = 0;
#pragma unroll
                for (int i2 = 0; i2 < 4; ++i2) cgt += __popcll(__ballot(bits[i2] > T));
                int remaining = 16 - cgt;
                const unsigned long long ltmask = (1ull << lane) - 1ull;
#pragma unroll
                for (int i2 = 0; i2 < 4; ++i2) { const bool eq = (bits[i2] == T) && valid[i2]; const unsigned long long ball = __ballot(eq); const int rank = __popcll(ball & ltmask);
                    sel[i2] = valid[i2] && ((bits[i2] > T) || (eq && rank < remaining)); remaining -= min(remaining, (int)__popcll(ball)); }
            }
            const size_t item = (size_t)bh * SEQ + qb * 64 + wave * 8 + q;
#pragma unroll
            for (int i2 = 0; i2 < 4; ++i2) { const unsigned long long ball = __ballot(sel[i2]);
                if (lane == 0) { SELM[item * 8 + 2 * i2] = (unsigned)ball; SELM[item * 8 + 2 * i2 + 1] = (unsigned)(ball >> 32); } }
        }
    }
}

__device__ __forceinline__ void fc_ldk(LAS const unsigned char* tb, int kro, bf16x8 (&kf)[2][4]) {
#pragma unroll
    for (int h = 0; h < 2; ++h)
#pragma unroll
        for (int s = 0; s < 4; ++s) kf[h][s] = *(LAS const bf16x8*)(tb + kro + h * 32 * 144 + s * 16);
}
__device__ __forceinline__ void fc_ldv(LAS const unsigned char* tb, int vro, bf16x8 (&vf)[2][2][2]) {
#pragma unroll
    for (int h = 0; h < 2; ++h)
#pragma unroll
        for (int ks = 0; ks < 2; ++ks)
#pragma unroll
            for (int dh = 0; dh < 2; ++dh) vf[h][ks][dh] = *(LAS const bf16x8*)(tb + vro + dh * 32 * 144 + (h * 32 + ks * 16) * 2);
}
template <int MODE> __device__ __forceinline__ void flash_compute1(LAS const unsigned char* tb, int blk, bool edge, int kro, int vro, bool rowsel, const bf16x8 (&qf)[4], int tq, int nvq, int hi, float mfix, f32x16 (&O)[2], float& l) {
    f32x16 S[2];
    { bf16x8 kf[2][4]; fc_ldk(tb, kro, kf);
#pragma unroll
      for (int h = 0; h < 2; ++h) { S[h] = (f32x16){0.f};
#pragma unroll
          for (int s = 0; s < 4; ++s) S[h] = __builtin_amdgcn_mfma_f32_32x32x16_bf16(kf[h][s], qf[s], S[h], 0, 0, 0); } }
    bf16x8 vf[2][2][2]; fc_ldv(tb, vro, vf);
    if (edge) {
#pragma unroll
        for (int h = 0; h < 2; ++h)
#pragma unroll
            for (int r = 0; r < 16; ++r) { const int kpos = blk * 64 + 32 * h + 16 * (r >> 3) + 8 * hi + (r & 7); bool valid;
                if (MODE == 0) valid = kpos < nvq; else if (MODE == 1) valid = (kpos <= tq); else valid = (kpos <= tq) && (kpos > tq - 512);
                S[h][r] = valid ? S[h][r] : -INFINITY; }
    }
    const float mu = (MODE == 1) ? (rowsel ? mfix : INFINITY) : mfix;
    const f32x2v mu2 = (f32x2v){mu, mu};
    f32x2v ls2 = (f32x2v){0.f, 0.f};
#pragma unroll
    for (int h = 0; h < 2; ++h)
#pragma unroll
        for (int r = 0; r < 16; r += 2) { const f32x2v d = (f32x2v){S[h][r], S[h][r + 1]} - mu2; f32x2v pv; pv.x = __builtin_amdgcn_exp2f(d.x); pv.y = __builtin_amdgcn_exp2f(d.y);
            S[h][r] = pv.x; S[h][r + 1] = pv.y; ls2 += pv; }
    l += ls2.x + ls2.y;
#pragma unroll
    for (int h = 0; h < 2; ++h)
#pragma unroll
        for (int ks = 0; ks < 2; ++ks) { u32x4 w; w.x = cvt_pk_bf16(S[h][8 * ks], S[h][8 * ks + 1]); w.y = cvt_pk_bf16(S[h][8 * ks + 2], S[h][8 * ks + 3]); w.z = cvt_pk_bf16(S[h][8 * ks + 4], S[h][8 * ks + 5]); w.w = cvt_pk_bf16(S[h][8 * ks + 6], S[h][8 * ks + 7]);
            const bf16x8 pf = __builtin_bit_cast(bf16x8, w);
#pragma unroll
            for (int dh = 0; dh < 2; ++dh) O[dh] = __builtin_amdgcn_mfma_f32_32x32x16_bf16(vf[h][ks][dh], pf, O[dh], 0, 0, 0); }
}
constexpr int AL_KV = 0, AL_SLOT = 18432, AL_WU = 55296  , AL_WAVE = 55808  , AL_ACC = 68096  ;
template <int MODE> __device__ __forceinline__ void flash_blocks(const bf16_t* Kb, const bf16_t* Vt, int ldv, int base, int nblk, LAS const int* list, LAS const unsigned* qm, LAS const unsigned* wun,
                                                                LAS unsigned char* ldsb, int tid, const bf16x8 (&qf)[4], int tq, int nvq, int qb, int wave, int ql, int lane, float mfix, f32x16 (&O)[2], float& l) {
    const int m_ = lane & 31, hi = lane >> 5;
    const int pim = (m_ & ~12) | ((m_ & 4) << 1) | ((m_ & 8) >> 1);
    const int kro = pim * 144 + 64 * hi;
    const int vro = 9216 + m_ * 144 + 16 * hi;
    const int srow = tid >> 3, sch = tid & 7;
    const bf16_t* kg = Kb + (size_t)tid * 8;
    const bf16_t* vg = Vt + (size_t)srow * ldv + sch * 8;
    const int sdst = srow * 144 + sch * 16;
    const int tminw = qb * 64 + wave * 8, tmaxw = tminw + 7;
    const int nvminw = tminw >= 31 ? ((tminw - 31) >> 4) + 1 : 0, nvmaxw = tmaxw >= 31 ? ((tmaxw - 31) >> 4) + 1 : 0;
#define FB_BLK(i) ((MODE == 1) ? list[(i)] : base + (i))
    u32x4 ra[3], rb[3];
#pragma unroll
    for (int k = 0; k < 3; ++k) { ra[k] = (u32x4){0u, 0u, 0u, 0u}; rb[k] = ra[k]; if (k < nblk) { const int nb = FB_BLK(k); ra[k] = *(const u32x4*)(kg + (size_t)nb * 4096); rb[k] = *(const u32x4*)(vg + (size_t)nb * 64); } }
    for (int i0 = 0; i0 < nblk; i0 += 3) {
        __syncthreads();
#pragma unroll
        for (int k = 0; k < 3; ++k) if (i0 + k < nblk) { LAS unsigned char* sl = ldsb + AL_KV + k * AL_SLOT; *(LAS u32x4*)(sl + sdst) = ra[k]; *(LAS u32x4*)(sl + 9216 + sdst) = rb[k]; }
        __syncthreads();
#pragma unroll
        for (int k = 0; k < 3; ++k) if (i0 + 3 + k < nblk) { const int nb = FB_BLK(i0 + 3 + k); ra[k] = *(const u32x4*)(kg + (size_t)nb * 4096); rb[k] = *(const u32x4*)(vg + (size_t)nb * 64); }
#pragma unroll 1
        for (int k = 0; k < 3; ++k) { if (i0 + k >= nblk) break;
            const int blk = FB_BLK(i0 + k); bool need = true, edge;
            if (MODE == 0) { need = blk * 64 < nvmaxw; edge = !(blk * 64 + 63 < nvminw); }
            else if (MODE == 1) { need = (wun[blk >> 5] >> (blk & 31)) & 1u; edge = (blk == qb); }
            else edge = (blk == qb) || (blk == qb - 8);
            if (need) { bool rs = true; if (MODE == 1) rs = (qm[ql * 8 + (blk >> 5)] >> (blk & 31)) & 1u;
                flash_compute1<MODE>(ldsb + AL_KV + k * AL_SLOT, blk, edge, kro, vro, rs, qf, tq, nvq, hi, mfix, O, l); } }
    }
#undef FB_BLK
}
__device__ __forceinline__ void phase_att(PK p, LAS unsigned char* ldsb, int wid_s) {
    const int tid = opaque_tid(wid_s), lane = tid & 63, wave = __builtin_amdgcn_readfirstlane(tid >> 6);
    const bf16_t* Q = (const bf16_t*)(p->ws + WS_Q); const bf16_t* QR = (const bf16_t*)(p->ws + WS_QR); bf16_t* AO = (bf16_t*)(p->ws + WS_AO);
    const float* GATES = (const float*)(p->ws + WS_GATES); const unsigned* SELM = (const unsigned*)(p->ws + WS_SELM);
    const bf16_t* KC = (const bf16_t*)(p->ws + WS_KC); const bf16_t* VCt = (const bf16_t*)(p->ws + WS_VC);
    const bf16_t* KS = (const bf16_t*)(p->ws + WS_KV + 32 * MiB); const bf16_t* VSt = (const bf16_t*)(p->ws + WS_KV + 48 * MiB);
    const bf16_t* KW = (const bf16_t*)(p->ws + WS_KV + 64 * MiB); const bf16_t* VWt = (const bf16_t*)(p->ws + WS_KV + 80 * MiB);
    LAS unsigned* wu = (LAS unsigned*)(ldsb + AL_WU);
    LAS unsigned* qm = (LAS unsigned*)(ldsb + AL_WAVE + wave * 1536); LAS unsigned* wun = qm + 64; LAS int* list = (LAS int*)(qm + 128);
    const int n = lane & 31, hi = lane >> 5, ql = n >> 2, g = n & 3;
    const float* kn_ = p->in[14];
    const float gmax0 = wave_max(fabsf(kn_[lane])), gmax12 = wave_max(fmaxf(fabsf(kn_[64 + lane]), fabsf(kn_[128 + lane])));
    for (int u = blockIdx.x; u < 2048; u += gridDim.x) {
        const int bh = u >> 8, iu = u & 255, ii = ((iu & 7) << 5) | (iu >> 3)  , qb = (bh & 1) ? 255 - ii : ii, b = bh >> 2, kvh = bh & 3;
        const int tq = qb * 64 + wave * 8 + ql, hd = kvh * 4 + g, row = b * SEQ + tq;
        const int nvq = tq >= 31 ? ((tq - 31) >> 4) + 1 : 0;
        const int tmaxw = qb * 64 + wave * 8 + 7; const int nvmaxw = tmaxw >= 31 ? ((tmaxw - 31) >> 4) + 1 : 0;
        { const unsigned mw = SELM[((size_t)bh * SEQ + qb * 64 + wave * 8 + (lane >> 3)) * 8 + (lane & 7)];
          qm[lane] = mw;
          unsigned uw = mw; uw |= __shfl_xor(uw, 8); uw |= __shfl_xor(uw, 16); uw |= __shfl_xor(uw, 32);
          if (lane < 8) { wun[lane] = uw; wu[wave * 8 + lane] = uw; } }
        __syncthreads();
        int nsel = 0;
        { unsigned bu = 0u;
#pragma unroll
          for (int w2 = 0; w2 < 8; ++w2) bu |= wu[w2 * 8 + (lane & 7)];
          const int cnt = __popc(bu); int pre = 0;
#pragma unroll
          for (int w2 = 0; w2 < 8; ++w2) { const int c2 = __shfl(cnt, w2); if (w2 < (lane & 7)) pre += c2; nsel += c2; }
          if (lane < 8) { unsigned ww = bu; int k = pre; while (ww) { const int bpos = __ffs(ww) - 1; list[k++] = lane * 32 + bpos; ww &= ww - 1; } } }
        nsel = __builtin_amdgcn_readfirstlane(nsel);
        float gate[3];
#pragma unroll
        for (int br = 0; br < 3; ++br) gate[br] = GATES[(size_t)row * 48 + br * 16 + hd];
        LAS float* oacc = (LAS float*)(ldsb + AL_ACC + wave * 8192) + lane;
        bf16x8 qf[4];
#pragma unroll
        for (int s = 0; s < 4; ++s) qf[s] = *(const bf16x8*)(Q + (size_t)row * DM + hd * 64 + 32 * hi + 8 * s);
        float mfix = row_bound(qf, gmax0);
        { f32x16 O[2]; O[0] = (f32x16){0.f}; O[1] = (f32x16){0.f}; float l = 0.f;
          const int tmax = qb * 64 + 63; const int nvmax = ((tmax - 31) >> 4) + 1; const int ncb = (nvmax + 63) >> 6;
          flash_blocks<0>(KC + (size_t)bh * 65536, VCt + (size_t)bh * 65536, 1024, 0, ncb, list, qm, wun, ldsb, tid, qf, tq, nvq, qb, wave, ql, lane, mfix, O, l);
          l += __shfl_xor(l, 32); const float sc = l > 0.f ? gate[0] / l : 0.f;
#pragma unroll
          for (int dh = 0; dh < 2; ++dh)
#pragma unroll
              for (int r = 0; r < 16; ++r) oacc[(dh * 16 + r) * 64] = O[dh][r] * sc; }
#pragma unroll
        for (int s = 0; s < 4; ++s) qf[s] = *(const bf16x8*)(QR + (size_t)row * DM + hd * 64 + 32 * hi + 8 * s);
        mfix = row_bound(qf, gmax12);
        { f32x16 O[2]; O[0] = (f32x16){0.f}; O[1] = (f32x16){0.f}; float l = 0.f;
          flash_blocks<1>(KS + (size_t)bh * SEQ * 64, VSt + (size_t)bh * SEQ * 64, SEQ, 0, nsel, list, qm, wun, ldsb, tid, qf, tq, nvq, qb, wave, ql, lane, mfix, O, l);
          l += __shfl_xor(l, 32); const float sc = l > 0.f ? gate[1] / l : 0.f;
#pragma unroll
          for (int dh = 0; dh < 2; ++dh)
#pragma unroll
              for (int r = 0; r < 16; ++r) oacc[(dh * 16 + r) * 64] += O[dh][r] * sc; }
        { f32x16 O[2]; O[0] = (f32x16){0.f}; O[1] = (f32x16){0.f}; float l = 0.f;
          const int b0 = max(0, qb - 8);
          flash_blocks<2>(KW + (size_t)bh * SEQ * 64, VWt + (size_t)bh * SEQ * 64, SEQ, b0, qb - b0 + 1, list, qm, wun, ldsb, tid, qf, tq, nvq, qb, wave, ql, lane, mfix, O, l);
          l += __shfl_xor(l, 32); const float sc = l > 0.f ? gate[2] / l : 0.f;
          bf16_t* op = AO + (size_t)row * DM + hd * 64 + 4 * hi;
#pragma unroll
          for (int dh = 0; dh < 2; ++dh)
#pragma unroll
              for (int rq = 0; rq < 4; ++rq) { float v[4];
#pragma unroll
                  for (int e = 0; e < 4; ++e) v[e] = oacc[(dh * 16 + rq * 4 + e) * 64] + O[dh][rq * 4 + e] * sc;
                  u32x2 w; w.x = cvt_pk_bf16(v[0], v[1]); w.y = cvt_pk_bf16(v[2], v[3]); *(u32x2*)(op + 32 * dh + 8 * rq) = w; } }
    }
}

#define XB_TMO      128
#define XB_XCNT(j)  (256  + 64 * (j))
#define XB_XSUB(j)  (1280 + 64 * (j))
#define XB_XGEN(j)  (2304 + 64 * (j))
#define XB_TOP      3328
#define XB_TOPGEN   3392
#define XCD_BAR_WORDS 3456
#define XB_SPIN_CAP (1u << 18)

__device__ __forceinline__ unsigned xb_ld(unsigned* p)              { return __hip_atomic_load(p, __ATOMIC_RELAXED, __HIP_MEMORY_SCOPE_AGENT); }
__device__ __forceinline__ unsigned xb_add(unsigned* p, unsigned v) { return __hip_atomic_fetch_add(p, v, __ATOMIC_RELAXED, __HIP_MEMORY_SCOPE_AGENT); }
__device__ __forceinline__ unsigned xb_xcc_id() { return (unsigned)__builtin_amdgcn_s_getreg((3 << 11) | 20) & 0xFu; }
#define XB_SPIN(cond, bar) do { unsigned _sp = 0; while (cond) { __builtin_amdgcn_s_sleep(1); \
    if ((++_sp & 255u) == 0u) { if (xb_ld(&(bar)[XB_TMO])) break; if (_sp > XB_SPIN_CAP) { atomicAdd(&(bar)[XB_TMO], 1u); break; } } } } while (0)

struct XcdBarrier {
    unsigned* bar; unsigned x;
    volatile LAS unsigned* st;
};

__device__ __forceinline__ XcdBarrier xcd_barrier_post(unsigned* bar, volatile LAS unsigned* st, bool is0) {
    XcdBarrier b; b.bar = bar; b.x = xb_xcc_id(); b.st = st;
    if (is0) (void)xb_add(&bar[XB_XCNT(b.x)], 1u);
    return b;
}
__device__ __forceinline__ void xcd_barrier_complete(unsigned* bar, unsigned x, unsigned& nloc, unsigned& nx) {
    const unsigned G = gridDim.x * gridDim.y * gridDim.z;
    unsigned sum, cnt, mine, sp = 0u;
    for (;;) {
        sum = 0u; cnt = 0u; mine = 0u;
#pragma unroll
        for (unsigned j = 0; j < 16; ++j) { const unsigned c = xb_ld(&bar[XB_XCNT(j)]); sum += c; cnt += (c > 0u) ? 1u : 0u; mine = (j == x) ? c : mine; }
        if (sum == G) break;
        __builtin_amdgcn_s_sleep(1);
        if ((++sp & 255u) == 0u) { if (xb_ld(&bar[XB_TMO])) break; if (sp > XB_SPIN_CAP) { atomicAdd(&bar[XB_TMO], 1u); break; } }
    }
    nloc = mine > 0u ? mine : 1u; nx = cnt > 0u ? cnt : 1u;
}

__device__ __attribute__((noinline)) void xcd_barrier(const XcdBarrier b, bool is0) {
    asm volatile("s_waitcnt vmcnt(0)" ::: "memory");
    __syncthreads();
    if (is0) {
        unsigned* bar = b.bar;
        __builtin_amdgcn_s_waitcnt(0);
        unsigned nloc = b.st[0], nx = b.st[1];
        if (nloc == 0u) { xcd_barrier_complete(bar, b.x, nloc, nx); b.st[0] = nloc; b.st[1] = nx; }
        const unsigned old = xb_add(&bar[XB_XSUB(b.x)], 1u);
        const unsigned gen = old / nloc;
        if (old + 1u == (gen + 1u) * nloc) {
            __builtin_amdgcn_fence(__ATOMIC_RELEASE, "agent");
            asm volatile("s_waitcnt vmcnt(0)" ::: "memory");
            const unsigned og = xb_add(&bar[XB_TOP], 1u);
            const unsigned tg = og / nx;
            if (og + 1u == (tg + 1u) * nx) xb_add(&bar[XB_TOPGEN], 1u);
            else XB_SPIN(xb_ld(&bar[XB_TOPGEN]) == tg, bar);
            __builtin_amdgcn_fence(__ATOMIC_ACQUIRE, "agent");
            xb_add(&bar[XB_XGEN(b.x)], 1u);
            asm volatile("s_waitcnt vmcnt(0)" ::: "memory");
        } else {
            XB_SPIN(xb_ld(&bar[XB_XGEN(b.x)]) == gen, bar);
            __builtin_amdgcn_fence(__ATOMIC_ACQUIRE, "agent");
            asm volatile("s_waitcnt vmcnt(0)" ::: "memory");
        }
    }
    __syncthreads();
}

__global__ void __launch_bounds__(NTHR, 2) yoco_fwd(Params p_unused) {
    extern __shared__ __attribute__((aligned(16))) unsigned char lds_raw[];
    LAS unsigned char* ldsb = (LAS unsigned char*)lds_raw;
    cg::grid_group grid = cg::this_grid();
    const int wid_s = __builtin_amdgcn_readfirstlane((int)threadIdx.x >> 6);
    volatile LAS unsigned* bst = (volatile LAS unsigned*)(ldsb + LDS_BYTES - 16);
    { const int t0_ = opaque_tid(wid_s); if (t0_ == 0) { bst[0] = 0u; bst[1] = 0u; } __syncthreads(); }
    XcdBarrier xbar; { PK pk = fresh_pk(); xbar = xcd_barrier_post((unsigned*)(pk->ws + WS_BAR), bst, opaque_tid(wid_s) == 0); }
#define GSYNC() xcd_barrier(xbar, opaque_tid(wid_s) == 0)
#define FRESH() PK pk = fresh_pk(); unsigned char* ws = pk->ws; float* mods = (float*)(ws + WS_MODS); float* SS = (float*)(ws + WS_SS); const float* BIAS = (const float*)(ws + WS_BIAS); \
    const f32x2v* cs = (const f32x2v*)(ws + WS_CS); bf16_t* XB = (bf16_t*)(ws + WS_XB); bf16_t* XB2 = (bf16_t*)(ws + WS_XB2); bf16_t* HB = (bf16_t*)(ws + WS_HB); bf16_t* OB = (bf16_t*)(ws + WS_OB); bf16_t* HID = (bf16_t*)(ws + WS_HID); \
    float* xout = pk->out; (void)mods; (void)SS; (void)BIAS; (void)cs; (void)XB; (void)XB2; (void)HB; (void)OB; (void)HID; (void)xout;

    { PK pk = fresh_pk(); phase0(pk, ldsb, wid_s); }
    GSYNC();
    if (fresh_pk()->out == nullptr) grid.sync();
    { PK pk = fresh_pk(); phase1(pk, ldsb, wid_s); }
    GSYNC();

#pragma unroll 1
    for (int layer = 0; layer < 4; ++layer) {
        if (layer < 2) {
            { FRESH(); EpiHin E{HB, SS + (size_t)(2 * layer) * MR, BIAS + BO_HIN + layer * 8192};
              RUN_GEMM(EpiHin, E, XB, ws + WS_WHIN + (size_t)layer * 4096 * 1024 * 2, MR, 4096, 1024, 1024); }
            GSYNC();
            { FRESH(); phase_hgrn<false>(HB, OB, (float*)(ws + WS_SLOC), (float*)(ws + WS_DSEG), pk->in[7], pk->in[8] + layer * 128, layer, ldsb, wid_s); }
            GSYNC();
            { FRESH(); phase_hgrn<true>(HB, OB, (float*)(ws + WS_SLOC), (float*)(ws + WS_DSEG), pk->in[7], pk->in[8] + layer * 128, layer, ldsb, wid_s); }
            GSYNC();
            { FRESH(); const float* xold = (layer == 0) ? pk->in[0] : xout;
              EpiRes<false> E{xold, xout, mods + (2 * layer) * 6144 + 2048, SS + (size_t)(2 * layer + 1) * MR, XB, BIAS + BO_GM + (2 * layer + 1) * 2048, nullptr, nullptr};
              RUN_GEMM(EpiRes<false>, E, OB, ws + WS_WHOUT + (size_t)layer * 1024 * 1024 * 2, MR, 1024, 1024, 1024); }
            GSYNC();
        } else {
            const int bl = layer - 2;
            if (bl == 0) {
                { FRESH(); EpiKV E{(bf16_t*)(ws + WS_KV), SS + (size_t)4 * MR, BIAS + BO_KV, pk->in[14], cs};
                  RUN_GEMM(EpiKV, E, XB2, ws + WS_WKV, MR, 1536, 1024, 1024); }
            }
            { FRESH(); EpiQ E{(bf16_t*)(ws + WS_Q), (bf16_t*)(ws + WS_QR), (float*)(ws + WS_GATES), SS + (size_t)(2 * layer) * MR, BIAS + BO_Q + bl * 2560, pk->in[19] + bl * 64, cs};
              RUN_GEMM(EpiQ, E, XB, ws + WS_WQ + (size_t)bl * 1280 * 1024 * 2, MR, 1280, 1024, 1024); }
            GSYNC();
            if (bl == 0) {
#pragma unroll 1
                for (int j = 0; j < 2; ++j) { FRESH(); EpiC1 E{(bf16_t*)(ws + WS_CHID) + (size_t)j * 8192 * 256, BIAS + BO_C1 + j * 256};
                    RUN_GEMM_AT(EpiC1, E, ws + WS_KV + (size_t)j * 16 * MiB, ws + WS_WC1 + (size_t)j * 256 * 2048 * 2, 8192, 256, 2048, 1024, (gridDim.x >= 64) ? 32 * j : 0); }
                GSYNC();
#pragma unroll 1
                for (int j = 0; j < 2; ++j) { FRESH(); EpiC2 E{(bf16_t*)(ws + (j == 0 ? WS_KC : WS_VC)), j == 0 ? pk->in[14] : nullptr, j};
                    RUN_GEMM_AT(EpiC2, E, ws + WS_CHID + (size_t)j * 8192 * 256 * 2, ws + WS_WC2 + (size_t)j * 256 * 256 * 2, 8192, 256, 256, 256, (gridDim.x >= 64) ? 32 * j : 0); }
                GSYNC();
            }
            { PK pk = fresh_pk(); phase_sel2(pk, ldsb, wid_s); }
            GSYNC();
            { PK pk = fresh_pk(); phase_att(pk, ldsb, wid_s); }
            GSYNC();
            { FRESH(); EpiRes<false> E{xout, xout, mods + (2 * layer) * 6144 + 2048, SS + (size_t)(2 * layer + 1) * MR, XB, BIAS + BO_GM + (2 * layer + 1) * 2048, nullptr, nullptr};
              RUN_GEMM(EpiRes<false>, E, ws + WS_AO, ws + WS_WAO + (size_t)bl * 1024 * 1024 * 2, MR, 1024, 1024, 1024); }
            GSYNC();
        }
        { FRESH(); EpiFin E{HID, SS + (size_t)(2 * layer + 1) * MR, BIAS + BO_FIN + layer * 11264};
          RUN_GEMM(EpiFin, E, XB, ws + WS_WFIN + (size_t)layer * 5632 * 1024 * 2, MR, 5632, 1024, 1024); }
        GSYNC();
        { FRESH(); const bool last = (layer == 3);
          float* sso = last ? SS : SS + (size_t)(2 * layer + 2) * MR; const float* gmn = BIAS + BO_GM + (last ? 0 : (2 * layer + 2) * 2048);
          const bf16_t* Wt = (const bf16_t*)(ws + WS_WFOUT + (size_t)layer * 1024 * 2816 * 2);
          if (layer == 1) { EpiRes<true> E{xout, xout, mods + (2 * layer + 1) * 6144 + 2048, sso, XB, gmn, XB2, BIAS + BO_GM + 8 * 2048};
              RUN_GEMM(EpiRes<true>, E, HID, Wt, MR, 1024, 2816, 2816); }
          else { EpiRes<false> E{xout, xout, mods + (2 * layer + 1) * 6144 + 2048, sso, XB, gmn, nullptr, nullptr};
              RUN_GEMM(EpiRes<false>, E, HID, Wt, MR, 1024, 2816, 2816); } }
        if (layer < 3) GSYNC();
    }
}

extern "C" void kernel_launch(void* const* d_in, const int* in_sizes, int n_in, void* d_out, int out_size, void* d_ws, size_t ws_size, hipStream_t stream) {
    static int grid = 0;
    if (grid == 0) {
        if (n_in != 23 || out_size != MR * DM || ws_size < WS_END) { fprintf(stderr, "kernel_launch: unexpected problem (n_in %d out %d ws %zu)\n", n_in, out_size, ws_size); grid = -1; return; }
        int dev = 0, cus = 0, per_cu = 0;
        hipGetDevice(&dev); hipDeviceGetAttribute(&cus, hipDeviceAttributeMultiprocessorCount, dev);
        hipFuncSetAttribute((const void*)yoco_fwd, hipFuncAttributeMaxDynamicSharedMemorySize, LDS_BYTES);
        hipOccupancyMaxActiveBlocksPerMultiprocessor(&per_cu, (const void*)yoco_fwd, NTHR, LDS_BYTES);
        if (per_cu < 1) per_cu = 1;
        grid = cus * per_cu;
        fprintf(stderr, "kernel_launch: grid %d (cus %d x %d)\n", grid, cus, per_cu);
    }
    if (grid < 0) return;
    (void)hipMemsetAsync((char*)d_ws + WS_BAR, 0, 16384, stream);
    Params p{};
    for (int i = 0; i < 23; ++i) p.in[i] = (const float*)d_in[i];
    p.out = (float*)d_out; p.ws = (unsigned char*)d_ws;
    void* args[] = {&p};
    hipError_t e = hipLaunchCooperativeKernel((const void*)yoco_fwd, dim3(grid), dim3(NTHR), args, LDS_BYTES, stream);
    if (e != hipSuccess) fprintf(stderr, "cooperative launch failed: %s (grid %d)\n", hipGetErrorString(e), grid);
}
```

```cpp
#include <hip/hip_runtime.h>
#include <hip/hip_cooperative_groups.h>
#include <cstdio>
#include <cstdint>
namespace cg = cooperative_groups;
__device__ __forceinline__ int opaque_tid(int wid) { int l; asm volatile("v_mbcnt_lo_u32_b32 %0, -1, 0\n\tv_mbcnt_hi_u32_b32 %0, -1, %0" : "=v"(l)); int w = wid; asm volatile("" : "+s"(w)); return (w << 6) | l; }
namespace pg8 {
#define PG8_LAS __attribute__((address_space(3)))
typedef unsigned short bf16_t;
typedef short bf16x8 __attribute__((ext_vector_type(8)));
typedef float f32x4 __attribute__((ext_vector_type(4)));
typedef unsigned u32x4 __attribute__((ext_vector_type(4)));
constexpr int BM = 256, BK = 64, HALF = 128, HTB = HALF * BK * 2  , STAGE_BYTES = 8 * HTB, NXCD = 8, WGM = 8;

__host__ __device__ __forceinline__ int lds_byte(int r, int c) { const int st = (r >> 4) * 2 + (c >> 5), rr = r & 15, cc = c & 31, ob = rr * 64 + cc * 2; return st * 1024 + (ob ^ (((ob >> 9) & 1) << 5)); }
__host__ __device__ __forceinline__ void stage_rc(int b, int& R, int& C) { const int st = b / 1024, sb = b % 1024, swz = sb ^ (((sb >> 9) & 1) << 5); R = (st >> 1) * 16 + swz / 64; C = (st & 1) * 32 + (swz % 64) / 2; }
__host__ __device__ __forceinline__ int perm32(int rho) { const int n = rho >> 4, i = rho & 15; return 8 * (i >> 2) + 4 * n + (i & 3); }

struct Unit { int pm, pn; };
struct Gemm { const bf16_t* A; const bf16_t* Bt; int M, N, K, lda; };

struct StaticOrder {
    int nM, nN, nwg, G, c;
    __host__ __device__ void init(int M, int N, int G_, int c_) { nM = M / BM; nN = N / BM; nwg = nM * nN; G = G_; c = c_; }
    __host__ __device__ bool next(int i, Unit& u) const {
        const long L = (long)i * G + c; if (c < 0 || L >= nwg) return false;
        int wgid = (int)L; { const int q = nwg / NXCD, r = nwg % NXCD, xcd = wgid % NXCD, off = wgid / NXCD; wgid = (xcd < r ? xcd * (q + 1) : r * (q + 1) + (xcd - r) * q) + off; }
        const int nig = WGM * nN, gid = wgid / nig, fm = gid * WGM, gsz = (nM - fm) < WGM ? (nM - fm) : WGM;
        u.pm = fm + ((wgid % nig) % gsz); u.pn = (wgid % nig) / gsz; return true;
    }
    __device__ __forceinline__ void a_ready(const Unit&) const {}
    __device__ __forceinline__ void done(const Unit&) const {}
};

typedef float f32x2c __attribute__((ext_vector_type(2))); typedef __bf16 bf16x2c __attribute__((ext_vector_type(2)));
__device__ __forceinline__ unsigned cvt_pk_bf16(float lo, float hi) { f32x2c v = {lo, hi}; bf16x2c b = __builtin_convertvector(v, bf16x2c); return __builtin_bit_cast(unsigned, b); }
typedef float f32x2 __attribute__((ext_vector_type(2)));
template <class Epi, class Sched, bool ALIGN_EPI = false, bool SP2 = false>
__device__ __forceinline__ void gemm_phase(PG8_LAS unsigned char* lds, const Gemm g, const Sched& S, const Epi& E, int wid_) {
    const int tid = opaque_tid(wid_), wid = __builtin_amdgcn_readfirstlane(tid >> 6), lane = tid & 63, wr = wid >> 2, wc = wid & 3, fr = lane & 15, fq = lane >> 4;
    const int K = g.K, nt = K / BK;
    unsigned voffA, voffB;
    { int R, C; stage_rc(tid * 16, R, C); const int Rb = Epi::PERM ? ((R & ~31) + perm32(R & 31)) : R;
      voffA = (unsigned)(R * g.lda + C) * 2u; voffB = (unsigned)(Rb * K + C) * 2u; }
    const size_t stepA = (size_t)64 * g.lda * 2, stepB = (size_t)64 * K * 2;
    const size_t kstep = (size_t)(BK * 2);
    const size_t hstepA = (size_t)HALF * g.lda * 2, hstepB = (size_t)HALF * K * 2;
    const size_t tstepA = 2 * hstepA, tstepB = 2 * hstepB;
    const unsigned ldsw = (unsigned)wid * 1024u;
    const int aoff = lds_byte(wr * 64 + fr, fq * 8), boff = lds_byte(wc * 32 + fr, fq * 8);
#define PG8_SA(b, h) (((b) * 2 + (h)) * HTB)
#define PG8_SB(b, h) ((4 + (b) * 2 + (h)) * HTB)
#define PG8_STAGE(bufoff, gbase, voff, rstep) do { _Pragma("unroll") for (int _i = 0; _i < 2; ++_i) \
        __builtin_amdgcn_global_load_lds((const unsigned*)((const char*)(gbase) + (size_t)_i * (rstep) + (voff)), (PG8_LAS unsigned*)(lds + (bufoff) + ldsw + _i * 8192), 16, 0, 0); } while (0)
#define PG8_LDA(dst, b, h) do { _Pragma("unroll") for (int m = 0; m < 4; ++m) _Pragma("unroll") for (int k = 0; k < 2; ++k) dst[m][k] = *(const PG8_LAS bf16x8*)(lds + PG8_SA(b, h) + aoff + m * 2048 + k * 1024); } while (0)
#define PG8_LDB(dst, b, h) do { _Pragma("unroll") for (int n = 0; n < 2; ++n) _Pragma("unroll") for (int k = 0; k < 2; ++k) dst[n][k] = *(const PG8_LAS bf16x8*)(lds + PG8_SB(b, h) + boff + n * 2048 + k * 1024); } while (0)
#define PG8_MMA(ai, bj, At, Bt) do { __builtin_amdgcn_s_setprio(1); _Pragma("unroll") for (int m = 0; m < 4; ++m) _Pragma("unroll") for (int n = 0; n < 2; ++n) _Pragma("unroll") for (int k = 0; k < 2; ++k) \
        acc[ai][bj][m][n] = __builtin_amdgcn_mfma_f32_16x16x32_bf16(Bt[n][k], At[m][k], acc[ai][bj][m][n], 0, 0, 0); __builtin_amdgcn_s_setprio(0); } while (0)
#define PG8_WAIT_V(n) asm volatile("s_waitcnt vmcnt(" #n ")" ::: "memory")
#define PG8_WAIT_L(n) asm volatile("s_waitcnt lgkmcnt(" #n ")" ::: "memory")
#define PG8_BAR __builtin_amdgcn_s_barrier()
#define PG8_SCHED __builtin_amdgcn_sched_barrier(0)
    Unit cur, nxt; int ui = 0;
    if (!S.next(0, cur)) return;
    f32x4 acc[2][2][4][2];
#pragma unroll
    for (int a = 0; a < 2; ++a)
#pragma unroll
        for (int b = 0; b < 2; ++b)
#pragma unroll
            for (int m = 0; m < 4; ++m)
#pragma unroll
                for (int n = 0; n < 2; ++n) acc[a][b][m][n] = (f32x4){0.f, 0.f, 0.f, 0.f};
    bf16x8 At[4][2], B0[2][2], B1[2][2];
    const char* cA = (const char*)g.A + (size_t)cur.pm * tstepA; const char* cB = (const char*)g.Bt + (size_t)cur.pn * tstepB;
    S.a_ready(cur);
    if constexpr (SP2) {
        PG8_STAGE(PG8_SB(0, 0), cB, voffB, stepB); PG8_STAGE(PG8_SB(0, 1), cB + hstepB, voffB, stepB); PG8_STAGE(PG8_SA(0, 0), cA, voffA, stepA); PG8_STAGE(PG8_SA(0, 1), cA + hstepA, voffA, stepA);
        if (wr == 1) PG8_BAR;
        PG8_WAIT_V(2); PG8_BAR;
        PG8_STAGE(PG8_SB(1, 0), cB + kstep, voffB, stepB); PG8_STAGE(PG8_SA(1, 0), cA + kstep, voffA, stepA); PG8_STAGE(PG8_SB(1, 1), cB + hstepB + kstep, voffB, stepB);
        PG8_WAIT_V(6); PG8_BAR;
    } else {
        PG8_STAGE(PG8_SB(0, 0), cB, voffB, stepB); PG8_STAGE(PG8_SA(0, 0), cA, voffA, stepA); PG8_STAGE(PG8_SB(0, 1), cB + hstepB, voffB, stepB); PG8_STAGE(PG8_SA(0, 1), cA + hstepA, voffA, stepA);
        if (wr == 1) PG8_BAR;
        PG8_WAIT_V(4); PG8_BAR;
        PG8_STAGE(PG8_SB(1, 0), cB + kstep, voffB, stepB); PG8_STAGE(PG8_SA(1, 0), cA + kstep, voffA, stepA); PG8_STAGE(PG8_SB(1, 1), cB + hstepB + kstep, voffB, stepB);
        PG8_WAIT_V(6); PG8_BAR;
    }
    for (;;) {
        const bool has_next = S.next(ui + 1, nxt);
        const char* nA = has_next ? (const char*)g.A + (size_t)nxt.pm * tstepA : cA; const char* nB = has_next ? (const char*)g.Bt + (size_t)nxt.pn * tstepB : cB;
        for (int t = 0; t < nt; t += 2) {
            const bool last = (t == nt - 2);
            const char* a1 = cA + (size_t)(t + 1) * kstep;
            const char* a2 = last ? nA : cA + (size_t)(t + 2) * kstep; const char* b2 = last ? nB : cB + (size_t)(t + 2) * kstep;
            const char* a3 = a2 + kstep; const char* b3 = b2 + kstep;
            if (last && has_next) S.a_ready(nxt);
            if constexpr (SP2) {
            PG8_LDB(B0, 0, 0); PG8_LDB(B1, 0, 1); PG8_SCHED; PG8_LDA(At, 0, 0); PG8_STAGE(PG8_SA(1, 1), a1 + hstepA, voffA, stepA);
            PG8_WAIT_V(8); PG8_WAIT_L(0); PG8_BAR; PG8_MMA(0, 0, At, B0); PG8_MMA(0, 1, At, B1); PG8_BAR; PG8_SCHED;
            PG8_LDA(At, 0, 1); PG8_STAGE(PG8_SB(0, 0), b2, voffB, stepB); PG8_STAGE(PG8_SB(0, 1), b2 + hstepB, voffB, stepB); PG8_STAGE(PG8_SA(0, 0), a2, voffA, stepA);
            PG8_WAIT_V(8); PG8_WAIT_L(0); PG8_BAR; PG8_MMA(1, 0, At, B0); PG8_MMA(1, 1, At, B1); PG8_BAR; PG8_SCHED;
            PG8_LDB(B0, 1, 0); PG8_LDB(B1, 1, 1); PG8_SCHED; PG8_LDA(At, 1, 0); PG8_STAGE(PG8_SA(0, 1), a2 + hstepA, voffA, stepA);
            PG8_WAIT_V(8); PG8_WAIT_L(0); PG8_BAR; PG8_MMA(0, 0, At, B0); PG8_MMA(0, 1, At, B1); PG8_BAR; PG8_SCHED;
            PG8_LDA(At, 1, 1); PG8_STAGE(PG8_SB(1, 0), b3, voffB, stepB); PG8_STAGE(PG8_SB(1, 1), b3 + hstepB, voffB, stepB); PG8_STAGE(PG8_SA(1, 0), a3, voffA, stepA);
            PG8_WAIT_V(8); PG8_WAIT_L(0); PG8_BAR; PG8_MMA(1, 0, At, B0); PG8_MMA(1, 1, At, B1); PG8_BAR; PG8_SCHED;
            } else {
            PG8_LDB(B0, 0, 0); PG8_SCHED; PG8_LDA(At, 0, 0); PG8_STAGE(PG8_SA(1, 1), a1 + hstepA, voffA, stepA);
            PG8_WAIT_L(8); PG8_BAR; PG8_WAIT_L(0); PG8_MMA(0, 0, At, B0); PG8_BAR; PG8_SCHED;
            PG8_LDB(B1, 0, 1); PG8_STAGE(PG8_SB(0, 0), b2, voffB, stepB);
            PG8_BAR; PG8_WAIT_L(0); PG8_MMA(0, 1, At, B1); PG8_BAR;
            PG8_LDA(At, 0, 1); PG8_STAGE(PG8_SA(0, 0), a2, voffA, stepA);
            PG8_BAR; PG8_WAIT_L(0); PG8_MMA(1, 0, At, B0); PG8_BAR; PG8_SCHED;
            PG8_STAGE(PG8_SB(0, 1), b2 + hstepB, voffB, stepB);
            PG8_WAIT_V(6); PG8_BAR; PG8_MMA(1, 1, At, B1); PG8_BAR;
            PG8_LDB(B0, 1, 0); PG8_SCHED; PG8_LDA(At, 1, 0); PG8_STAGE(PG8_SA(0, 1), a2 + hstepA, voffA, stepA);
            PG8_WAIT_L(8); PG8_BAR; PG8_WAIT_L(0); PG8_MMA(0, 0, At, B0); PG8_BAR; PG8_SCHED;
            PG8_LDB(B1, 1, 1); PG8_STAGE(PG8_SB(1, 0), b3, voffB, stepB);
            PG8_BAR; PG8_WAIT_L(0); PG8_MMA(0, 1, At, B1); PG8_BAR;
            PG8_LDA(At, 1, 1); PG8_STAGE(PG8_SA(1, 0), a3, voffA, stepA);
            PG8_BAR; PG8_WAIT_L(0); PG8_MMA(1, 0, At, B0); PG8_BAR; PG8_SCHED;
            PG8_STAGE(PG8_SB(1, 1), b3 + hstepB, voffB, stepB);
            PG8_WAIT_V(6); PG8_BAR; PG8_MMA(1, 1, At, B1); PG8_BAR;
            }
        }
        if constexpr (ALIGN_EPI) { if (wr == 0) PG8_BAR; }
        if constexpr (!Epi::AFTER_DRAIN) { E(acc, cur, wr, wc, fr, fq); S.done(cur); }
        if (!has_next) break;
#pragma unroll
        for (int a = 0; a < 2; ++a)
#pragma unroll
            for (int b = 0; b < 2; ++b)
#pragma unroll
                for (int m = 0; m < 4; ++m)
#pragma unroll
                    for (int n = 0; n < 2; ++n) acc[a][b][m][n] = (f32x4){0.f, 0.f, 0.f, 0.f};
        cur = nxt; cA = nA; cB = nB; ++ui;
        if constexpr (ALIGN_EPI) { if (wr == 1) PG8_BAR; }
    }
    PG8_WAIT_V(0);
    if constexpr (!ALIGN_EPI) { if (wr == 0) PG8_BAR; }
    PG8_BAR;
    if constexpr (Epi::AFTER_DRAIN) { E.fused(acc, cur, wr, wc, fr, fq, lds, wid, lane); S.done(cur); }
#undef PG8_SA
#undef PG8_SB
#undef PG8_STAGE
#undef PG8_LDA
#undef PG8_LDB
#undef PG8_MMA
#undef PG8_WAIT_V
#undef PG8_WAIT_L
#undef PG8_BAR
#undef PG8_SCHED
}
}

#define LAS __attribute__((address_space(3)))
using pg8::bf16_t; using pg8::f32x4; using pg8::u32x4; using pg8::cvt_pk_bf16; using pg8::Unit; using pg8::bf16x8;
typedef unsigned u32x2 __attribute__((ext_vector_type(2)));
typedef float f32x2v __attribute__((ext_vector_type(2)));
constexpr int NB = 2, SEQ = 16384, DM = 1024, MR = NB * SEQ, FFH = 2816, NTHR = 512;
constexpr size_t MiB = 1u << 20;
constexpr size_t WS_MODS = 0, WS_KVMODS = 256 * 1024, WS_SS = 1 * MiB, WS_BIAS = 2 * MiB, WS_CS = 3 * MiB;
constexpr size_t WS_WHIN = 8 * MiB, WS_WHOUT = 24 * MiB, WS_WFIN = 28 * MiB, WS_WFOUT = 72 * MiB, WS_WQ = 94 * MiB, WS_WKV = 99 * MiB, WS_WAO = 102 * MiB, WS_WC1 = 106 * MiB, WS_WC2 = 108 * MiB;
constexpr size_t WS_XB = 112 * MiB, WS_R = 176 * MiB;
constexpr size_t WS_HB = WS_R, WS_OB = 432 * MiB, WS_HID = WS_R, WS_Q = WS_R, WS_QR = 240 * MiB, WS_AO = 304 * MiB, WS_XB2 = 352 * MiB, WS_GATES = 370 * MiB, WS_SELM = 376 * MiB, WS_SLOC = 496 * MiB, WS_DSEG = 2 * MiB + 512 * 1024, WS_BAR = 768 * 1024;
constexpr size_t WS_KC = 406 * MiB, WS_VC = 407 * MiB, WS_CHID = 408 * MiB, WS_KV = 416 * MiB;
constexpr size_t WS_END = 512 * MiB;
constexpr int BO_HIN = 0, BO_FIN = 16384, BO_Q = BO_FIN + 45056, BO_KV = BO_Q + 5120, BO_C1 = BO_KV + 3072, BO_GM = BO_C1 + 512;
constexpr int LDS_BYTES = 147456;

struct Params { const float* in[23]; float* out; unsigned char* ws; };
typedef const __attribute__((address_space(4))) Params* PK;
__device__ __forceinline__ PK fresh_pk() { PK k = (PK)__builtin_amdgcn_kernarg_segment_ptr(); asm volatile("" : "+s"(k)); return k; }

__device__ __forceinline__ float bf2f(unsigned short v) { return __uint_as_float(((unsigned)v) << 16); }
__device__ __forceinline__ float bflo(unsigned w) { return __uint_as_float(w << 16); }
__device__ __forceinline__ float bfhi(unsigned w) { return __uint_as_float(w & 0xffff0000u); }
__device__ __forceinline__ float fsigmoid(float v) { return __builtin_amdgcn_rcpf(1.f + __expf(-v)); }
__device__ __forceinline__ float fsilu(float v) { return v * fsigmoid(v); }
__device__ __forceinline__ float wave_sum(float v) {
#pragma unroll
    for (int o = 32; o >= 1; o >>= 1) v += __shfl_xor(v, o);
    return v; }
__device__ __forceinline__ float wave_max(float v) {
#pragma unroll
    for (int o = 32; o >= 1; o >>= 1) v = fmaxf(v, __shfl_xor(v, o));
    return v; }

__device__ __forceinline__ int opaque_lane() { int l; asm volatile("v_mbcnt_lo_u32_b32 %0, -1, 0\n\tv_mbcnt_hi_u32_b32 %0, -1, %0" : "=v"(l)); return l; }
__device__ __forceinline__ float shx(float v, int lane, int mask) { return __int_as_float(__builtin_amdgcn_ds_bpermute((lane ^ mask) << 2, __float_as_int(v))); }
__device__ __forceinline__ bf16_t f2bf(float v) { return (bf16_t)(cvt_pk_bf16(v, 0.f) & 0xffffu); }

struct TJob { const float* W; bf16_t* Wt; int K, Nsrc, Npad, kind, ntiles; };
__device__ __forceinline__ int map_col(int kind, int r) {
    if (kind == 0) return r;
    const int tile = r >> 8, w = r & 255;
    if (kind == 1) { const int j = tile * 128 + (w & 127); return (w < 128) ? j : FFH + j; }
    const int bj = w >> 7, wc = (w >> 5) & 3, jj = w & 31;
    if (kind == 2) { if (r < 1024) return tile * 256 + wc * 64 + bj * 32 + jj; const int g = r - 1024; return g < 48 ? 1024 + g : -1; }
    if (kind == 4) return tile * 256 + wc * 64 + bj * 32 + jj;
    return (wc == 0) ? bj * 32 + jj : -1;
}
__device__ __forceinline__ void get_tjob(PK p, int j, TJob& o) {
    unsigned char* ws = p->ws;
    if (j < 2) { o.W = p->in[6] + (size_t)j * 1024 * 4096; o.Wt = (bf16_t*)(ws + WS_WHIN) + (size_t)j * 4096 * 1024; o.K = 1024; o.Nsrc = 4096; o.Npad = 4096; o.kind = 0; }
    else if (j < 4) { const int l = j - 2; o.W = p->in[9] + (size_t)l * 1024 * 1024; o.Wt = (bf16_t*)(ws + WS_WHOUT) + (size_t)l * 1024 * 1024; o.K = 1024; o.Nsrc = 1024; o.Npad = 1024; o.kind = 0; }
    else if (j < 8) { const int l = j - 4; o.W = p->in[21] + (size_t)l * 1024 * 5632; o.Wt = (bf16_t*)(ws + WS_WFIN) + (size_t)l * 5632 * 1024; o.K = 1024; o.Nsrc = 5632; o.Npad = 5632; o.kind = 1; }
    else if (j < 12) { const int l = j - 8; o.W = p->in[22] + (size_t)l * 2816 * 1024; o.Wt = (bf16_t*)(ws + WS_WFOUT) + (size_t)l * 1024 * 2816; o.K = 2816; o.Nsrc = 1024; o.Npad = 1024; o.kind = 0; }
    else if (j < 14) { const int l = j - 12; o.W = p->in[18] + (size_t)l * 1024 * 1072; o.Wt = (bf16_t*)(ws + WS_WQ) + (size_t)l * 1280 * 1024; o.K = 1024; o.Nsrc = 1072; o.Npad = 1280; o.kind = 2; }
    else if (j == 14) { o.W = p->in[13]; o.Wt = (bf16_t*)(ws + WS_WKV); o.K = 1024; o.Nsrc = 1536; o.Npad = 1536; o.kind = 4; }
    else if (j < 17) { const int l = j - 15; o.W = p->in[20] + (size_t)l * 1024 * 1024; o.Wt = (bf16_t*)(ws + WS_WAO) + (size_t)l * 1024 * 1024; o.K = 1024; o.Nsrc = 1024; o.Npad = 1024; o.kind = 0; }
    else if (j < 19) { const int l = j - 17; o.W = p->in[16] + (size_t)l * 2048 * 256; o.Wt = (bf16_t*)(ws + WS_WC1) + (size_t)l * 256 * 2048; o.K = 2048; o.Nsrc = 256; o.Npad = 256; o.kind = 0; }
    else { const int l = j - 19; o.W = p->in[17] + (size_t)l * 256 * 64; o.Wt = (bf16_t*)(ws + WS_WC2) + (size_t)l * 256 * 256; o.K = 256; o.Nsrc = 64; o.Npad = 256; o.kind = 3; }
    o.ntiles = (o.K / 64) * (o.Npad / 64);
}
__device__ __forceinline__ void transpose_tiles(const TJob& J, int tile0, int tile1, LAS float* scr, int tid) {
    const int nrt = J.Npad / 64; const int rl = tid & 63, kl = tid >> 6; const int rr = tid >> 3, kc = tid & 7;
    float va[8], vb[8];
    { const int kt = tile0 / nrt, rt = tile0 % nrt; const int sc = map_col(J.kind, rt * 64 + rl);
#pragma unroll
      for (int i = 0; i < 8; ++i) va[i] = sc >= 0 ? J.W[(size_t)(kt * 64 + kl + 8 * i) * J.Nsrc + sc] : 0.f; }
    if (tile1 >= 0) { const int kt = tile1 / nrt, rt = tile1 % nrt; const int sc = map_col(J.kind, rt * 64 + rl);
#pragma unroll
      for (int i = 0; i < 8; ++i) vb[i] = sc >= 0 ? J.W[(size_t)(kt * 64 + kl + 8 * i) * J.Nsrc + sc] : 0.f; }
#pragma unroll
    for (int i = 0; i < 8; ++i) scr[(kl + 8 * i) * 65 + rl] = va[i];
    if (tile1 >= 0) {
#pragma unroll
        for (int i = 0; i < 8; ++i) scr[4160 + (kl + 8 * i) * 65 + rl] = vb[i]; }
    __syncthreads();
#pragma unroll
    for (int t = 0; t < 2; ++t) { const int tile = t ? tile1 : tile0; if (tile < 0) continue;
        const int kt = tile / nrt, rt = tile % nrt;
        LAS const float* sp = scr + t * 4160 + (kc * 8) * 65 + rr;
        u32x4 o; o.x = cvt_pk_bf16(sp[0], sp[65]); o.y = cvt_pk_bf16(sp[130], sp[195]); o.z = cvt_pk_bf16(sp[260], sp[325]); o.w = cvt_pk_bf16(sp[390], sp[455]);
        *(u32x4*)(J.Wt + (size_t)(rt * 64 + rr) * J.K + kt * 64 + kc * 8) = o; }
    __syncthreads();
}

__device__ __forceinline__ void phase0(PK p, LAS unsigned char* ldsb, int wid_s) {
    const int tid = opaque_tid(wid_s), G = gridDim.x;
    float* mods = (float*)(p->ws + WS_MODS); float* kvmods = (float*)(p->ws + WS_KVMODS); float* SS = (float*)(p->ws + WS_SS);
    for (int i = blockIdx.x * NTHR + tid; i < 8 * MR; i += G * NTHR) SS[i] = 0.f;
    LAS float* ca = (LAS float*)ldsb; LAS float* red = ca + 2048;
    for (int i = tid; i < 2048; i += NTHR) ca[i] = fsilu(p->in[1][i]);
    __syncthreads();
    for (int item = blockIdx.x; item < 208; item += G) {
        const float* W; const float* bias; float* out; int ld, col0, ostride;
        if (item < 192) { const int l = item / 24, cb = item % 24; W = p->in[2] + (size_t)l * 1024 * 3072; ld = 3072; col0 = cb * 128; bias = p->in[3] + l * 3072; out = mods + l * 6144; ostride = 3072; }
        else { W = p->in[10]; ld = 2048; col0 = (item - 192) * 128; bias = p->in[11]; out = kvmods; ostride = 2048; }
        const int ks = tid >> 5, cq = tid & 31;
        f32x4 a0 = (f32x4){0.f, 0.f, 0.f, 0.f}, a1 = a0;
        const float* wp = W + (size_t)(ks * 64) * ld + col0 + cq * 4;
#pragma unroll 8
        for (int k = 0; k < 64; ++k) { const f32x4 w = *(const f32x4*)(wp + (size_t)k * ld); a0 += w * ca[ks * 64 + k]; a1 += w * ca[1024 + ks * 64 + k]; }
        LAS f32x4* red4 = (LAS f32x4*)red;
        red4[(ks * 32 + cq) * 2] = a0; red4[(ks * 32 + cq) * 2 + 1] = a1;
        __syncthreads();
        if (tid < 256) { const int col = tid & 127, bb = tid >> 7; float sum = 0.f;
#pragma unroll
            for (int q = 0; q < 16; ++q) sum += red[((q * 32 + (col >> 2)) * 2 + bb) * 4 + (col & 3)];
            out[bb * ostride + col0 + col] = sum + bias[col0 + col]; }
        __syncthreads();
    }
    f32x2v* cs = (f32x2v*)(p->ws + WS_CS);
    for (int i = blockIdx.x * NTHR + tid; i < SEQ * 32; i += G * NTHR) {
        const int t = i >> 5, d = i & 31;
        const float e = (float)(2 * d) / 64.f; const float invf = 1.0f / exp2f(e * 13.287712379549449f);
        const float ang = (float)t * invf;
        double r = (double)ang * 0.15915494309189535; r -= rint(r);
        const float rf = (float)r;
        cs[i] = (f32x2v){__builtin_amdgcn_cosf(rf), __builtin_amdgcn_sinf(rf)};
    }
    LAS float* scr = (LAS float*)ldsb + 4096;
    int base = 0;
#pragma unroll 1
    for (int j = 0; j < 21; ++j) { TJob J; get_tjob(p, j, J);
        int first = ((int)blockIdx.x - base) % G; if (first < 0) first += G;
        for (int tile = first; tile < J.ntiles; tile += 2 * G) transpose_tiles(J, tile, (tile + G < J.ntiles) ? tile + G : -1, scr, tid);
        base += J.ntiles; }
}

__device__ __forceinline__ void phase1(PK p, LAS unsigned char* ldsb, int wid_s) {
    const int tid = opaque_tid(wid_s), G = gridDim.x, lane = tid & 63, wave = tid >> 6;
    const float* mods = (const float*)(p->ws + WS_MODS); const float* kvmods = (const float*)(p->ws + WS_KVMODS); float* BIAS = (float*)(p->ws + WS_BIAS);
    for (int gr = blockIdx.x * 8 + wave; gr < 35328; gr += G * 8) {
        const bf16_t* wr; const float* s0; const float* s1; float* out; int K, ostride; int r = gr;
        if (r < 8192) { const int l = r >> 12; r &= 4095; wr = (const bf16_t*)(p->ws + WS_WHIN) + ((size_t)l * 4096 + r) * 1024; K = 1024; s0 = mods + (2 * l) * 6144; s1 = s0 + 3072; out = BIAS + BO_HIN + l * 8192 + r; ostride = 4096; }
        else if ((r -= 8192) < 22528) { const int l = r / 5632; r -= l * 5632; wr = (const bf16_t*)(p->ws + WS_WFIN) + ((size_t)l * 5632 + r) * 1024; K = 1024; s0 = mods + (2 * l + 1) * 6144; s1 = s0 + 3072; out = BIAS + BO_FIN + l * 11264 + r; ostride = 5632; }
        else if ((r -= 22528) < 2560) { const int l = r / 1280; r -= l * 1280; wr = (const bf16_t*)(p->ws + WS_WQ) + ((size_t)l * 1280 + r) * 1024; K = 1024; s0 = mods + (2 * (l + 2)) * 6144; s1 = s0 + 3072; out = BIAS + BO_Q + l * 2560 + r; ostride = 1280; }
        else if ((r -= 2560) < 1536) { wr = (const bf16_t*)(p->ws + WS_WKV) + (size_t)r * 1024; K = 1024; s0 = kvmods; s1 = kvmods + 2048; out = BIAS + BO_KV + r; ostride = 1536; }
        else { r -= 1536; const int l = r >> 8; r &= 255; wr = (const bf16_t*)(p->ws + WS_WC1) + ((size_t)l * 256 + r) * 2048; K = 2048; s0 = p->in[15] + l * 2048; s1 = s0; out = BIAS + BO_C1 + l * 256 + r; ostride = 0; }
        float a0 = 0.f, a1 = 0.f;
        for (int k = lane * 8; k < K; k += 512) { const u32x4 w = *(const u32x4*)(wr + k);
            const f32x4 x0 = *(const f32x4*)(s0 + k), x1 = *(const f32x4*)(s0 + k + 4), y0 = *(const f32x4*)(s1 + k), y1 = *(const f32x4*)(s1 + k + 4);
            const float wf[8] = {bflo(w.x), bfhi(w.x), bflo(w.y), bfhi(w.y), bflo(w.z), bfhi(w.z), bflo(w.w), bfhi(w.w)};
            a0 += (x0.x * wf[0] + x0.y * wf[1]) + (x0.z * wf[2] + x0.w * wf[3]) + (x1.x * wf[4] + x1.y * wf[5]) + (x1.z * wf[6] + x1.w * wf[7]);
            a1 += (y0.x * wf[0] + y0.y * wf[1]) + (y0.z * wf[2] + y0.w * wf[3]) + (y1.x * wf[4] + y1.y * wf[5]) + (y1.z * wf[6] + y1.w * wf[7]); }
        a0 = wave_sum(a0); a1 = wave_sum(a1);
        if (lane == 0) { out[0] = a0; if (ostride) out[ostride] = a1; }
    }
    for (int i = blockIdx.x * NTHR + tid; i < 9 * 2048; i += G * NTHR) { const int l2 = i >> 11, b = (i >> 10) & 1, k = i & 1023;
        float g, sc; if (l2 < 8) { g = ((l2 & 1) ? p->in[5] : p->in[4])[(l2 >> 1) * 1024 + k]; sc = mods[l2 * 6144 + b * 3072 + 1024 + k]; } else { g = p->in[12][k]; sc = kvmods[b * 2048 + 1024 + k]; }
        BIAS[BO_GM + i] = g * (1.0f + sc); }
    const float* x = p->in[0]; bf16_t* XB = (bf16_t*)(p->ws + WS_XB); float* SS0 = (float*)(p->ws + WS_SS);
    const float* ng = p->in[4]; const float* scl = mods + 1024;
    for (int row = blockIdx.x * 8 + wave; row < MR; row += G * 8) {
        const int b = row >> 14; f32x4 v[4]; float ss = 0.f;
#pragma unroll
        for (int j = 0; j < 4; ++j) { v[j] = *(const f32x4*)(x + (size_t)row * DM + j * 256 + lane * 4); ss += (v[j].x * v[j].x + v[j].y * v[j].y) + (v[j].z * v[j].z + v[j].w * v[j].w); }
        ss = wave_sum(ss); if (lane == 0) SS0[row] = ss;
#pragma unroll
        for (int j = 0; j < 4; ++j) { const int col = j * 256 + lane * 4; const f32x4 g = *(const f32x4*)(ng + col); const f32x4 s = *(const f32x4*)(scl + b * 3072 + col);
            const f32x4 o = v[j] * (g * (s + 1.0f)); u32x2 w; w.x = cvt_pk_bf16(o.x, o.y); w.y = cvt_pk_bf16(o.z, o.w); *(u32x2*)(XB + (size_t)row * DM + col) = w; }
    }
}

#define EPI_ROWS(ai, m) (u.pm * 256 + (ai) * 128 + wr * 64 + (m) * 16 + fr)
__device__ __forceinline__ float rstd_of(const float* ss, int row) { return rsqrtf(ss[row] * (1.0f / 1024.0f) + 1e-6f); }

struct EpiHin {
    static constexpr bool PERM = true, AFTER_DRAIN = false;
    bf16_t* HB; const float* ss; const float* bias;
    __device__ __forceinline__ void operator()(const f32x4 (&acc)[2][2][4][2], const Unit& u, int wr, int wc, int fr_, int fq_) const {
        const int lane_ = opaque_lane(), fr = lane_ & 15, fq = lane_ >> 4;
        const int seg = u.pn >> 2; const bool act = (seg == 0) || (seg == 3);
#pragma unroll
        for (int ai = 0; ai < 2; ++ai)
#pragma unroll
            for (int m = 0; m < 4; ++m) { asm volatile("" ::: "memory"); const int row = EPI_ROWS(ai, m), b = row >> 14; const float rs = rstd_of(ss, row);
#pragma unroll
                for (int bj = 0; bj < 2; ++bj) { const int c0 = u.pn * 256 + bj * 128 + wc * 32 + fq * 8;
                    f32x4 v0 = acc[ai][bj][m][0] * rs + *(const f32x4*)(bias + b * 4096 + c0), v1 = acc[ai][bj][m][1] * rs + *(const f32x4*)(bias + b * 4096 + c0 + 4);
                    if (act) { v0 = (f32x4){fsilu(v0.x), fsilu(v0.y), fsilu(v0.z), fsilu(v0.w)}; v1 = (f32x4){fsilu(v1.x), fsilu(v1.y), fsilu(v1.z), fsilu(v1.w)}; }
                    u32x4 w; w.x = cvt_pk_bf16(v0.x, v0.y); w.y = cvt_pk_bf16(v0.z, v0.w); w.z = cvt_pk_bf16(v1.x, v1.y); w.w = cvt_pk_bf16(v1.z, v1.w);
                    *(u32x4*)(HB + (size_t)row * 4096 + c0) = w; } }
    }
};
struct EpiFin {
    static constexpr bool PERM = true, AFTER_DRAIN = false;
    bf16_t* HID; const float* ss; const float* bias;
    __device__ __forceinline__ void operator()(const f32x4 (&acc)[2][2][4][2], const Unit& u, int wr, int wc, int fr_, int fq_) const {
        const int lane_ = opaque_lane(), fr = lane_ & 15, fq = lane_ >> 4;
        const int ca = u.pn * 256 + wc * 32 + fq * 8, cb = ca + 128, co = u.pn * 128 + wc * 32 + fq * 8;
#pragma unroll
        for (int ai = 0; ai < 2; ++ai)
#pragma unroll
            for (int m = 0; m < 4; ++m) { asm volatile("" ::: "memory"); const int row = EPI_ROWS(ai, m), b = row >> 14; const float rs = rstd_of(ss, row);
                const f32x4 a0 = acc[ai][0][m][0] * rs + *(const f32x4*)(bias + b * 5632 + ca), a1 = acc[ai][0][m][1] * rs + *(const f32x4*)(bias + b * 5632 + ca + 4);
                const f32x4 b0 = acc[ai][1][m][0] * rs + *(const f32x4*)(bias + b * 5632 + cb), b1 = acc[ai][1][m][1] * rs + *(const f32x4*)(bias + b * 5632 + cb + 4);
                u32x4 w; w.x = cvt_pk_bf16(fsilu(a0.x) * b0.x, fsilu(a0.y) * b0.y); w.y = cvt_pk_bf16(fsilu(a0.z) * b0.z, fsilu(a0.w) * b0.w);
                w.z = cvt_pk_bf16(fsilu(a1.x) * b1.x, fsilu(a1.y) * b1.y); w.w = cvt_pk_bf16(fsilu(a1.z) * b1.z, fsilu(a1.w) * b1.w);
                *(u32x4*)(HID + (size_t)row * FFH + co) = w; }
    }
};
template <bool XB2> struct EpiRes {
    static constexpr bool PERM = true, AFTER_DRAIN = false;
    const float* xold; float* xout; const float* gate;
    float* ssout; bf16_t* xb; const float* gm1;
    bf16_t* xb2; const float* gm2;
    __device__ __forceinline__ void operator()(const f32x4 (&acc)[2][2][4][2], const Unit& u, int wr, int wc, int fr_, int fq_) const {
        const int lane_ = opaque_lane(), fr = lane_ & 15, fq = lane_ >> 4;
#pragma unroll
        for (int ai = 0; ai < 2; ++ai)
#pragma unroll
            for (int m = 0; m < 4; ++m) { const int row = EPI_ROWS(ai, m), b = row >> 14; float sq = 0.f;
#pragma unroll
                for (int bj = 0; bj < 2; ++bj)
#pragma unroll
                    for (int n = 0; n < 2; ++n) { asm volatile("" ::: "memory");
                        const int c0 = u.pn * 256 + bj * 128 + wc * 32 + fq * 8 + n * 4; const size_t off = (size_t)row * DM + c0;
                        const f32x4 x0 = *(const f32x4*)(xold + off) + *(const f32x4*)(gate + b * 3072 + c0) * acc[ai][bj][m][n];
                        *(f32x4*)(xout + off) = x0;
                        sq += (x0.x * x0.x + x0.y * x0.y) + (x0.z * x0.z + x0.w * x0.w);
                        { const f32x4 o0 = x0 * *(const f32x4*)(gm1 + b * 1024 + c0); u32x2 w; w.x = cvt_pk_bf16(o0.x, o0.y); w.y = cvt_pk_bf16(o0.z, o0.w); *(u32x2*)(xb + off) = w; }
                        if (XB2) { const f32x4 o0 = x0 * *(const f32x4*)(gm2 + b * 1024 + c0); u32x2 w; w.x = cvt_pk_bf16(o0.x, o0.y); w.y = cvt_pk_bf16(o0.z, o0.w); *(u32x2*)(xb2 + off) = w; } }
                sq += shx(sq, lane_, 16); sq += shx(sq, lane_, 32);
                if (fq == 0) atomicAdd(ssout + row, sq); }
    }
};
__device__ __forceinline__ void head_norm(float (&v0)[8], float (&v1)[8], const float* gain, int fq, int lane_) {
    float s = 0.f;
#pragma unroll
    for (int i = 0; i < 8; ++i) s += v0[i] * v0[i] + v1[i] * v1[i];
    s += shx(s, lane_, 16); s += shx(s, lane_, 32);
    const float r = rsqrtf(s * (1.0f / 64.0f) + 1e-6f);
#pragma unroll
    for (int i = 0; i < 8; ++i) { v0[i] = v0[i] * r * gain[fq * 8 + i]; v1[i] = v1[i] * r * gain[32 + fq * 8 + i]; }
}
__device__ __forceinline__ void store8(bf16_t* p, const float (&v)[8]) { u32x4 w; w.x = cvt_pk_bf16(v[0], v[1]); w.y = cvt_pk_bf16(v[2], v[3]); w.z = cvt_pk_bf16(v[4], v[5]); w.w = cvt_pk_bf16(v[6], v[7]); *(u32x4*)p = w; }
__device__ __forceinline__ void rope8(const float (&v0)[8], const float (&v1)[8], const f32x2v* cs, int t, int fq, float (&r0)[8], float (&r1)[8]) {
#pragma unroll
    for (int i = 0; i < 8; ++i) { const f32x2v c = cs[t * 32 + fq * 8 + i]; r0[i] = v0[i] * c.x - v1[i] * c.y; r1[i] = v1[i] * c.x + v0[i] * c.y; }
}
struct EpiQ {
    static constexpr bool PERM = true, AFTER_DRAIN = false;
    bf16_t* Q; bf16_t* QR; float* GATES; const float* ss; const float* bias; const float* qn; const f32x2v* cs;
    __device__ __forceinline__ void operator()(const f32x4 (&acc)[2][2][4][2], const Unit& u, int wr, int wc, int fr_, int fq_) const {
        const int lane_ = opaque_lane(), fr = lane_ & 15, fq = lane_ >> 4;
#pragma unroll
        for (int ai = 0; ai < 2; ++ai)
#pragma unroll
            for (int m = 0; m < 4; ++m) { asm volatile("" ::: "memory"); const int row = EPI_ROWS(ai, m), b = row >> 14, t = row & (SEQ - 1); const float rs = rstd_of(ss, row);
                const float* bp = bias + b * 1280 + u.pn * 256 + wc * 32 + fq * 8;
                float v0[8], v1[8];
#pragma unroll
                for (int i = 0; i < 8; ++i) { v0[i] = acc[ai][0][m][i >> 2][i & 3] * rs + bp[i]; v1[i] = acc[ai][1][m][i >> 2][i & 3] * rs + bp[128 + i]; }
                if (u.pn < 4) { const int hd = u.pn * 4 + wc;
                    head_norm(v0, v1, qn, fq, lane_);
#pragma unroll
                    for (int i = 0; i < 8; ++i) { v0[i] *= 0.18033688011112042f; v1[i] *= 0.18033688011112042f; }
                    bf16_t* qp = Q + (size_t)row * DM + hd * 64 + fq * 8; store8(qp, v0); store8(qp + 32, v1);
                    float r0[8], r1[8]; rope8(v0, v1, cs, t, fq, r0, r1);
                    bf16_t* rp = QR + (size_t)row * DM + hd * 64 + fq * 8; store8(rp, r0); store8(rp + 32, r1);
                } else {
                    const int cg = wc * 32 + fq * 8;
#pragma unroll
                    for (int i = 0; i < 8; ++i) if (cg + i < 48) GATES[(size_t)row * 48 + cg + i] = fsigmoid(v0[i]);
                } }
    }
};
struct EpiKV {
    static constexpr bool PERM = true, AFTER_DRAIN = false;
    bf16_t* KV; const float* ss; const float* bias; const float* kn; const f32x2v* cs;
    __device__ __forceinline__ void operator()(const f32x4 (&acc)[2][2][4][2], const Unit& u, int wr, int wc, int fr_, int fq_) const {
        const int lane_ = opaque_lane(), fr = lane_ & 15, fq = lane_ >> 4;
        bf16_t* dst = KV + (size_t)u.pn * (8u << 20);
        const bool nr = (u.pn == 2) || (u.pn == 4);
#pragma unroll
        for (int ai = 0; ai < 2; ++ai)
#pragma unroll
            for (int m = 0; m < 4; ++m) { asm volatile("" ::: "memory"); const int row = EPI_ROWS(ai, m), b = row >> 14, t = row & (SEQ - 1); const float rs = rstd_of(ss, row);
                const float* bp = bias + b * 1536 + u.pn * 256 + wc * 32 + fq * 8;
                float v0[8], v1[8];
#pragma unroll
                for (int i = 0; i < 8; ++i) { v0[i] = acc[ai][0][m][i >> 2][i & 3] * rs + bp[i]; v1[i] = acc[ai][1][m][i >> 2][i & 3] * rs + bp[128 + i]; }
                bf16_t* op = dst + ((size_t)(b * 4 + wc) * SEQ + t) * 64 + fq * 8;
                if (nr) { head_norm(v0, v1, kn + (u.pn >> 1) * 64, fq, lane_); float r0[8], r1[8]; rope8(v0, v1, cs, t, fq, r0, r1); store8(op, r0); store8(op + 32, r1); }
                else if (u.pn == 3 || u.pn == 5) {
                    bf16_t* tp = dst + ((size_t)(b * 4 + wc) * 64 + fq * 8) * SEQ + t;
#pragma unroll
                    for (int i = 0; i < 8; ++i) { tp[(size_t)i * SEQ] = f2bf(v0[i]); tp[(size_t)(32 + i) * SEQ] = f2bf(v1[i]); } }
                else { store8(op, v0); store8(op + 32, v1); } }
    }
};
struct EpiC1 {
    static constexpr bool PERM = true, AFTER_DRAIN = false;
    bf16_t* H; const float* bias;
    __device__ __forceinline__ void operator()(const f32x4 (&acc)[2][2][4][2], const Unit& u, int wr, int wc, int fr_, int fq_) const {
        const int lane_ = opaque_lane(), fr = lane_ & 15, fq = lane_ >> 4;
#pragma unroll
        for (int ai = 0; ai < 2; ++ai)
#pragma unroll
            for (int m = 0; m < 4; ++m) { asm volatile("" ::: "memory"); const int row = EPI_ROWS(ai, m);
#pragma unroll
                for (int bj = 0; bj < 2; ++bj) { const int c0 = bj * 128 + wc * 32 + fq * 8; float v[8];
#pragma unroll
                    for (int i = 0; i < 8; ++i) v[i] = fsilu(acc[ai][bj][m][i >> 2][i & 3] + bias[c0 + i]);
                    store8(H + (size_t)row * 256 + c0, v); } }
    }
};
struct EpiC2 {
    static constexpr bool PERM = true, AFTER_DRAIN = false;
    bf16_t* O; const float* kn; int tr;
    __device__ __forceinline__ void operator()(const f32x4 (&acc)[2][2][4][2], const Unit& u, int wr, int wc, int fr_, int fq_) const {
        const int lane_ = opaque_lane(), fr = lane_ & 15, fq = lane_ >> 4;
        if (wc != 0) return;
#pragma unroll
        for (int ai = 0; ai < 2; ++ai)
#pragma unroll
            for (int m = 0; m < 4; ++m) { asm volatile("" ::: "memory"); const int row = EPI_ROWS(ai, m); float v0[8], v1[8];
#pragma unroll
                for (int i = 0; i < 8; ++i) { v0[i] = acc[ai][0][m][i >> 2][i & 3]; v1[i] = acc[ai][1][m][i >> 2][i & 3]; }
                if (kn) head_norm(v0, v1, kn, fq, lane_);
                if (tr) { bf16_t* tp = O + ((size_t)(row >> 10) * 64 + fq * 8) * 1024 + (row & 1023);
#pragma unroll
                    for (int i = 0; i < 8; ++i) { tp[i * 1024] = f2bf(v0[i]); tp[(32 + i) * 1024] = f2bf(v1[i]); } }
                else { bf16_t* op = O + (size_t)row * 64 + fq * 8; store8(op, v0); store8(op + 32, v1); } }
    }
};
#define RUN_GEMM(EpiT, E, Aptr, Btptr, Mv, Nv, Kv, ldav) do { pg8::Gemm g_{(const bf16_t*)(Aptr), (const bf16_t*)(Btptr), (Mv), (Nv), (Kv), (ldav)}; pg8::StaticOrder S_; int g_x_ = (int)gridDim.x, b_x_ = (int)blockIdx.x; asm volatile("" : "+s"(g_x_), "+s"(b_x_)); S_.init((Mv), (Nv), g_x_, b_x_); \
    pg8::gemm_phase<EpiT, pg8::StaticOrder, true, true>(ldsb, g_, S_, (E), wid_s); } while (0)
#define RUN_GEMM_AT(EpiT, E, Aptr, Btptr, Mv, Nv, Kv, ldav, cshift) do { pg8::Gemm g_{(const bf16_t*)(Aptr), (const bf16_t*)(Btptr), (Mv), (Nv), (Kv), (ldav)}; pg8::StaticOrder S_; int g_x_ = (int)gridDim.x, b_x_ = (int)blockIdx.x - (cshift); asm volatile("" : "+s"(g_x_), "+s"(b_x_)); S_.init((Mv), (Nv), g_x_, b_x_); \
    pg8::gemm_phase<EpiT, pg8::StaticOrder, true, true>(ldsb, g_, S_, (E), wid_s); } while (0)

constexpr int HL_G = 0, HL_ATT = 0, HL_OBUF = 9216, HL_QX = 32768, HL_KX = 50176, HL_KXT = 67584, HL_IT = 86016, HL_ST = 104448, HL_VEC = 139264;
template <bool FULL> __device__ __forceinline__ void phase_hgrn(const bf16_t* HB, bf16_t* OG, float* SLOC, float* DSEG, const float* lbraw, const float* onorm, int layer, LAS unsigned char* ldsb, int wid_s) {
    const int tid = opaque_tid(wid_s), lane = tid & 63, wave = __builtin_amdgcn_readfirstlane(tid >> 6);
    const int t1 = tid >> 3, c0 = (tid & 7) * 16;
    const int k2 = tid & 127, tq = tid >> 7;
    const int fi = lane & 15, fkq = lane >> 4;
    LAS float* Gs = (LAS float*)(ldsb + HL_G); LAS float* vec = (LAS float*)(ldsb + HL_VEC);
    LAS float* eg31 = vec, *e2v = vec + 128, *decv = vec + 256, *lbv = vec + 384, *tot = vec + 512;
    for (int unit = blockIdx.x; unit < 256; unit += gridDim.x) {
        const int b = unit >> 7, h = (unit >> 4) & 7, seg = unit & 15;
        if (tid < 128) { float lb = 0.f; if (layer == 1) lb = 1.0f / (1.0f + __expf(lbraw[h * 128 + tid] - lbraw[1024 + h * 128 + tid])); lbv[tid] = lb; }
        f32x4 S[8];
#pragma unroll
        for (int kt = 0; kt < 8; ++kt) S[kt] = (f32x4){0.f, 0.f, 0.f, 0.f};
        if (FULL) {
            for (int sp = 0; sp < seg; ++sp) { const float* sl = SLOC + (size_t)(unit - seg + sp) * 16384; const float* ds = DSEG + (size_t)(unit - seg + sp) * 128;
#pragma unroll
                for (int kt = 0; kt < 8; ++kt)
#pragma unroll
                    for (int r = 0; r < 4; ++r) { const int k = kt * 16 + fkq * 4 + r; S[kt][r] = ds[k] * S[kt][r] + sl[k * 128 + wave * 16 + fi]; } }
        }
        float lseg = 0.f;
        u32x4 pfa, pfb, pia, pib;
        { const bf16_t* h0 = HB + ((size_t)b * SEQ + seg * 1024 + t1) * 4096 + h * 128 + c0;
          pfa = *(const u32x4*)(h0 + 1024); pfb = *(const u32x4*)(h0 + 1024 + 8); pia = *(const u32x4*)(h0 + 2048); pib = *(const u32x4*)(h0 + 2048 + 8);
        }
        __syncthreads();
#pragma unroll 1
        for (int ch = 0; ch < 16; ++ch) {
            const size_t row0 = (size_t)b * SEQ + seg * 1024 + ch * 64;
            const bf16_t* hrow = HB + (row0 + t1) * 4096 + h * 128 + c0;
            const bf16_t* hnext = hrow + (size_t)64 * 4096; const bool more = (ch + 1 < 16);
            float kk[16];
            { const u32x4 fa = pfa, fb = pfb;
              if (more) { pfa = *(const u32x4*)(hnext + 1024); pfb = *(const u32x4*)(hnext + 1024 + 8); }
              const unsigned fw[8] = {fa.x, fa.y, fa.z, fa.w, fb.x, fb.y, fb.z, fb.w};
              float lg[16];
#pragma unroll
              for (int j = 0; j < 16; ++j) { const float f = fmaxf((j & 1) ? bfhi(fw[j >> 1]) : bflo(fw[j >> 1]), -80.f); const float lb = lbv[c0 + j], om = 1.f - lb;
                  const float e = __expf(-f), sg = __builtin_amdgcn_rcpf(1.f + e); kk[j] = om * (e * sg); lg[j] = __logf(lb + om * sg); }
#pragma unroll
              for (int j = 0; j < 16; j += 4) *(LAS f32x4*)(Gs + t1 * 128 + c0 + j) = (f32x4){lg[j], lg[j + 1], lg[j + 2], lg[j + 3]}; }
            __syncthreads();
            { float loc[16]; float run = 0.f;
#pragma unroll
              for (int j = 0; j < 16; ++j) { run += Gs[(tq * 16 + j) * 128 + k2]; loc[j] = run; }
              tot[tq * 128 + k2] = run;
              __syncthreads();
              float off = 0.f;
#pragma unroll
              for (int q = 0; q < 3; ++q) if (q < tq) off += tot[q * 128 + k2];
#pragma unroll
              for (int j = 0; j < 16; ++j) Gs[(tq * 16 + j) * 128 + k2] = loc[j] + off;
              if (!FULL && tq == 3) lseg += loc[15] + off; }
            __syncthreads();
            { float g31[16], gt[16];
#pragma unroll
              for (int j = 0; j < 16; j += 4) { const f32x4 a = *(LAS const f32x4*)(Gs + 31 * 128 + c0 + j), c = *(LAS const f32x4*)(Gs + t1 * 128 + c0 + j);
                  g31[j] = a.x; g31[j + 1] = a.y; g31[j + 2] = a.z; g31[j + 3] = a.w; gt[j] = c.x; gt[j + 1] = c.y; gt[j + 2] = c.z; gt[j + 3] = c.w; }
              float kx[16];
#pragma unroll
              for (int j = 0; j < 16; ++j) kx[j] = kk[j] * __expf(fminf(g31[j] - gt[j], 80.f));
              LAS bf16_t* kxt = (LAS bf16_t*)(ldsb + HL_KXT);
#pragma unroll
              for (int j = 0; j < 16; ++j) kxt[(c0 + j) * 72 + ((((t1 >> 3) ^ (tid & 7)) << 3) | (t1 & 7))] = f2bf(kx[j]);
              { const u32x4 ia = pia, ib = pib; const unsigned iw[8] = {ia.x, ia.y, ia.z, ia.w, ib.x, ib.y, ib.z, ib.w};
                if (more) { pia = *(const u32x4*)(hnext + 2048); pib = *(const u32x4*)(hnext + 2048 + 8); }
                LAS bf16_t* it = (LAS bf16_t*)(ldsb + HL_IT);
#pragma unroll
                for (int j = 0; j < 16; ++j) it[(c0 + j) * 72 + ((((t1 >> 3) ^ (tid & 7)) << 3) | (t1 & 7))] = (bf16_t)((j & 1) ? (iw[j >> 1] >> 16) : (iw[j >> 1] & 0xffffu)); }
              if (t1 == 0) {
#pragma unroll
                  for (int j = 0; j < 16; ++j) { const float g63 = Gs[63 * 128 + c0 + j]; e2v[c0 + j] = __expf(g63 - g31[j]); decv[c0 + j] = __expf(g63); } }
              if (FULL) {
                  const u32x4 qa = *(const u32x4*)(hrow), qb = *(const u32x4*)(hrow + 8); const unsigned qw[8] = {qa.x, qa.y, qa.z, qa.w, qb.x, qb.y, qb.z, qb.w};
                  float qx[16];
#pragma unroll
                  for (int j = 0; j < 16; ++j) qx[j] = ((j & 1) ? bfhi(qw[j >> 1]) : bflo(qw[j >> 1])) * __expf(fminf(gt[j] - g31[j], 80.f));
                  LAS bf16_t* qxp = (LAS bf16_t*)(ldsb + HL_QX) + t1 * 136 + c0; LAS bf16_t* kxp = (LAS bf16_t*)(ldsb + HL_KX) + t1 * 136 + c0;
                  u32x4 w0, w1;
                  w0.x = cvt_pk_bf16(qx[0], qx[1]); w0.y = cvt_pk_bf16(qx[2], qx[3]); w0.z = cvt_pk_bf16(qx[4], qx[5]); w0.w = cvt_pk_bf16(qx[6], qx[7]);
                  w1.x = cvt_pk_bf16(qx[8], qx[9]); w1.y = cvt_pk_bf16(qx[10], qx[11]); w1.z = cvt_pk_bf16(qx[12], qx[13]); w1.w = cvt_pk_bf16(qx[14], qx[15]);
                  *(LAS u32x4*)qxp = w0; *(LAS u32x4*)(qxp + 8) = w1;
                  w0.x = cvt_pk_bf16(kx[0], kx[1]); w0.y = cvt_pk_bf16(kx[2], kx[3]); w0.z = cvt_pk_bf16(kx[4], kx[5]); w0.w = cvt_pk_bf16(kx[6], kx[7]);
                  w1.x = cvt_pk_bf16(kx[8], kx[9]); w1.y = cvt_pk_bf16(kx[10], kx[11]); w1.z = cvt_pk_bf16(kx[12], kx[13]); w1.w = cvt_pk_bf16(kx[14], kx[15]);
                  *(LAS u32x4*)kxp = w0; *(LAS u32x4*)(kxp + 8) = w1;
                  LAS bf16_t* stp = (LAS bf16_t*)(ldsb + HL_ST) + (wave * 16 + fi) * 136;
#pragma unroll
                  for (int kt = 0; kt < 8; ++kt) { const int k = kt * 16 + fkq * 4; const f32x4 gg = *(LAS const f32x4*)(Gs + 31 * 128 + k);
                      u32x2 w; w.x = cvt_pk_bf16(S[kt][0] * __expf(gg.x), S[kt][1] * __expf(gg.y)); w.y = cvt_pk_bf16(S[kt][2] * __expf(gg.z), S[kt][3] * __expf(gg.w));
                      *(LAS u32x2*)(stp + k) = w; }
              } }
            __syncthreads();
            if (FULL) {
                { const int tt = wave >> 1; LAS bf16_t* att = (LAS bf16_t*)(ldsb + HL_ATT);
                  const LAS bf16_t* qxa = (const LAS bf16_t*)(ldsb + HL_QX) + (tt * 16 + fi) * 136 + fkq * 8;
#pragma unroll
                  for (int u2 = 0; u2 < 2; ++u2) { const int st = 2 * (wave & 1) + u2; f32x4 acc = (f32x4){0.f, 0.f, 0.f, 0.f};
                      if (st <= tt) { const LAS bf16_t* kxb = (const LAS bf16_t*)(ldsb + HL_KX) + (st * 16 + fi) * 136 + fkq * 8;
#pragma unroll
                          for (int ks = 0; ks < 4; ++ks) acc = __builtin_amdgcn_mfma_f32_16x16x32_bf16(*(const LAS bf16x8*)(qxa + ks * 32), *(const LAS bf16x8*)(kxb + ks * 32), acc, 0, 0, 0);
                          if (st == tt) {
#pragma unroll
                              for (int r = 0; r < 4; ++r) if (fi > fkq * 4 + r) acc[r] = 0.f; } }
#pragma unroll
                      for (int r = 0; r < 4; ++r) att[(tt * 16 + fkq * 4 + r) * 72 + st * 16 + fi] = f2bf(acc[r]); } }
                __syncthreads();
                { LAS bf16_t* obuf = (LAS bf16_t*)(ldsb + HL_OBUF);
                  const LAS bf16_t* stb = (const LAS bf16_t*)(ldsb + HL_ST) + (wave * 16 + fi) * 136 + fkq * 8;
                  const LAS bf16_t* itb = (const LAS bf16_t*)(ldsb + HL_IT) + (wave * 16 + fi) * 72;
                  f32x4 oacc[4];
#pragma unroll
                  for (int tt = 0; tt < 4; ++tt) { f32x4 acc = (f32x4){0.f, 0.f, 0.f, 0.f};
                      const LAS bf16_t* qxa = (const LAS bf16_t*)(ldsb + HL_QX) + (tt * 16 + fi) * 136 + fkq * 8;
                      const LAS bf16_t* ata = (const LAS bf16_t*)(ldsb + HL_ATT) + (tt * 16 + fi) * 72 + fkq * 8;
#pragma unroll
                      for (int ks = 0; ks < 4; ++ks) acc = __builtin_amdgcn_mfma_f32_16x16x32_bf16(*(const LAS bf16x8*)(qxa + ks * 32), *(const LAS bf16x8*)(stb + ks * 32), acc, 0, 0, 0);
#pragma unroll
                      for (int ks = 0; ks < 2; ++ks) acc = __builtin_amdgcn_mfma_f32_16x16x32_bf16(*(const LAS bf16x8*)(ata + ks * 32), *(const LAS bf16x8*)(itb + (((ks * 4 + fkq) ^ (wave & 7)) << 3)), acc, 0, 0, 0);
                      oacc[tt] = acc; }
                  __syncthreads();
#pragma unroll
                  for (int tt = 0; tt < 4; ++tt)
#pragma unroll
                      for (int r = 0; r < 4; ++r) obuf[(tt * 16 + fkq * 4 + r) * 136 + wave * 16 + fi] = f2bf(oacc[tt][r]); }
            }
            { const LAS bf16_t* itb = (const LAS bf16_t*)(ldsb + HL_IT) + (wave * 16 + fi) * 72;
#pragma unroll
              for (int kt = 0; kt < 8; ++kt) { f32x4 acc = (f32x4){0.f, 0.f, 0.f, 0.f};
                  const LAS bf16_t* ka = (const LAS bf16_t*)(ldsb + HL_KXT) + (kt * 16 + fi) * 72;
#pragma unroll
                  for (int ks = 0; ks < 2; ++ks) acc = __builtin_amdgcn_mfma_f32_16x16x32_bf16(*(const LAS bf16x8*)(ka + (((ks * 4 + fkq) ^ (kt & 7)) << 3)), *(const LAS bf16x8*)(itb + (((ks * 4 + fkq) ^ (wave & 7)) << 3)), acc, 0, 0, 0);
                  const f32x4 dv = *(LAS const f32x4*)(decv + kt * 16 + fkq * 4), ev = *(LAS const f32x4*)(e2v + kt * 16 + fkq * 4);
                  S[kt] = dv * S[kt] + ev * acc; } }
            __syncthreads();
            if (FULL) {
                const LAS bf16_t* ob = (const LAS bf16_t*)(ldsb + HL_OBUF) + t1 * 136 + c0;
                const u32x4 oa = *(const LAS u32x4*)ob, ob2 = *(const LAS u32x4*)(ob + 8); const unsigned ow[8] = {oa.x, oa.y, oa.z, oa.w, ob2.x, ob2.y, ob2.z, ob2.w};
                const u32x4 ga = *(const u32x4*)(hrow + 3072), gb = *(const u32x4*)(hrow + 3072 + 8); const unsigned gw[8] = {ga.x, ga.y, ga.z, ga.w, gb.x, gb.y, gb.z, gb.w};
                float o[16]; float ss = 0.f;
#pragma unroll
                for (int j = 0; j < 16; ++j) { o[j] = (j & 1) ? bfhi(ow[j >> 1]) : bflo(ow[j >> 1]); ss += o[j] * o[j]; }
                ss += __shfl_xor(ss, 1); ss += __shfl_xor(ss, 2); ss += __shfl_xor(ss, 4);
                const float rs = rsqrtf(ss * (1.0f / 128.0f) + 1e-6f);
                u32x4 w0, w1; float v[16];
#pragma unroll
                for (int j = 0; j < 16; ++j) v[j] = o[j] * rs * onorm[c0 + j] * ((j & 1) ? bfhi(gw[j >> 1]) : bflo(gw[j >> 1]));
                w0.x = cvt_pk_bf16(v[0], v[1]); w0.y = cvt_pk_bf16(v[2], v[3]); w0.z = cvt_pk_bf16(v[4], v[5]); w0.w = cvt_pk_bf16(v[6], v[7]);
                w1.x = cvt_pk_bf16(v[8], v[9]); w1.y = cvt_pk_bf16(v[10], v[11]); w1.z = cvt_pk_bf16(v[12], v[13]); w1.w = cvt_pk_bf16(v[14], v[15]);
                bf16_t* og = OG + (row0 + t1) * DM + h * 128 + c0; *(u32x4*)og = w0; *(u32x4*)(og + 8) = w1;
                __syncthreads();
            }
        }
        if (!FULL) {
            float* sl = SLOC + (size_t)unit * 16384;
#pragma unroll
            for (int kt = 0; kt < 8; ++kt)
#pragma unroll
                for (int r = 0; r < 4; ++r) sl[(kt * 16 + fkq * 4 + r) * 128 + wave * 16 + fi] = S[kt][r];
            if (tq == 3) DSEG[(size_t)unit * 128 + k2] = __expf(lseg);
        }
    }
}

typedef float f32x16 __attribute__((ext_vector_type(16)));
__device__ __forceinline__ void sel_scores(const bf16_t* kp, const bf16x8 (&qf)[4], f32x16 (&S)[2]) {
#pragma unroll
    for (int h = 0; h < 2; ++h) { bf16x8 kf[4];
#pragma unroll
        for (int s = 0; s < 4; ++s) kf[s] = *(const bf16x8*)(kp + h * 2048 + s * 8);
        S[h] = (f32x16){0.f};
#pragma unroll
        for (int s = 0; s < 4; ++s) S[h] = __builtin_amdgcn_mfma_f32_32x32x16_bf16(kf[s], qf[s], S[h], 0, 0, 0); }
}
__device__ __forceinline__ float row_bound(const bf16x8 (&qf)[4], float gmax) {
    float ss = 0.f;
#pragma unroll
    for (int s = 0; s < 4; ++s)
#pragma unroll
        for (int j = 0; j < 8; ++j) { const float v = bf2f((unsigned short)qf[s][j]); ss += v * v; }
    ss += __shfl_xor(ss, 32);
    return sqrtf(ss) * 8.08f * gmax;
}
__device__ __forceinline__ float dpp_quad_sum(float v) {
    v += __int_as_float(__builtin_amdgcn_update_dpp(0, __float_as_int(v), 0xB1, 0xF, 0xF, true));
    v += __int_as_float(__builtin_amdgcn_update_dpp(0, __float_as_int(v), 0x4E, 0xF, 0xF, true));
    return v; }
__device__ __forceinline__ void phase_sel2(PK p, LAS unsigned char* ldsb, int wid_s) {
    const int tid = opaque_tid(wid_s), lane = tid & 63, wave = __builtin_amdgcn_readfirstlane(tid >> 6);
    const bf16_t* Q = (const bf16_t*)(p->ws + WS_Q); const bf16_t* KC = (const bf16_t*)(p->ws + WS_KC); unsigned* SELM = (unsigned*)(p->ws + WS_SELM);
    LAS float* imp = (LAS float*)(ldsb + wave * 8448);
    const int n = lane & 31, hi = lane >> 5, ql = n >> 2, g = n & 3;
    const int pim = (n & ~12) | ((n & 4) << 1) | ((n & 8) >> 1);
    const float gmax0 = wave_max(fabsf(p->in[14][lane]));
    for (int u = blockIdx.x; u < 2048; u += gridDim.x) {
        const int bh = u >> 8, ii = u & 255, qb = (bh & 1) ? 255 - ii : ii, b = bh >> 2, kvh = bh & 3;
        const int tq = qb * 64 + wave * 8 + ql, hd = kvh * 4 + g, row = b * SEQ + tq;
        const int nvq = tq >= 31 ? ((tq - 31) >> 4) + 1 : 0;
        const int tmaxw = qb * 64 + wave * 8 + 7; const int nvmaxw = tmaxw >= 31 ? ((tmaxw - 31) >> 4) + 1 : 0; const int ncb = (nvmaxw + 63) >> 6;
        bf16x8 qf[4];
#pragma unroll
        for (int s = 0; s < 4; ++s) qf[s] = *(const bf16x8*)(Q + (size_t)row * DM + hd * 64 + 32 * hi + 8 * s);
        const bf16_t* kbase = KC + (size_t)bh * 65536 + pim * 64 + 32 * hi;
        for (int i = lane; i < 8 * 264; i += 64) imp[i] = 0.f;
        const float mfix = row_bound(qf, gmax0);
        float l = 0.f;
        for (int blk = 0; blk < ncb; ++blk) { f32x16 S[2]; sel_scores(kbase + (size_t)blk * 4096, qf, S);
            f32x2v ls2 = (f32x2v){0.f, 0.f};
#pragma unroll
            for (int h = 0; h < 2; ++h)
#pragma unroll
                for (int r = 0; r < 16; r += 2) { const int kpos = blk * 64 + 32 * h + 16 * (r >> 3) + 8 * hi + (r & 7);
                    f32x2v pv; pv.x = (kpos < nvq) ? __builtin_amdgcn_exp2f(S[h][r] - mfix) : 0.f; pv.y = (kpos + 1 < nvq) ? __builtin_amdgcn_exp2f(S[h][r + 1] - mfix) : 0.f; ls2 += pv; }
            l += ls2.x + ls2.y; }
        l += __shfl_xor(l, 32);
        const float mfn = l > 0.f ? mfix + log2f(l) : INFINITY;
        for (int blk = 0; blk < ncb; ++blk) { f32x16 S[2]; sel_scores(kbase + (size_t)blk * 4096, qf, S);
#pragma unroll
            for (int h = 0; h < 2; ++h)
#pragma unroll
                for (int rg = 0; rg < 2; ++rg) { float pv[8];
#pragma unroll
                    for (int e = 0; e < 8; ++e) { const int kpos = blk * 64 + 32 * h + 16 * rg + 8 * hi + e; pv[e] = (kpos < nvq) ? __builtin_amdgcn_exp2f(S[h][8 * rg + e] - mfn) : 0.f; }
                    float s0 = (pv[0] + pv[1]) + (pv[2] + pv[3]), s1 = pv[3] + (pv[4] + pv[5]) + (pv[6] + pv[7]), s2 = pv[7];
                    s0 = dpp_quad_sum(s0); s1 = dpp_quad_sum(s1); s2 = dpp_quad_sum(s2);
                    if (g == 0) { const int j0 = (blk * 64 + 32 * h + 16 * rg + 8 * hi) >> 2; LAS float* ip = imp + ql * 264 + j0;
                        atomicAdd((float*)ip, s0); atomicAdd((float*)(ip + 1), s1); atomicAdd((float*)(ip + 2), s2); } } }
        const int cur = qb;
#pragma unroll 1
        for (int q = 0; q < 8; ++q) {
            unsigned bits[4]; bool valid[4], sel[4];
#pragma unroll
            for (int i2 = 0; i2 < 4; ++i2) { const int j = lane + 64 * i2; valid[i2] = j <= cur; const float im = imp[q * 264 + j];
                const bool forced = (j == 0) || (j == cur) || (j == cur - 1);
                bits[i2] = valid[i2] ? __float_as_uint(forced ? 1e9f : im) : 0u; sel[i2] = valid[i2]; }
            if (cur + 1 > 16) {
                unsigned T = 0u;
#define TK_SEARCH(NI2) for (int bit = 30; bit >= 0; --bit) { const unsigned cand = T | (1u << bit); int cnt = 0; \
                    _Pragma("unroll") for (int i2 = 0; i2 < NI2; ++i2) cnt += __popcll(__ballot(bits[i2] >= cand)); \
                    if (cnt >= 16) T = cand; }
                const int ni2 = (cur >> 6) + 1;
                if (ni2 == 1) { TK_SEARCH(1) } else if (ni2 == 2) { TK_SEARCH(2) } else if (ni2 == 3) { TK_SEARCH(3) } else { TK_SEARCH(4) }
#undef TK_SEARCH
                int cgt = 0;
#pragma unroll
                for (int i2 = 0; i2 < 4; ++i2) cgt += __popcll(__ballot(bits[i2] > T));
                int remaining = 16 - cgt;
                const unsigned long long ltmask = (1ull << lane) - 1ull;
#pragma unroll
                for (int i2 = 0; i2 < 4; ++i2) { const bool eq = (bits[i2] == T) && valid[i2]; const unsigned long long ball = __ballot(eq); const int rank = __popcll(ball & ltmask);
                    sel[i2] = valid[i2] && ((bits[i2] > T) || (eq && rank < remaining)); remaining -= min(remaining, (int)__popcll(ball)); }
            }
            const size_t item = (size_t)bh * SEQ + qb * 64 + wave * 8 + q;
#pragma unroll
            for (int i2 = 0; i2 < 4; ++i2) { const unsigned long long ball = __ballot(sel[i2]);
                if (lane == 0) { SELM[item * 8 + 2 * i2] = (unsigned)ball; SELM[item * 8 + 2 * i2 + 1] = (unsigned)(ball >> 32); } }
        }
    }
}

__device__ __forceinline__ void fc_ldk(LAS const unsigned char* tb, int kro, bf16x8 (&kf)[2][4]) {
#pragma unroll
    for (int h = 0; h < 2; ++h)
#pragma unroll
        for (int s = 0; s < 4; ++s) kf[h][s] = *(LAS const bf16x8*)(tb + kro + h * 32 * 144 + s * 16);
}
__device__ __forceinline__ void fc_ldv(LAS const unsigned char* tb, int vro, bf16x8 (&vf)[2][2][2]) {
#pragma unroll
    for (int h = 0; h < 2; ++h)
#pragma unroll
        for (int ks = 0; ks < 2; ++ks)
#pragma unroll
            for (int dh = 0; dh < 2; ++dh) vf[h][ks][dh] = *(LAS const bf16x8*)(tb + vro + dh * 32 * 144 + (h * 32 + ks * 16) * 2);
}
template <int MODE> __device__ __forceinline__ void flash_compute1(LAS const unsigned char* tb, int blk, bool edge, int kro, int vro, bool rowsel, const bf16x8 (&qf)[4], int tq, int nvq, int hi, float mfix, f32x16 (&O)[2], float& l) {
    f32x16 S[2];
    { bf16x8 kf[2][4]; fc_ldk(tb, kro, kf);
#pragma unroll
      for (int h = 0; h < 2; ++h) { S[h] = (f32x16){0.f};
#pragma unroll
          for (int s = 0; s < 4; ++s) S[h] = __builtin_amdgcn_mfma_f32_32x32x16_bf16(kf[h][s], qf[s], S[h], 0, 0, 0); } }
    bf16x8 vf[2][2][2]; fc_ldv(tb, vro, vf);
    if (edge) {
#pragma unroll
        for (int h = 0; h < 2; ++h)
#pragma unroll
            for (int r = 0; r < 16; ++r) { const int kpos = blk * 64 + 32 * h + 16 * (r >> 3) + 8 * hi + (r & 7); bool valid;
                if (MODE == 0) valid = kpos < nvq; else if (MODE == 1) valid = (kpos <= tq); else valid = (kpos <= tq) && (kpos > tq - 512);
                S[h][r] = valid ? S[h][r] : -INFINITY; }
    }
    const float mu = (MODE == 1) ? (rowsel ? mfix : INFINITY) : mfix;
    const f32x2v mu2 = (f32x2v){mu, mu};
    f32x2v ls2 = (f32x2v){0.f, 0.f};
#pragma unroll
    for (int h = 0; h < 2; ++h)
#pragma unroll
        for (int r = 0; r < 16; r += 2) { const f32x2v d = (f32x2v){S[h][r], S[h][r + 1]} - mu2; f32x2v pv; pv.x = __builtin_amdgcn_exp2f(d.x); pv.y = __builtin_amdgcn_exp2f(d.y);
            S[h][r] = pv.x; S[h][r + 1] = pv.y; ls2 += pv; }
    l += ls2.x + ls2.y;
#pragma unroll
    for (int h = 0; h < 2; ++h)
#pragma unroll
        for (int ks = 0; ks < 2; ++ks) { u32x4 w; w.x = cvt_pk_bf16(S[h][8 * ks], S[h][8 * ks + 1]); w.y = cvt_pk_bf16(S[h][8 * ks + 2], S[h][8 * ks + 3]); w.z = cvt_pk_bf16(S[h][8 * ks + 4], S[h][8 * ks + 5]); w.w = cvt_pk_bf16(S[h][8 * ks + 6], S[h][8 * ks + 7]);
            const bf16x8 pf = __builtin_bit_cast(bf16x8, w);
#pragma unroll
            for (int dh = 0; dh < 2; ++dh) O[dh] = __builtin_amdgcn_mfma_f32_32x32x16_bf16(vf[h][ks][dh], pf, O[dh], 0, 0, 0); }
}
constexpr int AL_KV = 0, AL_SLOT = 18432, AL_WU = 55296  , AL_WAVE = 55808  , AL_ACC = 68096  ;
template <int MODE> __device__ __forceinline__ void flash_blocks(const bf16_t* Kb, const bf16_t* Vt, int ldv, int base, int nblk, LAS const int* list, LAS const unsigned* qm, LAS const unsigned* wun,
                                                                LAS unsigned char* ldsb, int tid, const bf16x8 (&qf)[4], int tq, int nvq, int qb, int wave, int ql, int lane, float mfix, f32x16 (&O)[2], float& l) {
    const int m_ = lane & 31, hi = lane >> 5;
    const int pim = (m_ & ~12) | ((m_ & 4) << 1) | ((m_ & 8) >> 1);
    const int kro = pim * 144 + 64 * hi;
    const int vro = 9216 + m_ * 144 + 16 * hi;
    const int srow = tid >> 3, sch = tid & 7;
    const bf16_t* kg = Kb + (size_t)tid * 8;
    const bf16_t* vg = Vt + (size_t)srow * ldv + sch * 8;
    const int sdst = srow * 144 + sch * 16;
    const int tminw = qb * 64 + wave * 8, tmaxw = tminw + 7;
    const int nvminw = tminw >= 31 ? ((tminw - 31) >> 4) + 1 : 0, nvmaxw = tmaxw >= 31 ? ((tmaxw - 31) >> 4) + 1 : 0;
#define FB_BLK(i) ((MODE == 1) ? list[(i)] : base + (i))
    u32x4 ra[3], rb[3];
#pragma unroll
    for (int k = 0; k < 3; ++k) { ra[k] = (u32x4){0u, 0u, 0u, 0u}; rb[k] = ra[k]; if (k < nblk) { const int nb = FB_BLK(k); ra[k] = *(const u32x4*)(kg + (size_t)nb * 4096); rb[k] = *(const u32x4*)(vg + (size_t)nb * 64); } }
    for (int i0 = 0; i0 < nblk; i0 += 3) {
        __syncthreads();
#pragma unroll
        for (int k = 0; k < 3; ++k) if (i0 + k < nblk) { LAS unsigned char* sl = ldsb + AL_KV + k * AL_SLOT; *(LAS u32x4*)(sl + sdst) = ra[k]; *(LAS u32x4*)(sl + 9216 + sdst) = rb[k]; }
        __syncthreads();
#pragma unroll
        for (int k = 0; k < 3; ++k) if (i0 + 3 + k < nblk) { const int nb = FB_BLK(i0 + 3 + k); ra[k] = *(const u32x4*)(kg + (size_t)nb * 4096); rb[k] = *(const u32x4*)(vg + (size_t)nb * 64); }
#pragma unroll 1
        for (int k = 0; k < 3; ++k) { if (i0 + k >= nblk) break;
            const int blk = FB_BLK(i0 + k); bool need = true, edge;
            if (MODE == 0) { need = blk * 64 < nvmaxw; edge = !(blk * 64 + 63 < nvminw); }
            else if (MODE == 1) { need = (wun[blk >> 5] >> (blk & 31)) & 1u; edge = (blk == qb); }
            else edge = (blk == qb) || (blk == qb - 8);
            if (need) { bool rs = true; if (MODE == 1) rs = (qm[ql * 8 + (blk >> 5)] >> (blk & 31)) & 1u;
                flash_compute1<MODE>(ldsb + AL_KV + k * AL_SLOT, blk, edge, kro, vro, rs, qf, tq, nvq, hi, mfix, O, l); } }
    }
#undef FB_BLK
}
__device__ __forceinline__ void phase_att(PK p, LAS unsigned char* ldsb, int wid_s) {
    const int tid = opaque_tid(wid_s), lane = tid & 63, wave = __builtin_amdgcn_readfirstlane(tid >> 6);
    const bf16_t* Q = (const bf16_t*)(p->ws + WS_Q); const bf16_t* QR = (const bf16_t*)(p->ws + WS_QR); bf16_t* AO = (bf16_t*)(p->ws + WS_AO);
    const float* GATES = (const float*)(p->ws + WS_GATES); const unsigned* SELM = (const unsigned*)(p->ws + WS_SELM);
    const bf16_t* KC = (const bf16_t*)(p->ws + WS_KC); const bf16_t* VCt = (const bf16_t*)(p->ws + WS_VC);
    const bf16_t* KS = (const bf16_t*)(p->ws + WS_KV + 32 * MiB); const bf16_t* VSt = (const bf16_t*)(p->ws + WS_KV + 48 * MiB);
    const bf16_t* KW = (const bf16_t*)(p->ws + WS_KV + 64 * MiB); const bf16_t* VWt = (const bf16_t*)(p->ws + WS_KV + 80 * MiB);
    LAS unsigned* wu = (LAS unsigned*)(ldsb + AL_WU);
    LAS unsigned* qm = (LAS unsigned*)(ldsb + AL_WAVE + wave * 1536); LAS unsigned* wun = qm + 64; LAS int* list = (LAS int*)(qm + 128);
    const int n = lane & 31, hi = lane >> 5, ql = n >> 2, g = n & 3;
    const float* kn_ = p->in[14];
    const float gmax0 = wave_max(fabsf(kn_[lane])), gmax12 = wave_max(fmaxf(fabsf(kn_[64 + lane]), fabsf(kn_[128 + lane])));
    for (int u = blockIdx.x; u < 2048; u += gridDim.x) {
        const int bh = u >> 8, ii = u & 255, qb = (bh & 1) ? 255 - ii : ii, b = bh >> 2, kvh = bh & 3;
        const int tq = qb * 64 + wave * 8 + ql, hd = kvh * 4 + g, row = b * SEQ + tq;
        const int nvq = tq >= 31 ? ((tq - 31) >> 4) + 1 : 0;
        const int tmaxw = qb * 64 + wave * 8 + 7; const int nvmaxw = tmaxw >= 31 ? ((tmaxw - 31) >> 4) + 1 : 0;
        { const unsigned mw = SELM[((size_t)bh * SEQ + qb * 64 + wave * 8 + (lane >> 3)) * 8 + (lane & 7)];
          qm[lane] = mw;
          unsigned uw = mw; uw |= __shfl_xor(uw, 8); uw |= __shfl_xor(uw, 16); uw |= __shfl_xor(uw, 32);
          if (lane < 8) { wun[lane] = uw; wu[wave * 8 + lane] = uw; } }
        __syncthreads();
        int nsel = 0;
        { unsigned bu = 0u;
#pragma unroll
          for (int w2 = 0; w2 < 8; ++w2) bu |= wu[w2 * 8 + (lane & 7)];
          const int cnt = __popc(bu); int pre = 0;
#pragma unroll
          for (int w2 = 0; w2 < 8; ++w2) { const int c2 = __shfl(cnt, w2); if (w2 < (lane & 7)) pre += c2; nsel += c2; }
          if (lane < 8) { unsigned ww = bu; int k = pre; while (ww) { const int bpos = __ffs(ww) - 1; list[k++] = lane * 32 + bpos; ww &= ww - 1; } } }
        nsel = __builtin_amdgcn_readfirstlane(nsel);
        float gate[3];
#pragma unroll
        for (int br = 0; br < 3; ++br) gate[br] = GATES[(size_t)row * 48 + br * 16 + hd];
        LAS float* oacc = (LAS float*)(ldsb + AL_ACC + wave * 8192) + lane;
        bf16x8 qf[4];
#pragma unroll
        for (int s = 0; s < 4; ++s) qf[s] = *(const bf16x8*)(Q + (size_t)row * DM + hd * 64 + 32 * hi + 8 * s);
        float mfix = row_bound(qf, gmax0);
        { f32x16 O[2]; O[0] = (f32x16){0.f}; O[1] = (f32x16){0.f}; float l = 0.f;
          const int tmax = qb * 64 + 63; const int nvmax = ((tmax - 31) >> 4) + 1; const int ncb = (nvmax + 63) >> 6;
          flash_blocks<0>(KC + (size_t)bh * 65536, VCt + (size_t)bh * 65536, 1024, 0, ncb, list, qm, wun, ldsb, tid, qf, tq, nvq, qb, wave, ql, lane, mfix, O, l);
          l += __shfl_xor(l, 32); const float sc = l > 0.f ? gate[0] / l : 0.f;
#pragma unroll
          for (int dh = 0; dh < 2; ++dh)
#pragma unroll
              for (int r = 0; r < 16; ++r) oacc[(dh * 16 + r) * 64] = O[dh][r] * sc; }
#pragma unroll
        for (int s = 0; s < 4; ++s) qf[s] = *(const bf16x8*)(QR + (size_t)row * DM + hd * 64 + 32 * hi + 8 * s);
        mfix = row_bound(qf, gmax12);
        { f32x16 O[2]; O[0] = (f32x16){0.f}; O[1] = (f32x16){0.f}; float l = 0.f;
          flash_blocks<1>(KS + (size_t)bh * SEQ * 64, VSt + (size_t)bh * SEQ * 64, SEQ, 0, nsel, list, qm, wun, ldsb, tid, qf, tq, nvq, qb, wave, ql, lane, mfix, O, l);
          l += __shfl_xor(l, 32); const float sc = l > 0.f ? gate[1] / l : 0.f;
#pragma unroll
          for (int dh = 0; dh < 2; ++dh)
#pragma unroll
              for (int r = 0; r < 16; ++r) oacc[(dh * 16 + r) * 64] += O[dh][r] * sc; }
        { f32x16 O[2]; O[0] = (f32x16){0.f}; O[1] = (f32x16){0.f}; float l = 0.f;
          const int b0 = max(0, qb - 8);
          flash_blocks<2>(KW + (size_t)bh * SEQ * 64, VWt + (size_t)bh * SEQ * 64, SEQ, b0, qb - b0 + 1, list, qm, wun, ldsb, tid, qf, tq, nvq, qb, wave, ql, lane, mfix, O, l);
          l += __shfl_xor(l, 32); const float sc = l > 0.f ? gate[2] / l : 0.f;
          bf16_t* op = AO + (size_t)row * DM + hd * 64 + 4 * hi;
#pragma unroll
          for (int dh = 0; dh < 2; ++dh)
#pragma unroll
              for (int rq = 0; rq < 4; ++rq) { float v[4];
#pragma unroll
                  for (int e = 0; e < 4; ++e) v[e] = oacc[(dh * 16 + rq * 4 + e) * 64] + O[dh][rq * 4 + e] * sc;
                  u32x2 w; w.x = cvt_pk_bf16(v[0], v[1]); w.y = cvt_pk_bf16(v[2], v[3]); *(u32x2*)(op + 32 * dh + 8 * rq) = w; } }
    }
}

#define XB_TMO      128
#define XB_XCNT(j)  (256  + 64 * (j))
#define XB_XSUB(j)  (1280 + 64 * (j))
#define XB_XGEN(j)  (2304 + 64 * (j))
#define XB_TOP      3328
#define XB_TOPGEN   3392
#define XCD_BAR_WORDS 3456
#define XB_SPIN_CAP (1u << 18)

__device__ __forceinline__ unsigned xb_ld(unsigned* p)              { return __hip_atomic_load(p, __ATOMIC_RELAXED, __HIP_MEMORY_SCOPE_AGENT); }
__device__ __forceinline__ unsigned xb_add(unsigned* p, unsigned v) { return __hip_atomic_fetch_add(p, v, __ATOMIC_RELAXED, __HIP_MEMORY_SCOPE_AGENT); }
__device__ __forceinline__ unsigned xb_xcc_id() { return (unsigned)__builtin_amdgcn_s_getreg((3 << 11) | 20) & 0xFu; }
#define XB_SPIN(cond, bar) do { unsigned _sp = 0; while (cond) { __builtin_amdgcn_s_sleep(1); \
    if ((++_sp & 255u) == 0u) { if (xb_ld(&(bar)[XB_TMO])) break; if (_sp > XB_SPIN_CAP) { atomicAdd(&(bar)[XB_TMO], 1u); break; } } } } while (0)

struct XcdBarrier {
    unsigned* bar; unsigned x;
    volatile LAS unsigned* st;
};

__device__ __forceinline__ XcdBarrier xcd_barrier_post(unsigned* bar, volatile LAS unsigned* st, bool is0) {
    XcdBarrier b; b.bar = bar; b.x = xb_xcc_id(); b.st = st;
    if (is0) (void)xb_add(&bar[XB_XCNT(b.x)], 1u);
    return b;
}
__device__ __forceinline__ void xcd_barrier_complete(unsigned* bar, unsigned x, unsigned& nloc, unsigned& nx) {
    const unsigned G = gridDim.x * gridDim.y * gridDim.z;
    unsigned sum, cnt, mine, sp = 0u;
    for (;;) {
        sum = 0u; cnt = 0u; mine = 0u;
#pragma unroll
        for (unsigned j = 0; j < 16; ++j) { const unsigned c = xb_ld(&bar[XB_XCNT(j)]); sum += c; cnt += (c > 0u) ? 1u : 0u; mine = (j == x) ? c : mine; }
        if (sum == G) break;
        __builtin_amdgcn_s_sleep(1);
        if ((++sp & 255u) == 0u) { if (xb_ld(&bar[XB_TMO])) break; if (sp > XB_SPIN_CAP) { atomicAdd(&bar[XB_TMO], 1u); break; } }
    }
    nloc = mine > 0u ? mine : 1u; nx = cnt > 0u ? cnt : 1u;
}

__device__ __attribute__((noinline)) void xcd_barrier(const XcdBarrier b, bool is0) {
    asm volatile("s_waitcnt vmcnt(0)" ::: "memory");
    __syncthreads();
    if (is0) {
        unsigned* bar = b.bar;
        __builtin_amdgcn_s_waitcnt(0);
        unsigned nloc = b.st[0], nx = b.st[1];
        if (nloc == 0u) { xcd_barrier_complete(bar, b.x, nloc, nx); b.st[0] = nloc; b.st[1] = nx; }
        const unsigned old = xb_add(&bar[XB_XSUB(b.x)], 1u);
        const unsigned gen = old / nloc;
        if (old + 1u == (gen + 1u) * nloc) {
            __builtin_amdgcn_fence(__ATOMIC_RELEASE, "agent");
            asm volatile("s_waitcnt vmcnt(0)" ::: "memory");
            const unsigned og = xb_add(&bar[XB_TOP], 1u);
            const unsigned tg = og / nx;
            if (og + 1u == (tg + 1u) * nx) xb_add(&bar[XB_TOPGEN], 1u);
            else XB_SPIN(xb_ld(&bar[XB_TOPGEN]) == tg, bar);
            __builtin_amdgcn_fence(__ATOMIC_ACQUIRE, "agent");
            xb_add(&bar[XB_XGEN(b.x)], 1u);
            asm volatile("s_waitcnt vmcnt(0)" ::: "memory");
        } else {
            XB_SPIN(xb_ld(&bar[XB_XGEN(b.x)]) == gen, bar);
            __builtin_amdgcn_fence(__ATOMIC_ACQUIRE, "agent");
            asm volatile("s_waitcnt vmcnt(0)" ::: "memory");
        }
    }
    __syncthreads();
}

__global__ void __launch_bounds__(NTHR, 2) yoco_fwd(Params p_unused) {
    extern __shared__ __attribute__((aligned(16))) unsigned char lds_raw[];
    LAS unsigned char* ldsb = (LAS unsigned char*)lds_raw;
    cg::grid_group grid = cg::this_grid();
    const int wid_s = __builtin_amdgcn_readfirstlane((int)threadIdx.x >> 6);
    volatile LAS unsigned* bst = (volatile LAS unsigned*)(ldsb + LDS_BYTES - 16);
    { const int t0_ = opaque_tid(wid_s); if (t0_ == 0) { bst[0] = 0u; bst[1] = 0u; } __syncthreads(); }
    XcdBarrier xbar; { PK pk = fresh_pk(); xbar = xcd_barrier_post((unsigned*)(pk->ws + WS_BAR), bst, opaque_tid(wid_s) == 0); }
#define GSYNC() xcd_barrier(xbar, opaque_tid(wid_s) == 0)
#define FRESH() PK pk = fresh_pk(); unsigned char* ws = pk->ws; float* mods = (float*)(ws + WS_MODS); float* SS = (float*)(ws + WS_SS); const float* BIAS = (const float*)(ws + WS_BIAS); \
    const f32x2v* cs = (const f32x2v*)(ws + WS_CS); bf16_t* XB = (bf16_t*)(ws + WS_XB); bf16_t* XB2 = (bf16_t*)(ws + WS_XB2); bf16_t* HB = (bf16_t*)(ws + WS_HB); bf16_t* OB = (bf16_t*)(ws + WS_OB); bf16_t* HID = (bf16_t*)(ws + WS_HID); \
    float* xout = pk->out; (void)mods; (void)SS; (void)BIAS; (void)cs; (void)XB; (void)XB2; (void)HB; (void)OB; (void)HID; (void)xout;

    { PK pk = fresh_pk(); phase0(pk, ldsb, wid_s); }
    GSYNC();
    if (fresh_pk()->out == nullptr) grid.sync();
    { PK pk = fresh_pk(); phase1(pk, ldsb, wid_s); }
    GSYNC();

#pragma unroll 1
    for (int layer = 0; layer < 4; ++layer) {
        if (layer < 2) {
            { FRESH(); EpiHin E{HB, SS + (size_t)(2 * layer) * MR, BIAS + BO_HIN + layer * 8192};
              RUN_GEMM(EpiHin, E, XB, ws + WS_WHIN + (size_t)layer * 4096 * 1024 * 2, MR, 4096, 1024, 1024); }
            GSYNC();
            { FRESH(); phase_hgrn<false>(HB, OB, (float*)(ws + WS_SLOC), (float*)(ws + WS_DSEG), pk->in[7], pk->in[8] + layer * 128, layer, ldsb, wid_s); }
            GSYNC();
            { FRESH(); phase_hgrn<true>(HB, OB, (float*)(ws + WS_SLOC), (float*)(ws + WS_DSEG), pk->in[7], pk->in[8] + layer * 128, layer, ldsb, wid_s); }
            GSYNC();
            { FRESH(); const float* xold = (layer == 0) ? pk->in[0] : xout;
              EpiRes<false> E{xold, xout, mods + (2 * layer) * 6144 + 2048, SS + (size_t)(2 * layer + 1) * MR, XB, BIAS + BO_GM + (2 * layer + 1) * 2048, nullptr, nullptr};
              RUN_GEMM(EpiRes<false>, E, OB, ws + WS_WHOUT + (size_t)layer * 1024 * 1024 * 2, MR, 1024, 1024, 1024); }
            GSYNC();
        } else {
            const int bl = layer - 2;
            if (bl == 0) {
                { FRESH(); EpiKV E{(bf16_t*)(ws + WS_KV), SS + (size_t)4 * MR, BIAS + BO_KV, pk->in[14], cs};
                  RUN_GEMM(EpiKV, E, XB2, ws + WS_WKV, MR, 1536, 1024, 1024); }
            }
            { FRESH(); EpiQ E{(bf16_t*)(ws + WS_Q), (bf16_t*)(ws + WS_QR), (float*)(ws + WS_GATES), SS + (size_t)(2 * layer) * MR, BIAS + BO_Q + bl * 2560, pk->in[19] + bl * 64, cs};
              RUN_GEMM(EpiQ, E, XB, ws + WS_WQ + (size_t)bl * 1280 * 1024 * 2, MR, 1280, 1024, 1024); }
            GSYNC();
            if (bl == 0) {
#pragma unroll 1
                for (int j = 0; j < 2; ++j) { FRESH(); EpiC1 E{(bf16_t*)(ws + WS_CHID) + (size_t)j * 8192 * 256, BIAS + BO_C1 + j * 256};
                    RUN_GEMM_AT(EpiC1, E, ws + WS_KV + (size_t)j * 16 * MiB, ws + WS_WC1 + (size_t)j * 256 * 2048 * 2, 8192, 256, 2048, 1024, (gridDim.x >= 64) ? 32 * j : 0); }
                GSYNC();
#pragma unroll 1
                for (int j = 0; j < 2; ++j) { FRESH(); EpiC2 E{(bf16_t*)(ws + (j == 0 ? WS_KC : WS_VC)), j == 0 ? pk->in[14] : nullptr, j};
                    RUN_GEMM_AT(EpiC2, E, ws + WS_CHID + (size_t)j * 8192 * 256 * 2, ws + WS_WC2 + (size_t)j * 256 * 256 * 2, 8192, 256, 256, 256, (gridDim.x >= 64) ? 32 * j : 0); }
                GSYNC();
            }
            { PK pk = fresh_pk(); phase_sel2(pk, ldsb, wid_s); }
            GSYNC();
            { PK pk = fresh_pk(); phase_att(pk, ldsb, wid_s); }
            GSYNC();
            { FRESH(); EpiRes<false> E{xout, xout, mods + (2 * layer) * 6144 + 2048, SS + (size_t)(2 * layer + 1) * MR, XB, BIAS + BO_GM + (2 * layer + 1) * 2048, nullptr, nullptr};
              RUN_GEMM(EpiRes<false>, E, ws + WS_AO, ws + WS_WAO + (size_t)bl * 1024 * 1024 * 2, MR, 1024, 1024, 1024); }
            GSYNC();
        }
        { FRESH(); EpiFin E{HID, SS + (size_t)(2 * layer + 1) * MR, BIAS + BO_FIN + layer * 11264};
          RUN_GEMM(EpiFin, E, XB, ws + WS_WFIN + (size_t)layer * 5632 * 1024 * 2, MR, 5632, 1024, 1024); }
        GSYNC();
        { FRESH(); const bool last = (layer == 3);
          float* sso = last ? SS : SS + (size_t)(2 * layer + 2) * MR; const float* gmn = BIAS + BO_GM + (last ? 0 : (2 * layer + 2) * 2048);
          const bf16_t* Wt = (const bf16_t*)(ws + WS_WFOUT + (size_t)layer * 1024 * 2816 * 2);
          if (layer == 1) { EpiRes<true> E{xout, xout, mods + (2 * layer + 1) * 6144 + 2048, sso, XB, gmn, XB2, BIAS + BO_GM + 8 * 2048};
              RUN_GEMM(EpiRes<true>, E, HID, Wt, MR, 1024, 2816, 2816); }
          else { EpiRes<false> E{xout, xout, mods + (2 * layer + 1) * 6144 + 2048, sso, XB, gmn, nullptr, nullptr};
              RUN_GEMM(EpiRes<false>, E, HID, Wt, MR, 1024, 2816, 2816); } }
        if (layer < 3) GSYNC();
    }
}

extern "C" void kernel_launch(void* const* d_in, const int* in_sizes, int n_in, void* d_out, int out_size, void* d_ws, size_t ws_size, hipStream_t stream) {
    static int grid = 0;
    if (grid == 0) {
        if (n_in != 23 || out_size != MR * DM || ws_size < WS_END) { fprintf(stderr, "kernel_launch: unexpected problem (n_in %d out %d ws %zu)\n", n_in, out_size, ws_size); grid = -1; return; }
        int dev = 0, cus = 0, per_cu = 0;
        hipGetDevice(&dev); hipDeviceGetAttribute(&cus, hipDeviceAttributeMultiprocessorCount, dev);
        hipFuncSetAttribute((const void*)yoco_fwd, hipFuncAttributeMaxDynamicSharedMemorySize, LDS_BYTES);
        hipOccupancyMaxActiveBlocksPerMultiprocessor(&per_cu, (const void*)yoco_fwd, NTHR, LDS_BYTES);
        if (per_cu < 1) per_cu = 1;
        grid = cus * per_cu;
        fprintf(stderr, "kernel_launch: grid %d (cus %d x %d)\n", grid, cus, per_cu);
    }
    if (grid < 0) return;
    (void)hipMemsetAsync((char*)d_ws + WS_BAR, 0, 16384, stream);
    Params p{};
    for (int i = 0; i < 23; ++i) p.in[i] = (const float*)d_in[i];
    p.out = (float*)d_out; p.ws = (unsigned char*)d_ws;
    void* args[] = {&p};
    hipError_t e = hipLaunchCooperativeKernel((const void*)yoco_fwd, dim3(grid), dim3(NTHR), args, LDS_BYTES, stream);
    if (e != hipSuccess) fprintf(stderr, "cooperative launch failed: %s (grid %d)\n", hipGetErrorString(e), grid);
}
```

```cpp
#include <hip/hip_runtime.h>
#include <hip/hip_cooperative_groups.h>
#include <cstdio>
#include <cstdint>
namespace cg = cooperative_groups;
__device__ __forceinline__ int opaque_tid(int wid) { int l; asm volatile("v_mbcnt_lo_u32_b32 %0, -1, 0\n\tv_mbcnt_hi_u32_b32 %0, -1, %0" : "=v"(l)); int w = wid; asm volatile("" : "+s"(w)); return (w << 6) | l; }
namespace pg8 {
#define PG8_LAS __attribute__((address_space(3)))
typedef unsigned short bf16_t;
typedef short bf16x8 __attribute__((ext_vector_type(8)));
typedef float f32x4 __attribute__((ext_vector_type(4)));
typedef unsigned u32x4 __attribute__((ext_vector_type(4)));
constexpr int BM = 256, BK = 64, HALF = 128, HTB = HALF * BK * 2  , STAGE_BYTES = 8 * HTB, NXCD = 8, WGM = 8;

__host__ __device__ __forceinline__ int lds_byte(int r, int c) { const int st = (r >> 4) * 2 + (c >> 5), rr = r & 15, cc = c & 31, ob = rr * 64 + cc * 2; return st * 1024 + (ob ^ (((ob >> 9) & 1) << 5)); }
__host__ __device__ __forceinline__ void stage_rc(int b, int& R, int& C) { const int st = b / 1024, sb = b % 1024, swz = sb ^ (((sb >> 9) & 1) << 5); R = (st >> 1) * 16 + swz / 64; C = (st & 1) * 32 + (swz % 64) / 2; }
__host__ __device__ __forceinline__ int perm32(int rho) { const int n = rho >> 4, i = rho & 15; return 8 * (i >> 2) + 4 * n + (i & 3); }

struct Unit { int pm, pn; };
struct Gemm { const bf16_t* A; const bf16_t* Bt; int M, N, K, lda; };

struct StaticOrder {
    int nM, nN, nwg, G, c;
    __host__ __device__ void init(int M, int N, int G_, int c_) { nM = M / BM; nN = N / BM; nwg = nM * nN; G = G_; c = c_; }
    __host__ __device__ bool next(int i, Unit& u) const {
        const long L = (long)i * G + c; if (c < 0 || L >= nwg) return false;
        int wgid = (int)L; { const int q = nwg / NXCD, r = nwg % NXCD, xcd = wgid % NXCD, off = wgid / NXCD; wgid = (xcd < r ? xcd * (q + 1) : r * (q + 1) + (xcd - r) * q) + off; }
        const int nig = WGM * nN, gid = wgid / nig, fm = gid * WGM, gsz = (nM - fm) < WGM ? (nM - fm) : WGM;
        u.pm = fm + ((wgid % nig) % gsz); u.pn = (wgid % nig) / gsz; return true;
    }
    __device__ __forceinline__ void a_ready(const Unit&) const {}
    __device__ __forceinline__ void done(const Unit&) const {}
};

typedef float f32x2c __attribute__((ext_vector_type(2))); typedef __bf16 bf16x2c __attribute__((ext_vector_type(2)));
__device__ __forceinline__ unsigned cvt_pk_bf16(float lo, float hi) { f32x2c v = {lo, hi}; bf16x2c b = __builtin_convertvector(v, bf16x2c); return __builtin_bit_cast(unsigned, b); }
typedef float f32x2 __attribute__((ext_vector_type(2)));
template <class Epi, class Sched, bool ALIGN_EPI = false, bool SP2 = false>
__device__ __forceinline__ void gemm_phase(PG8_LAS unsigned char* lds, const Gemm g, const Sched& S, const Epi& E, int wid_) {
    const int tid = opaque_tid(wid_), wid = __builtin_amdgcn_readfirstlane(tid >> 6), lane = tid & 63, wr = wid >> 2, wc = wid & 3, fr = lane & 15, fq = lane >> 4;
    const int K = g.K, nt = K / BK;
    unsigned voffA, voffB;
    { int R, C; stage_rc(tid * 16, R, C); const int Rb = Epi::PERM ? ((R & ~31) + perm32(R & 31)) : R;
      voffA = (unsigned)(R * g.lda + C) * 2u; voffB = (unsigned)(Rb * K + C) * 2u; }
    const size_t stepA = (size_t)64 * g.lda * 2, stepB = (size_t)64 * K * 2;
    const size_t kstep = (size_t)(BK * 2);
    const size_t hstepA = (size_t)HALF * g.lda * 2, hstepB = (size_t)HALF * K * 2;
    const size_t tstepA = 2 * hstepA, tstepB = 2 * hstepB;
    const unsigned ldsw = (unsigned)wid * 1024u;
    const int aoff = lds_byte(wr * 64 + fr, fq * 8), boff = lds_byte(wc * 32 + fr, fq * 8);
#define PG8_SA(b, h) (((b) * 2 + (h)) * HTB)
#define PG8_SB(b, h) ((4 + (b) * 2 + (h)) * HTB)
#define PG8_STAGE(bufoff, gbase, voff, rstep) do { _Pragma("unroll") for (int _i = 0; _i < 2; ++_i) \
        __builtin_amdgcn_global_load_lds((const unsigned*)((const char*)(gbase) + (size_t)_i * (rstep) + (voff)), (PG8_LAS unsigned*)(lds + (bufoff) + ldsw + _i * 8192), 16, 0, 0); } while (0)
#define PG8_LDA(dst, b, h) do { _Pragma("unroll") for (int m = 0; m < 4; ++m) _Pragma("unroll") for (int k = 0; k < 2; ++k) dst[m][k] = *(const PG8_LAS bf16x8*)(lds + PG8_SA(b, h) + aoff + m * 2048 + k * 1024); } while (0)
#define PG8_LDB(dst, b, h) do { _Pragma("unroll") for (int n = 0; n < 2; ++n) _Pragma("unroll") for (int k = 0; k < 2; ++k) dst[n][k] = *(const PG8_LAS bf16x8*)(lds + PG8_SB(b, h) + boff + n * 2048 + k * 1024); } while (0)
#define PG8_MMA(ai, bj, At, Bt) do { __builtin_amdgcn_s_setprio(1); _Pragma("unroll") for (int m = 0; m < 4; ++m) _Pragma("unroll") for (int n = 0; n < 2; ++n) _Pragma("unroll") for (int k = 0; k < 2; ++k) \
        acc[ai][bj][m][n] = __builtin_amdgcn_mfma_f32_16x16x32_bf16(Bt[n][k], At[m][k], acc[ai][bj][m][n], 0, 0, 0); __builtin_amdgcn_s_setprio(0); } while (0)
#define PG8_WAIT_V(n) asm volatile("s_waitcnt vmcnt(" #n ")" ::: "memory")
#define PG8_WAIT_L(n) asm volatile("s_waitcnt lgkmcnt(" #n ")" ::: "memory")
#define PG8_BAR __builtin_amdgcn_s_barrier()
#define PG8_SCHED __builtin_amdgcn_sched_barrier(0)
    Unit cur, nxt; int ui = 0;
    if (!S.next(0, cur)) return;
    f32x4 acc[2][2][4][2];
#pragma unroll
    for (int a = 0; a < 2; ++a)
#pragma unroll
        for (int b = 0; b < 2; ++b)
#pragma unroll
            for (int m = 0; m < 4; ++m)
#pragma unroll
                for (int n = 0; n < 2; ++n) acc[a][b][m][n] = (f32x4){0.f, 0.f, 0.f, 0.f};
    bf16x8 At[4][2], B0[2][2], B1[2][2];
    const char* cA = (const char*)g.A + (size_t)cur.pm * tstepA; const char* cB = (const char*)g.Bt + (size_t)cur.pn * tstepB;
    S.a_ready(cur);
    if constexpr (SP2) {
        PG8_STAGE(PG8_SB(0, 0), cB, voffB, stepB); PG8_STAGE(PG8_SB(0, 1), cB + hstepB, voffB, stepB); PG8_STAGE(PG8_SA(0, 0), cA, voffA, stepA); PG8_STAGE(PG8_SA(0, 1), cA + hstepA, voffA, stepA);
        if (wr == 1) PG8_BAR;
        PG8_WAIT_V(2); PG8_BAR;
        PG8_STAGE(PG8_SB(1, 0), cB + kstep, voffB, stepB); PG8_STAGE(PG8_SA(1, 0), cA + kstep, voffA, stepA); PG8_STAGE(PG8_SB(1, 1), cB + hstepB + kstep, voffB, stepB);
        PG8_WAIT_V(6); PG8_BAR;
    } else {
        PG8_STAGE(PG8_SB(0, 0), cB, voffB, stepB); PG8_STAGE(PG8_SA(0, 0), cA, voffA, stepA); PG8_STAGE(PG8_SB(0, 1), cB + hstepB, voffB, stepB); PG8_STAGE(PG8_SA(0, 1), cA + hstepA, voffA, stepA);
        if (wr == 1) PG8_BAR;
        PG8_WAIT_V(4); PG8_BAR;
        PG8_STAGE(PG8_SB(1, 0), cB + kstep, voffB, stepB); PG8_STAGE(PG8_SA(1, 0), cA + kstep, voffA, stepA); PG8_STAGE(PG8_SB(1, 1), cB + hstepB + kstep, voffB, stepB);
        PG8_WAIT_V(6); PG8_BAR;
    }
    for (;;) {
        const bool has_next = S.next(ui + 1, nxt);
        const char* nA = has_next ? (const char*)g.A + (size_t)nxt.pm * tstepA : cA; const char* nB = has_next ? (const char*)g.Bt + (size_t)nxt.pn * tstepB : cB;
        for (int t = 0; t < nt; t += 2) {
            const bool last = (t == nt - 2);
            const char* a1 = cA + (size_t)(t + 1) * kstep;
            const char* a2 = last ? nA : cA + (size_t)(t + 2) * kstep; const char* b2 = last ? nB : cB + (size_t)(t + 2) * kstep;
            const char* a3 = a2 + kstep; const char* b3 = b2 + kstep;
            if (last && has_next) S.a_ready(nxt);
            if constexpr (SP2) {
            PG8_LDB(B0, 0, 0); PG8_LDB(B1, 0, 1); PG8_SCHED; PG8_LDA(At, 0, 0); PG8_STAGE(PG8_SA(1, 1), a1 + hstepA, voffA, stepA);
            PG8_WAIT_V(8); PG8_WAIT_L(0); PG8_BAR; PG8_MMA(0, 0, At, B0); PG8_MMA(0, 1, At, B1); PG8_BAR; PG8_SCHED;
            PG8_LDA(At, 0, 1); PG8_STAGE(PG8_SB(0, 0), b2, voffB, stepB); PG8_STAGE(PG8_SB(0, 1), b2 + hstepB, voffB, stepB); PG8_STAGE(PG8_SA(0, 0), a2, voffA, stepA);
            PG8_WAIT_V(8); PG8_WAIT_L(0); PG8_BAR; PG8_MMA(1, 0, At, B0); PG8_MMA(1, 1, At, B1); PG8_BAR; PG8_SCHED;
            PG8_LDB(B0, 1, 0); PG8_LDB(B1, 1, 1); PG8_SCHED; PG8_LDA(At, 1, 0); PG8_STAGE(PG8_SA(0, 1), a2 + hstepA, voffA, stepA);
            PG8_WAIT_V(8); PG8_WAIT_L(0); PG8_BAR; PG8_MMA(0, 0, At, B0); PG8_MMA(0, 1, At, B1); PG8_BAR; PG8_SCHED;
            PG8_LDA(At, 1, 1); PG8_STAGE(PG8_SB(1, 0), b3, voffB, stepB); PG8_STAGE(PG8_SB(1, 1), b3 + hstepB, voffB, stepB); PG8_STAGE(PG8_SA(1, 0), a3, voffA, stepA);
            PG8_WAIT_V(8); PG8_WAIT_L(0); PG8_BAR; PG8_MMA(1, 0, At, B0); PG8_MMA(1, 1, At, B1); PG8_BAR; PG8_SCHED;
            } else {
            PG8_LDB(B0, 0, 0); PG8_SCHED; PG8_LDA(At, 0, 0); PG8_STAGE(PG8_SA(1, 1), a1 + hstepA, voffA, stepA);
            PG8_WAIT_L(8); PG8_BAR; PG8_WAIT_L(0); PG8_MMA(0, 0, At, B0); PG8_BAR; PG8_SCHED;
            PG8_LDB(B1, 0, 1); PG8_STAGE(PG8_SB(0, 0), b2, voffB, stepB);
            PG8_BAR; PG8_WAIT_L(0); PG8_MMA(0, 1, At, B1); PG8_BAR;
            PG8_LDA(At, 0, 1); PG8_STAGE(PG8_SA(0, 0), a2, voffA, stepA);
            PG8_BAR; PG8_WAIT_L(0); PG8_MMA(1, 0, At, B0); PG8_BAR; PG8_SCHED;
            PG8_STAGE(PG8_SB(0, 1), b2 + hstepB, voffB, stepB);
            PG8_WAIT_V(6); PG8_BAR; PG8_MMA(1, 1, At, B1); PG8_BAR;
            PG8_LDB(B0, 1, 0); PG8_SCHED; PG8_LDA(At, 1, 0); PG8_STAGE(PG8_SA(0, 1), a2 + hstepA, voffA, stepA);
            PG8_WAIT_L(8); PG8_BAR; PG8_WAIT_L(0); PG8_MMA(0, 0, At, B0); PG8_BAR; PG8_SCHED;
            PG8_LDB(B1, 1, 1); PG8_STAGE(PG8_SB(1, 0), b3, voffB, stepB);
            PG8_BAR; PG8_WAIT_L(0); PG8_MMA(0, 1, At, B1); PG8_BAR;
            PG8_LDA(At, 1, 1); PG8_STAGE(PG8_SA(1, 0), a3, voffA, stepA);
            PG8_BAR; PG8_WAIT_L(0); PG8_MMA(1, 0, At, B0); PG8_BAR; PG8_SCHED;
            PG8_STAGE(PG8_SB(1, 1), b3 + hstepB, voffB, stepB);
            PG8_WAIT_V(6); PG8_BAR; PG8_MMA(1, 1, At, B1); PG8_BAR;
            }
        }
        if constexpr (ALIGN_EPI) { if (wr == 0) PG8_BAR; }
        if constexpr (!Epi::AFTER_DRAIN) { E(acc, cur, wr, wc, fr, fq); S.done(cur); }
        if (!has_next) break;
#pragma unroll
        for (int a = 0; a < 2; ++a)
#pragma unroll
            for (int b = 0; b < 2; ++b)
#pragma unroll
                for (int m = 0; m < 4; ++m)
#pragma unroll
                    for (int n = 0; n < 2; ++n) acc[a][b][m][n] = (f32x4){0.f, 0.f, 0.f, 0.f};
        cur = nxt; cA = nA; cB = nB; ++ui;
        if constexpr (ALIGN_EPI) { if (wr == 1) PG8_BAR; }
    }
    PG8_WAIT_V(0);
    if constexpr (!ALIGN_EPI) { if (wr == 0) PG8_BAR; }
    PG8_BAR;
    if constexpr (Epi::AFTER_DRAIN) { E.fused(acc, cur, wr, wc, fr, fq, lds, wid, lane); S.done(cur); }
#undef PG8_SA
#undef PG8_SB
#undef PG8_STAGE
#undef PG8_LDA
#undef PG8_LDB
#undef PG8_MMA
#undef PG8_WAIT_V
#undef PG8_WAIT_L
#undef PG8_BAR
#undef PG8_SCHED
}
}

#define LAS __attribute__((address_space(3)))
using pg8::bf16_t; using pg8::f32x4; using pg8::u32x4; using pg8::cvt_pk_bf16; using pg8::Unit; using pg8::bf16x8;
typedef unsigned u32x2 __attribute__((ext_vector_type(2)));
typedef float f32x2v __attribute__((ext_vector_type(2)));
constexpr int NB = 2, SEQ = 16384, DM = 1024, MR = NB * SEQ, FFH = 2816, NTHR = 512;
constexpr size_t MiB = 1u << 20;
constexpr size_t WS_MODS = 0, WS_KVMODS = 256 * 1024, WS_SS = 1 * MiB, WS_BIAS = 2 * MiB, WS_CS = 3 * MiB;
constexpr size_t WS_WHIN = 8 * MiB, WS_WHOUT = 24 * MiB, WS_WFIN = 28 * MiB, WS_WFOUT = 72 * MiB, WS_WQ = 94 * MiB, WS_WKV = 99 * MiB, WS_WAO = 102 * MiB, WS_WC1 = 106 * MiB, WS_WC2 = 108 * MiB;
constexpr size_t WS_XB = 112 * MiB, WS_R = 176 * MiB;
constexpr size_t WS_HB = WS_R, WS_OB = 432 * MiB, WS_HID = WS_R, WS_Q = WS_R, WS_QR = 240 * MiB, WS_AO = 304 * MiB, WS_XB2 = 352 * MiB, WS_GATES = 370 * MiB, WS_SELM = 376 * MiB, WS_SLOC = 496 * MiB, WS_DSEG = 2 * MiB + 512 * 1024, WS_BAR = 768 * 1024;
constexpr size_t WS_KC = 406 * MiB, WS_VC = 407 * MiB, WS_CHID = 408 * MiB, WS_KV = 416 * MiB;
constexpr size_t WS_END = 512 * MiB;
constexpr int BO_HIN = 0, BO_FIN = 16384, BO_Q = BO_FIN + 45056, BO_KV = BO_Q + 5120, BO_C1 = BO_KV + 3072, BO_GM = BO_C1 + 512;
constexpr int LDS_BYTES = 147456;

struct Params { const float* in[23]; float* out; unsigned char* ws; };
typedef const __attribute__((address_space(4))) Params* PK;
__device__ __forceinline__ PK fresh_pk() { PK k = (PK)__builtin_amdgcn_kernarg_segment_ptr(); asm volatile("" : "+s"(k)); return k; }

__device__ __forceinline__ float bf2f(unsigned short v) { return __uint_as_float(((unsigned)v) << 16); }
__device__ __forceinline__ float bflo(unsigned w) { return __uint_as_float(w << 16); }
__device__ __forceinline__ float bfhi(unsigned w) { return __uint_as_float(w & 0xffff0000u); }
__device__ __forceinline__ float fsigmoid(float v) { return __builtin_amdgcn_rcpf(1.f + __expf(-v)); }
__device__ __forceinline__ float fsilu(float v) { return v * fsigmoid(v); }
__device__ __forceinline__ float wave_sum(float v) {
#pragma unroll
    for (int o = 32; o >= 1; o >>= 1) v += __shfl_xor(v, o);
    return v; }
__device__ __forceinline__ float wave_max(float v) {
#pragma unroll
    for (int o = 32; o >= 1; o >>= 1) v = fmaxf(v, __shfl_xor(v, o));
    return v; }

__device__ __forceinline__ int opaque_lane() { int l; asm volatile("v_mbcnt_lo_u32_b32 %0, -1, 0\n\tv_mbcnt_hi_u32_b32 %0, -1, %0" : "=v"(l)); return l; }
__device__ __forceinline__ float shx(float v, int lane, int mask) { return __int_as_float(__builtin_amdgcn_ds_bpermute((lane ^ mask) << 2, __float_as_int(v))); }
__device__ __forceinline__ bf16_t f2bf(float v) { return (bf16_t)(cvt_pk_bf16(v, 0.f) & 0xffffu); }

struct TJob { const float* W; bf16_t* Wt; int K, Nsrc, Npad, kind, ntiles; };
__device__ __forceinline__ int map_col(int kind, int r) {
    if (kind == 0) return r;
    const int tile = r >> 8, w = r & 255;
    if (kind == 1) { const int j = tile * 128 + (w & 127); return (w < 128) ? j : FFH + j; }
    const int bj = w >> 7, wc = (w >> 5) & 3, jj = w & 31;
    if (kind == 2) { if (r < 1024) return tile * 256 + wc * 64 + bj * 32 + jj; const int g = r - 1024; return g < 48 ? 1024 + g : -1; }
    if (kind == 4) return tile * 256 + wc * 64 + bj * 32 + jj;
    return (wc == 0) ? bj * 32 + jj : -1;
}
__device__ __forceinline__ void get_tjob(PK p, int j, TJob& o) {
    unsigned char* ws = p->ws;
    if (j < 2) { o.W = p->in[6] + (size_t)j * 1024 * 4096; o.Wt = (bf16_t*)(ws + WS_WHIN) + (size_t)j * 4096 * 1024; o.K = 1024; o.Nsrc = 4096; o.Npad = 4096; o.kind = 0; }
    else if (j < 4) { const int l = j - 2; o.W = p->in[9] + (size_t)l * 1024 * 1024; o.Wt = (bf16_t*)(ws + WS_WHOUT) + (size_t)l * 1024 * 1024; o.K = 1024; o.Nsrc = 1024; o.Npad = 1024; o.kind = 0; }
    else if (j < 8) { const int l = j - 4; o.W = p->in[21] + (size_t)l * 1024 * 5632; o.Wt = (bf16_t*)(ws + WS_WFIN) + (size_t)l * 5632 * 1024; o.K = 1024; o.Nsrc = 5632; o.Npad = 5632; o.kind = 1; }
    else if (j < 12) { const int l = j - 8; o.W = p->in[22] + (size_t)l * 2816 * 1024; o.Wt = (bf16_t*)(ws + WS_WFOUT) + (size_t)l * 1024 * 2816; o.K = 2816; o.Nsrc = 1024; o.Npad = 1024; o.kind = 0; }
    else if (j < 14) { const int l = j - 12; o.W = p->in[18] + (size_t)l * 1024 * 1072; o.Wt = (bf16_t*)(ws + WS_WQ) + (size_t)l * 1280 * 1024; o.K = 1024; o.Nsrc = 1072; o.Npad = 1280; o.kind = 2; }
    else if (j == 14) { o.W = p->in[13]; o.Wt = (bf16_t*)(ws + WS_WKV); o.K = 1024; o.Nsrc = 1536; o.Npad = 1536; o.kind = 4; }
    else if (j < 17) { const int l = j - 15; o.W = p->in[20] + (size_t)l * 1024 * 1024; o.Wt = (bf16_t*)(ws + WS_WAO) + (size_t)l * 1024 * 1024; o.K = 1024; o.Nsrc = 1024; o.Npad = 1024; o.kind = 0; }
    else if (j < 19) { const int l = j - 17; o.W = p->in[16] + (size_t)l * 2048 * 256; o.Wt = (bf16_t*)(ws + WS_WC1) + (size_t)l * 256 * 2048; o.K = 2048; o.Nsrc = 256; o.Npad = 256; o.kind = 0; }
    else { const int l = j - 19; o.W = p->in[17] + (size_t)l * 256 * 64; o.Wt = (bf16_t*)(ws + WS_WC2) + (size_t)l * 256 * 256; o.K = 256; o.Nsrc = 64; o.Npad = 256; o.kind = 3; }
    o.ntiles = (o.K / 64) * (o.Npad / 64);
}
__device__ __forceinline__ void transpose_tiles(const TJob& J, int tile0, int G, LAS float* scr, int tid) {
    const int nrt = J.Npad / 64; const int rl = tid & 63, kl = tid >> 6; const int rr = tid >> 3, kc = tid & 7;
    float v[4][8];
#pragma unroll
    for (int t = 0; t < 4; ++t) { const int tile = tile0 + t * G;
        if (tile < J.ntiles) { const int kt = tile / nrt, rt = tile % nrt; const int sc = map_col(J.kind, rt * 64 + rl);
#pragma unroll
            for (int i = 0; i < 8; ++i) v[t][i] = sc >= 0 ? J.W[(size_t)(kt * 64 + kl + 8 * i) * J.Nsrc + sc] : 0.f; } }
#pragma unroll
    for (int t = 0; t < 4; ++t) if (tile0 + t * G < J.ntiles) {
#pragma unroll
        for (int i = 0; i < 8; ++i) scr[t * 4160 + (kl + 8 * i) * 65 + rl] = v[t][i]; }
    __syncthreads();
#pragma unroll
    for (int t = 0; t < 4; ++t) { const int tile = tile0 + t * G; if (tile >= J.ntiles) continue;
        const int kt = tile / nrt, rt = tile % nrt;
        LAS const float* sp = scr + t * 4160 + (kc * 8) * 65 + rr;
        u32x4 o; o.x = cvt_pk_bf16(sp[0], sp[65]); o.y = cvt_pk_bf16(sp[130], sp[195]); o.z = cvt_pk_bf16(sp[260], sp[325]); o.w = cvt_pk_bf16(sp[390], sp[455]);
        *(u32x4*)(J.Wt + (size_t)(rt * 64 + rr) * J.K + kt * 64 + kc * 8) = o; }
    __syncthreads();
}

__device__ __forceinline__ void phase0(PK p, LAS unsigned char* ldsb, int wid_s) {
    const int tid = opaque_tid(wid_s), G = gridDim.x;
    float* mods = (float*)(p->ws + WS_MODS); float* kvmods = (float*)(p->ws + WS_KVMODS); float* SS = (float*)(p->ws + WS_SS);
    for (int i = blockIdx.x * NTHR + tid; i < 8 * MR; i += G * NTHR) SS[i] = 0.f;
    LAS float* ca = (LAS float*)ldsb; LAS float* red = ca + 2048;
    for (int i = tid; i < 2048; i += NTHR) ca[i] = fsilu(p->in[1][i]);
    __syncthreads();
    for (int item = blockIdx.x; item < 208; item += G) {
        const float* W; const float* bias; float* out; int ld, col0, ostride;
        if (item < 192) { const int l = item / 24, cb = item % 24; W = p->in[2] + (size_t)l * 1024 * 3072; ld = 3072; col0 = cb * 128; bias = p->in[3] + l * 3072; out = mods + l * 6144; ostride = 3072; }
        else { W = p->in[10]; ld = 2048; col0 = (item - 192) * 128; bias = p->in[11]; out = kvmods; ostride = 2048; }
        const int ks = tid >> 5, cq = tid & 31;
        f32x4 a0 = (f32x4){0.f, 0.f, 0.f, 0.f}, a1 = a0;
        const float* wp = W + (size_t)(ks * 64) * ld + col0 + cq * 4;
#pragma unroll 8
        for (int k = 0; k < 64; ++k) { const f32x4 w = *(const f32x4*)(wp + (size_t)k * ld); a0 += w * ca[ks * 64 + k]; a1 += w * ca[1024 + ks * 64 + k]; }
        LAS f32x4* red4 = (LAS f32x4*)red;
        red4[(ks * 32 + cq) * 2] = a0; red4[(ks * 32 + cq) * 2 + 1] = a1;
        __syncthreads();
        if (tid < 256) { const int col = tid & 127, bb = tid >> 7; float sum = 0.f;
#pragma unroll
            for (int q = 0; q < 16; ++q) sum += red[((q * 32 + (col >> 2)) * 2 + bb) * 4 + (col & 3)];
            out[bb * ostride + col0 + col] = sum + bias[col0 + col]; }
        __syncthreads();
    }
    f32x2v* cs = (f32x2v*)(p->ws + WS_CS);
    for (int i = blockIdx.x * NTHR + tid; i < SEQ * 32; i += G * NTHR) {
        const int t = i >> 5, d = i & 31;
        const float e = (float)(2 * d) / 64.f; const float invf = 1.0f / exp2f(e * 13.287712379549449f);
        const float ang = (float)t * invf;
        double r = (double)ang * 0.15915494309189535; r -= rint(r);
        const float rf = (float)r;
        cs[i] = (f32x2v){__builtin_amdgcn_cosf(rf), __builtin_amdgcn_sinf(rf)};
    }
    LAS float* scr = (LAS float*)ldsb + 4096;
    int base = 0;
#pragma unroll 1
    for (int j = 0; j < 21; ++j) { TJob J; get_tjob(p, j, J);
        int first = ((int)blockIdx.x - base) % G; if (first < 0) first += G;
        for (int tile = first; tile < J.ntiles; tile += 4 * G) transpose_tiles(J, tile, G, scr, tid);
        base += J.ntiles; }
}

__device__ __forceinline__ void phase1(PK p, LAS unsigned char* ldsb, int wid_s) {
    const int tid = opaque_tid(wid_s), G = gridDim.x, lane = tid & 63, wave = tid >> 6;
    const float* mods = (const float*)(p->ws + WS_MODS); const float* kvmods = (const float*)(p->ws + WS_KVMODS); float* BIAS = (float*)(p->ws + WS_BIAS);
    for (int gr = blockIdx.x * 8 + wave; gr < 35328; gr += G * 8) {
        const bf16_t* wr; const float* s0; const float* s1; float* out; int K, ostride; int r = gr;
        if (r < 8192) { const int l = r >> 12; r &= 4095; wr = (const bf16_t*)(p->ws + WS_WHIN) + ((size_t)l * 4096 + r) * 1024; K = 1024; s0 = mods + (2 * l) * 6144; s1 = s0 + 3072; out = BIAS + BO_HIN + l * 8192 + r; ostride = 4096; }
        else if ((r -= 8192) < 22528) { const int l = r / 5632; r -= l * 5632; wr = (const bf16_t*)(p->ws + WS_WFIN) + ((size_t)l * 5632 + r) * 1024; K = 1024; s0 = mods + (2 * l + 1) * 6144; s1 = s0 + 3072; out = BIAS + BO_FIN + l * 11264 + r; ostride = 5632; }
        else if ((r -= 22528) < 2560) { const int l = r / 1280; r -= l * 1280; wr = (const bf16_t*)(p->ws + WS_WQ) + ((size_t)l * 1280 + r) * 1024; K = 1024; s0 = mods + (2 * (l + 2)) * 6144; s1 = s0 + 3072; out = BIAS + BO_Q + l * 2560 + r; ostride = 1280; }
        else if ((r -= 2560) < 1536) { wr = (const bf16_t*)(p->ws + WS_WKV) + (size_t)r * 1024; K = 1024; s0 = kvmods; s1 = kvmods + 2048; out = BIAS + BO_KV + r; ostride = 1536; }
        else { r -= 1536; const int l = r >> 8; r &= 255; wr = (const bf16_t*)(p->ws + WS_WC1) + ((size_t)l * 256 + r) * 2048; K = 2048; s0 = p->in[15] + l * 2048; s1 = s0; out = BIAS + BO_C1 + l * 256 + r; ostride = 0; }
        float a0 = 0.f, a1 = 0.f;
        for (int k = lane * 8; k < K; k += 512) { const u32x4 w = *(const u32x4*)(wr + k);
            const f32x4 x0 = *(const f32x4*)(s0 + k), x1 = *(const f32x4*)(s0 + k + 4), y0 = *(const f32x4*)(s1 + k), y1 = *(const f32x4*)(s1 + k + 4);
            const float wf[8] = {bflo(w.x), bfhi(w.x), bflo(w.y), bfhi(w.y), bflo(w.z), bfhi(w.z), bflo(w.w), bfhi(w.w)};
            a0 += (x0.x * wf[0] + x0.y * wf[1]) + (x0.z * wf[2] + x0.w * wf[3]) + (x1.x * wf[4] + x1.y * wf[5]) + (x1.z * wf[6] + x1.w * wf[7]);
            a1 += (y0.x * wf[0] + y0.y * wf[1]) + (y0.z * wf[2] + y0.w * wf[3]) + (y1.x * wf[4] + y1.y * wf[5]) + (y1.z * wf[6] + y1.w * wf[7]); }
        a0 = wave_sum(a0); a1 = wave_sum(a1);
        if (lane == 0) { out[0] = a0; if (ostride) out[ostride] = a1; }
    }
    for (int i = blockIdx.x * NTHR + tid; i < 9 * 2048; i += G * NTHR) { const int l2 = i >> 11, b = (i >> 10) & 1, k = i & 1023;
        float g, sc; if (l2 < 8) { g = ((l2 & 1) ? p->in[5] : p->in[4])[(l2 >> 1) * 1024 + k]; sc = mods[l2 * 6144 + b * 3072 + 1024 + k]; } else { g = p->in[12][k]; sc = kvmods[b * 2048 + 1024 + k]; }
        BIAS[BO_GM + i] = g * (1.0f + sc); }
    const float* x = p->in[0]; bf16_t* XB = (bf16_t*)(p->ws + WS_XB); float* SS0 = (float*)(p->ws + WS_SS);
    const float* ng = p->in[4]; const float* scl = mods + 1024;
    for (int row = blockIdx.x * 8 + wave; row < MR; row += G * 8) {
        const int b = row >> 14; f32x4 v[4]; float ss = 0.f;
#pragma unroll
        for (int j = 0; j < 4; ++j) { v[j] = *(const f32x4*)(x + (size_t)row * DM + j * 256 + lane * 4); ss += (v[j].x * v[j].x + v[j].y * v[j].y) + (v[j].z * v[j].z + v[j].w * v[j].w); }
        ss = wave_sum(ss); if (lane == 0) SS0[row] = ss;
#pragma unroll
        for (int j = 0; j < 4; ++j) { const int col = j * 256 + lane * 4; const f32x4 g = *(const f32x4*)(ng + col); const f32x4 s = *(const f32x4*)(scl + b * 3072 + col);
            const f32x4 o = v[j] * (g * (s + 1.0f)); u32x2 w; w.x = cvt_pk_bf16(o.x, o.y); w.y = cvt_pk_bf16(o.z, o.w); *(u32x2*)(XB + (size_t)row * DM + col) = w; }
    }
}

#define EPI_ROWS(ai, m) (u.pm * 256 + (ai) * 128 + wr * 64 + (m) * 16 + fr)
__device__ __forceinline__ float rstd_of(const float* ss, int row) { return rsqrtf(ss[row] * (1.0f / 1024.0f) + 1e-6f); }

struct EpiHin {
    static constexpr bool PERM = true, AFTER_DRAIN = false;
    bf16_t* HB; const float* ss; const float* bias;
    __device__ __forceinline__ void operator()(const f32x4 (&acc)[2][2][4][2], const Unit& u, int wr, int wc, int fr_, int fq_) const {
        const int lane_ = opaque_lane(), fr = lane_ & 15, fq = lane_ >> 4;
        const int seg = u.pn >> 2; const bool act = (seg == 0) || (seg == 3);
#pragma unroll
        for (int ai = 0; ai < 2; ++ai)
#pragma unroll
            for (int m = 0; m < 4; ++m) { asm volatile("" ::: "memory"); const int row = EPI_ROWS(ai, m), b = row >> 14; const float rs = rstd_of(ss, row);
#pragma unroll
                for (int bj = 0; bj < 2; ++bj) { const int c0 = u.pn * 256 + bj * 128 + wc * 32 + fq * 8;
                    f32x4 v0 = acc[ai][bj][m][0] * rs + *(const f32x4*)(bias + b * 4096 + c0), v1 = acc[ai][bj][m][1] * rs + *(const f32x4*)(bias + b * 4096 + c0 + 4);
                    if (act) { v0 = (f32x4){fsilu(v0.x), fsilu(v0.y), fsilu(v0.z), fsilu(v0.w)}; v1 = (f32x4){fsilu(v1.x), fsilu(v1.y), fsilu(v1.z), fsilu(v1.w)}; }
                    u32x4 w; w.x = cvt_pk_bf16(v0.x, v0.y); w.y = cvt_pk_bf16(v0.z, v0.w); w.z = cvt_pk_bf16(v1.x, v1.y); w.w = cvt_pk_bf16(v1.z, v1.w);
                    *(u32x4*)(HB + (size_t)row * 4096 + c0) = w; } }
    }
};
struct EpiFin {
    static constexpr bool PERM = true, AFTER_DRAIN = false;
    bf16_t* HID; const float* ss; const float* bias;
    __device__ __forceinline__ void operator()(const f32x4 (&acc)[2][2][4][2], const Unit& u, int wr, int wc, int fr_, int fq_) const {
        const int lane_ = opaque_lane(), fr = lane_ & 15, fq = lane_ >> 4;
        const int ca = u.pn * 256 + wc * 32 + fq * 8, cb = ca + 128, co = u.pn * 128 + wc * 32 + fq * 8;
#pragma unroll
        for (int ai = 0; ai < 2; ++ai)
#pragma unroll
            for (int m = 0; m < 4; ++m) { asm volatile("" ::: "memory"); const int row = EPI_ROWS(ai, m), b = row >> 14; const float rs = rstd_of(ss, row);
                const f32x4 a0 = acc[ai][0][m][0] * rs + *(const f32x4*)(bias + b * 5632 + ca), a1 = acc[ai][0][m][1] * rs + *(const f32x4*)(bias + b * 5632 + ca + 4);
                const f32x4 b0 = acc[ai][1][m][0] * rs + *(const f32x4*)(bias + b * 5632 + cb), b1 = acc[ai][1][m][1] * rs + *(const f32x4*)(bias + b * 5632 + cb + 4);
                u32x4 w; w.x = cvt_pk_bf16(fsilu(a0.x) * b0.x, fsilu(a0.y) * b0.y); w.y = cvt_pk_bf16(fsilu(a0.z) * b0.z, fsilu(a0.w) * b0.w);
                w.z = cvt_pk_bf16(fsilu(a1.x) * b1.x, fsilu(a1.y) * b1.y); w.w = cvt_pk_bf16(fsilu(a1.z) * b1.z, fsilu(a1.w) * b1.w);
                *(u32x4*)(HID + (size_t)row * FFH + co) = w; }
    }
};
template <bool XB2> struct EpiRes {
    static constexpr bool PERM = true, AFTER_DRAIN = false;
    const float* xold; float* xout; const float* gate;
    float* ssout; bf16_t* xb; const float* gm1;
    bf16_t* xb2; const float* gm2;
    __device__ __forceinline__ void operator()(const f32x4 (&acc)[2][2][4][2], const Unit& u, int wr, int wc, int fr_, int fq_) const {
        const int lane_ = opaque_lane(), fr = lane_ & 15, fq = lane_ >> 4;
#pragma unroll
        for (int ai = 0; ai < 2; ++ai)
#pragma unroll
            for (int m = 0; m < 4; ++m) { const int row = EPI_ROWS(ai, m), b = row >> 14; float sq = 0.f;
#pragma unroll
                for (int bj = 0; bj < 2; ++bj)
#pragma unroll
                    for (int n = 0; n < 2; ++n) { asm volatile("" ::: "memory");
                        const int c0 = u.pn * 256 + bj * 128 + wc * 32 + fq * 8 + n * 4; const size_t off = (size_t)row * DM + c0;
                        const f32x4 x0 = *(const f32x4*)(xold + off) + *(const f32x4*)(gate + b * 3072 + c0) * acc[ai][bj][m][n];
                        *(f32x4*)(xout + off) = x0;
                        sq += (x0.x * x0.x + x0.y * x0.y) + (x0.z * x0.z + x0.w * x0.w);
                        { const f32x4 o0 = x0 * *(const f32x4*)(gm1 + b * 1024 + c0); u32x2 w; w.x = cvt_pk_bf16(o0.x, o0.y); w.y = cvt_pk_bf16(o0.z, o0.w); *(u32x2*)(xb + off) = w; }
                        if (XB2) { const f32x4 o0 = x0 * *(const f32x4*)(gm2 + b * 1024 + c0); u32x2 w; w.x = cvt_pk_bf16(o0.x, o0.y); w.y = cvt_pk_bf16(o0.z, o0.w); *(u32x2*)(xb2 + off) = w; } }
                sq += shx(sq, lane_, 16); sq += shx(sq, lane_, 32);
                if (fq == 0) atomicAdd(ssout + row, sq); }
    }
};
__device__ __forceinline__ void head_norm(float (&v0)[8], float (&v1)[8], const float* gain, int fq, int lane_) {
    float s = 0.f;
#pragma unroll
    for (int i = 0; i < 8; ++i) s += v0[i] * v0[i] + v1[i] * v1[i];
    s += shx(s, lane_, 16); s += shx(s, lane_, 32);
    const float r = rsqrtf(s * (1.0f / 64.0f) + 1e-6f);
#pragma unroll
    for (int i = 0; i < 8; ++i) { v0[i] = v0[i] * r * gain[fq * 8 + i]; v1[i] = v1[i] * r * gain[32 + fq * 8 + i]; }
}
__device__ __forceinline__ void store8(bf16_t* p, const float (&v)[8]) { u32x4 w; w.x = cvt_pk_bf16(v[0], v[1]); w.y = cvt_pk_bf16(v[2], v[3]); w.z = cvt_pk_bf16(v[4], v[5]); w.w = cvt_pk_bf16(v[6], v[7]); *(u32x4*)p = w; }
__device__ __forceinline__ void rope8(const float (&v0)[8], const float (&v1)[8], const f32x2v* cs, int t, int fq, float (&r0)[8], float (&r1)[8]) {
#pragma unroll
    for (int i = 0; i < 8; ++i) { const f32x2v c = cs[t * 32 + fq * 8 + i]; r0[i] = v0[i] * c.x - v1[i] * c.y; r1[i] = v1[i] * c.x + v0[i] * c.y; }
}
struct EpiQ {
    static constexpr bool PERM = true, AFTER_DRAIN = false;
    bf16_t* Q; bf16_t* QR; float* GATES; const float* ss; const float* bias; const float* qn; const f32x2v* cs;
    __device__ __forceinline__ void operator()(const f32x4 (&acc)[2][2][4][2], const Unit& u, int wr, int wc, int fr_, int fq_) const {
        const int lane_ = opaque_lane(), fr = lane_ & 15, fq = lane_ >> 4;
#pragma unroll
        for (int ai = 0; ai < 2; ++ai)
#pragma unroll
            for (int m = 0; m < 4; ++m) { asm volatile("" ::: "memory"); const int row = EPI_ROWS(ai, m), b = row >> 14, t = row & (SEQ - 1); const float rs = rstd_of(ss, row);
                const float* bp = bias + b * 1280 + u.pn * 256 + wc * 32 + fq * 8;
                float v0[8], v1[8];
#pragma unroll
                for (int i = 0; i < 8; ++i) { v0[i] = acc[ai][0][m][i >> 2][i & 3] * rs + bp[i]; v1[i] = acc[ai][1][m][i >> 2][i & 3] * rs + bp[128 + i]; }
                if (u.pn < 4) { const int hd = u.pn * 4 + wc;
                    head_norm(v0, v1, qn, fq, lane_);
#pragma unroll
                    for (int i = 0; i < 8; ++i) { v0[i] *= 0.18033688011112042f; v1[i] *= 0.18033688011112042f; }
                    bf16_t* qp = Q + (size_t)row * DM + hd * 64 + fq * 8; store8(qp, v0); store8(qp + 32, v1);
                    float r0[8], r1[8]; rope8(v0, v1, cs, t, fq, r0, r1);
                    bf16_t* rp = QR + (size_t)row * DM + hd * 64 + fq * 8; store8(rp, r0); store8(rp + 32, r1);
                } else {
                    const int cg = wc * 32 + fq * 8;
#pragma unroll
                    for (int i = 0; i < 8; ++i) if (cg + i < 48) GATES[(size_t)row * 48 + cg + i] = fsigmoid(v0[i]);
                } }
    }
};
struct EpiKV {
    static constexpr bool PERM = true, AFTER_DRAIN = false;
    bf16_t* KV; const float* ss; const float* bias; const float* kn; const f32x2v* cs;
    __device__ __forceinline__ void operator()(const f32x4 (&acc)[2][2][4][2], const Unit& u, int wr, int wc, int fr_, int fq_) const {
        const int lane_ = opaque_lane(), fr = lane_ & 15, fq = lane_ >> 4;
        bf16_t* dst = KV + (size_t)u.pn * (8u << 20);
        const bool nr = (u.pn == 2) || (u.pn == 4);
#pragma unroll
        for (int ai = 0; ai < 2; ++ai)
#pragma unroll
            for (int m = 0; m < 4; ++m) { asm volatile("" ::: "memory"); const int row = EPI_ROWS(ai, m), b = row >> 14, t = row & (SEQ - 1); const float rs = rstd_of(ss, row);
                const float* bp = bias + b * 1536 + u.pn * 256 + wc * 32 + fq * 8;
                float v0[8], v1[8];
#pragma unroll
                for (int i = 0; i < 8; ++i) { v0[i] = acc[ai][0][m][i >> 2][i & 3] * rs + bp[i]; v1[i] = acc[ai][1][m][i >> 2][i & 3] * rs + bp[128 + i]; }
                bf16_t* op = dst + ((size_t)(b * 4 + wc) * SEQ + t) * 64 + fq * 8;
                if (nr) { head_norm(v0, v1, kn + (u.pn >> 1) * 64, fq, lane_); float r0[8], r1[8]; rope8(v0, v1, cs, t, fq, r0, r1); store8(op, r0); store8(op + 32, r1); }
                else if (u.pn == 3 || u.pn == 5) {
                    bf16_t* tp = dst + ((size_t)(b * 4 + wc) * 64 + fq * 8) * SEQ + t;
#pragma unroll
                    for (int i = 0; i < 8; ++i) { tp[(size_t)i * SEQ] = f2bf(v0[i]); tp[(size_t)(32 + i) * SEQ] = f2bf(v1[i]); } }
                else { store8(op, v0); store8(op + 32, v1); } }
    }
};
struct EpiC1 {
    static constexpr bool PERM = true, AFTER_DRAIN = false;
    bf16_t* H; const float* bias;
    __device__ __forceinline__ void operator()(const f32x4 (&acc)[2][2][4][2], const Unit& u, int wr, int wc, int fr_, int fq_) const {
        const int lane_ = opaque_lane(), fr = lane_ & 15, fq = lane_ >> 4;
#pragma unroll
        for (int ai = 0; ai < 2; ++ai)
#pragma unroll
            for (int m = 0; m < 4; ++m) { asm volatile("" ::: "memory"); const int row = EPI_ROWS(ai, m);
#pragma unroll
                for (int bj = 0; bj < 2; ++bj) { const int c0 = bj * 128 + wc * 32 + fq * 8; float v[8];
#pragma unroll
                    for (int i = 0; i < 8; ++i) v[i] = fsilu(acc[ai][bj][m][i >> 2][i & 3] + bias[c0 + i]);
                    store8(H + (size_t)row * 256 + c0, v); } }
    }
};
struct EpiC2 {
    static constexpr bool PERM = true, AFTER_DRAIN = false;
    bf16_t* O; const float* kn; int tr;
    __device__ __forceinline__ void operator()(const f32x4 (&acc)[2][2][4][2], const Unit& u, int wr, int wc, int fr_, int fq_) const {
        const int lane_ = opaque_lane(), fr = lane_ & 15, fq = lane_ >> 4;
        if (wc != 0) return;
#pragma unroll
        for (int ai = 0; ai < 2; ++ai)
#pragma unroll
            for (int m = 0; m < 4; ++m) { asm volatile("" ::: "memory"); const int row = EPI_ROWS(ai, m); float v0[8], v1[8];
#pragma unroll
                for (int i = 0; i < 8; ++i) { v0[i] = acc[ai][0][m][i >> 2][i & 3]; v1[i] = acc[ai][1][m][i >> 2][i & 3]; }
                if (kn) head_norm(v0, v1, kn, fq, lane_);
                if (tr) { bf16_t* tp = O + ((size_t)(row >> 10) * 64 + fq * 8) * 1024 + (row & 1023);
#pragma unroll
                    for (int i = 0; i < 8; ++i) { tp[i * 1024] = f2bf(v0[i]); tp[(32 + i) * 1024] = f2bf(v1[i]); } }
                else { bf16_t* op = O + (size_t)row * 64 + fq * 8; store8(op, v0); store8(op + 32, v1); } }
    }
};
#define RUN_GEMM(EpiT, E, Aptr, Btptr, Mv, Nv, Kv, ldav) do { pg8::Gemm g_{(const bf16_t*)(Aptr), (const bf16_t*)(Btptr), (Mv), (Nv), (Kv), (ldav)}; pg8::StaticOrder S_; int g_x_ = (int)gridDim.x, b_x_ = (int)blockIdx.x; asm volatile("" : "+s"(g_x_), "+s"(b_x_)); S_.init((Mv), (Nv), g_x_, b_x_); \
    pg8::gemm_phase<EpiT, pg8::StaticOrder, true, true>(ldsb, g_, S_, (E), wid_s); } while (0)
#define RUN_GEMM_AT(EpiT, E, Aptr, Btptr, Mv, Nv, Kv, ldav, cshift) do { pg8::Gemm g_{(const bf16_t*)(Aptr), (const bf16_t*)(Btptr), (Mv), (Nv), (Kv), (ldav)}; pg8::StaticOrder S_; int g_x_ = (int)gridDim.x, b_x_ = (int)blockIdx.x - (cshift); asm volatile("" : "+s"(g_x_), "+s"(b_x_)); S_.init((Mv), (Nv), g_x_, b_x_); \
    pg8::gemm_phase<EpiT, pg8::StaticOrder, true, true>(ldsb, g_, S_, (E), wid_s); } while (0)

constexpr int HL_G = 0, HL_ATT = 0, HL_OBUF = 9216, HL_QX = 32768, HL_KX = 50176, HL_KXT = 67584, HL_IT = 86016, HL_ST = 104448, HL_VEC = 139264;
template <bool FULL> __device__ __forceinline__ void phase_hgrn(const bf16_t* HB, bf16_t* OG, float* SLOC, float* DSEG, const float* lbraw, const float* onorm, int layer, LAS unsigned char* ldsb, int wid_s) {
    const int tid = opaque_tid(wid_s), lane = tid & 63, wave = __builtin_amdgcn_readfirstlane(tid >> 6);
    const int t1 = tid >> 3, c0 = (tid & 7) * 16;
    const int k2 = tid & 127, tq = tid >> 7;
    const int fi = lane & 15, fkq = lane >> 4;
    LAS float* Gs = (LAS float*)(ldsb + HL_G); LAS float* vec = (LAS float*)(ldsb + HL_VEC);
    LAS float* eg31 = vec, *e2v = vec + 128, *decv = vec + 256, *lbv = vec + 384, *tot = vec + 512;
    for (int unit = blockIdx.x; unit < 256; unit += gridDim.x) {
        const int b = unit >> 7, h = (unit >> 4) & 7, seg = unit & 15;
        if (!FULL && seg == 15) continue;
        if (tid < 128) { float lb = 0.f; if (layer == 1) lb = 1.0f / (1.0f + __expf(lbraw[h * 128 + tid] - lbraw[1024 + h * 128 + tid])); lbv[tid] = lb; }
        f32x4 S[8];
#pragma unroll
        for (int kt = 0; kt < 8; ++kt) S[kt] = (f32x4){0.f, 0.f, 0.f, 0.f};
        if (FULL) {
            for (int sp = 0; sp < seg; ++sp) { const float* sl = SLOC + (size_t)(unit - seg + sp) * 16384; const float* ds = DSEG + (size_t)(unit - seg + sp) * 128;
#pragma unroll
                for (int kt = 0; kt < 8; ++kt)
#pragma unroll
                    for (int r = 0; r < 4; ++r) { const int k = kt * 16 + fkq * 4 + r; S[kt][r] = ds[k] * S[kt][r] + sl[k * 128 + wave * 16 + fi]; } }
        }
        float lseg = 0.f;
        u32x4 pfa, pfb, pia, pib;
        { const bf16_t* h0 = HB + ((size_t)b * SEQ + seg * 1024 + t1) * 4096 + h * 128 + c0;
          pfa = *(const u32x4*)(h0 + 1024); pfb = *(const u32x4*)(h0 + 1024 + 8); pia = *(const u32x4*)(h0 + 2048); pib = *(const u32x4*)(h0 + 2048 + 8);
        }
        __syncthreads();
#pragma unroll 1
        for (int ch = 0; ch < 16; ++ch) {
            const size_t row0 = (size_t)b * SEQ + seg * 1024 + ch * 64;
            const bf16_t* hrow = HB + (row0 + t1) * 4096 + h * 128 + c0;
            const bf16_t* hnext = hrow + (size_t)64 * 4096; const bool more = (ch + 1 < 16);
            float kk[16];
            { const u32x4 fa = pfa, fb = pfb;
              if (more) { pfa = *(const u32x4*)(hnext + 1024); pfb = *(const u32x4*)(hnext + 1024 + 8); }
              const unsigned fw[8] = {fa.x, fa.y, fa.z, fa.w, fb.x, fb.y, fb.z, fb.w};
              float lg[16];
#pragma unroll
              for (int j = 0; j < 16; ++j) { const float f = fmaxf((j & 1) ? bfhi(fw[j >> 1]) : bflo(fw[j >> 1]), -80.f); const float lb = lbv[c0 + j], om = 1.f - lb;
                  const float e = __expf(-f), sg = __builtin_amdgcn_rcpf(1.f + e); kk[j] = om * (e * sg); lg[j] = __logf(lb + om * sg); }
#pragma unroll
              for (int j = 0; j < 16; j += 4) *(LAS f32x4*)(Gs + t1 * 128 + c0 + j) = (f32x4){lg[j], lg[j + 1], lg[j + 2], lg[j + 3]}; }
            __syncthreads();
            { float loc[16]; float run = 0.f;
#pragma unroll
              for (int j = 0; j < 16; ++j) { run += Gs[(tq * 16 + j) * 128 + k2]; loc[j] = run; }
              tot[tq * 128 + k2] = run;
              __syncthreads();
              float off = 0.f;
#pragma unroll
              for (int q = 0; q < 3; ++q) if (q < tq) off += tot[q * 128 + k2];
#pragma unroll
              for (int j = 0; j < 16; ++j) Gs[(tq * 16 + j) * 128 + k2] = loc[j] + off;
              if (!FULL && tq == 3) lseg += loc[15] + off; }
            __syncthreads();
            { float g31[16], gt[16];
#pragma unroll
              for (int j = 0; j < 16; j += 4) { const f32x4 a = *(LAS const f32x4*)(Gs + 31 * 128 + c0 + j), c = *(LAS const f32x4*)(Gs + t1 * 128 + c0 + j);
                  g31[j] = a.x; g31[j + 1] = a.y; g31[j + 2] = a.z; g31[j + 3] = a.w; gt[j] = c.x; gt[j + 1] = c.y; gt[j + 2] = c.z; gt[j + 3] = c.w; }
              float kx[16];
#pragma unroll
              for (int j = 0; j < 16; ++j) kx[j] = kk[j] * __expf(fminf(g31[j] - gt[j], 80.f));
              LAS bf16_t* kxt = (LAS bf16_t*)(ldsb + HL_KXT);
#pragma unroll
              for (int j = 0; j < 16; ++j) kxt[(c0 + j) * 72 + ((((t1 >> 3) ^ (tid & 7)) << 3) | (t1 & 7))] = f2bf(kx[j]);
              { const u32x4 ia = pia, ib = pib; const unsigned iw[8] = {ia.x, ia.y, ia.z, ia.w, ib.x, ib.y, ib.z, ib.w};
                if (more) { pia = *(const u32x4*)(hnext + 2048); pib = *(const u32x4*)(hnext + 2048 + 8); }
                LAS bf16_t* it = (LAS bf16_t*)(ldsb + HL_IT);
#pragma unroll
                for (int j = 0; j < 16; ++j) it[(c0 + j) * 72 + ((((t1 >> 3) ^ (tid & 7)) << 3) | (t1 & 7))] = (bf16_t)((j & 1) ? (iw[j >> 1] >> 16) : (iw[j >> 1] & 0xffffu)); }
              if (t1 == 0) {
#pragma unroll
                  for (int j = 0; j < 16; ++j) { const float g63 = Gs[63 * 128 + c0 + j]; e2v[c0 + j] = __expf(g63 - g31[j]); decv[c0 + j] = __expf(g63); } }
              if (FULL) {
                  const u32x4 qa = *(const u32x4*)(hrow), qb = *(const u32x4*)(hrow + 8); const unsigned qw[8] = {qa.x, qa.y, qa.z, qa.w, qb.x, qb.y, qb.z, qb.w};
                  float qx[16];
#pragma unroll
                  for (int j = 0; j < 16; ++j) qx[j] = ((j & 1) ? bfhi(qw[j >> 1]) : bflo(qw[j >> 1])) * __expf(fminf(gt[j] - g31[j], 80.f));
                  LAS bf16_t* qxp = (LAS bf16_t*)(ldsb + HL_QX) + t1 * 136 + c0; LAS bf16_t* kxp = (LAS bf16_t*)(ldsb + HL_KX) + t1 * 136 + c0;
                  u32x4 w0, w1;
                  w0.x = cvt_pk_bf16(qx[0], qx[1]); w0.y = cvt_pk_bf16(qx[2], qx[3]); w0.z = cvt_pk_bf16(qx[4], qx[5]); w0.w = cvt_pk_bf16(qx[6], qx[7]);
                  w1.x = cvt_pk_bf16(qx[8], qx[9]); w1.y = cvt_pk_bf16(qx[10], qx[11]); w1.z = cvt_pk_bf16(qx[12], qx[13]); w1.w = cvt_pk_bf16(qx[14], qx[15]);
                  *(LAS u32x4*)qxp = w0; *(LAS u32x4*)(qxp + 8) = w1;
                  w0.x = cvt_pk_bf16(kx[0], kx[1]); w0.y = cvt_pk_bf16(kx[2], kx[3]); w0.z = cvt_pk_bf16(kx[4], kx[5]); w0.w = cvt_pk_bf16(kx[6], kx[7]);
                  w1.x = cvt_pk_bf16(kx[8], kx[9]); w1.y = cvt_pk_bf16(kx[10], kx[11]); w1.z = cvt_pk_bf16(kx[12], kx[13]); w1.w = cvt_pk_bf16(kx[14], kx[15]);
                  *(LAS u32x4*)kxp = w0; *(LAS u32x4*)(kxp + 8) = w1;
                  LAS bf16_t* stp = (LAS bf16_t*)(ldsb + HL_ST) + (wave * 16 + fi) * 136;
#pragma unroll
                  for (int kt = 0; kt < 8; ++kt) { const int k = kt * 16 + fkq * 4; const f32x4 gg = *(LAS const f32x4*)(Gs + 31 * 128 + k);
                      u32x2 w; w.x = cvt_pk_bf16(S[kt][0] * __expf(gg.x), S[kt][1] * __expf(gg.y)); w.y = cvt_pk_bf16(S[kt][2] * __expf(gg.z), S[kt][3] * __expf(gg.w));
                      *(LAS u32x2*)(stp + k) = w; }
              } }
            __syncthreads();
            if (FULL) {
                { const int tt = wave >> 1; LAS bf16_t* att = (LAS bf16_t*)(ldsb + HL_ATT);
                  const LAS bf16_t* qxa = (const LAS bf16_t*)(ldsb + HL_QX) + (tt * 16 + fi) * 136 + fkq * 8;
#pragma unroll
                  for (int u2 = 0; u2 < 2; ++u2) { const int st = 2 * (wave & 1) + u2; f32x4 acc = (f32x4){0.f, 0.f, 0.f, 0.f};
                      if (st <= tt) { const LAS bf16_t* kxb = (const LAS bf16_t*)(ldsb + HL_KX) + (st * 16 + fi) * 136 + fkq * 8;
#pragma unroll
                          for (int ks = 0; ks < 4; ++ks) acc = __builtin_amdgcn_mfma_f32_16x16x32_bf16(*(const LAS bf16x8*)(qxa + ks * 32), *(const LAS bf16x8*)(kxb + ks * 32), acc, 0, 0, 0);
                          if (st == tt) {
#pragma unroll
                              for (int r = 0; r < 4; ++r) if (fi > fkq * 4 + r) acc[r] = 0.f; } }
#pragma unroll
                      for (int r = 0; r < 4; ++r) att[(tt * 16 + fkq * 4 + r) * 72 + st * 16 + fi] = f2bf(acc[r]); } }
                __syncthreads();
                { LAS bf16_t* obuf = (LAS bf16_t*)(ldsb + HL_OBUF);
                  const LAS bf16_t* stb = (const LAS bf16_t*)(ldsb + HL_ST) + (wave * 16 + fi) * 136 + fkq * 8;
                  const LAS bf16_t* itb = (const LAS bf16_t*)(ldsb + HL_IT) + (wave * 16 + fi) * 72;
                  f32x4 oacc[4];
#pragma unroll
                  for (int tt = 0; tt < 4; ++tt) { f32x4 acc = (f32x4){0.f, 0.f, 0.f, 0.f};
                      const LAS bf16_t* qxa = (const LAS bf16_t*)(ldsb + HL_QX) + (tt * 16 + fi) * 136 + fkq * 8;
                      const LAS bf16_t* ata = (const LAS bf16_t*)(ldsb + HL_ATT) + (tt * 16 + fi) * 72 + fkq * 8;
#pragma unroll
                      for (int ks = 0; ks < 4; ++ks) acc = __builtin_amdgcn_mfma_f32_16x16x32_bf16(*(const LAS bf16x8*)(qxa + ks * 32), *(const LAS bf16x8*)(stb + ks * 32), acc, 0, 0, 0);
#pragma unroll
                      for (int ks = 0; ks < 2; ++ks) acc = __builtin_amdgcn_mfma_f32_16x16x32_bf16(*(const LAS bf16x8*)(ata + ks * 32), *(const LAS bf16x8*)(itb + (((ks * 4 + fkq) ^ (wave & 7)) << 3)), acc, 0, 0, 0);
                      oacc[tt] = acc; }
                  __syncthreads();
#pragma unroll
                  for (int tt = 0; tt < 4; ++tt)
#pragma unroll
                      for (int r = 0; r < 4; ++r) obuf[(tt * 16 + fkq * 4 + r) * 136 + wave * 16 + fi] = f2bf(oacc[tt][r]); }
            }
            { const LAS bf16_t* itb = (const LAS bf16_t*)(ldsb + HL_IT) + (wave * 16 + fi) * 72;
#pragma unroll
              for (int kt = 0; kt < 8; ++kt) { f32x4 acc = (f32x4){0.f, 0.f, 0.f, 0.f};
                  const LAS bf16_t* ka = (const LAS bf16_t*)(ldsb + HL_KXT) + (kt * 16 + fi) * 72;
#pragma unroll
                  for (int ks = 0; ks < 2; ++ks) acc = __builtin_amdgcn_mfma_f32_16x16x32_bf16(*(const LAS bf16x8*)(ka + (((ks * 4 + fkq) ^ (kt & 7)) << 3)), *(const LAS bf16x8*)(itb + (((ks * 4 + fkq) ^ (wave & 7)) << 3)), acc, 0, 0, 0);
                  const f32x4 dv = *(LAS const f32x4*)(decv + kt * 16 + fkq * 4), ev = *(LAS const f32x4*)(e2v + kt * 16 + fkq * 4);
                  S[kt] = dv * S[kt] + ev * acc; } }
            __syncthreads();
            if (FULL) {
                const LAS bf16_t* ob = (const LAS bf16_t*)(ldsb + HL_OBUF) + t1 * 136 + c0;
                const u32x4 oa = *(const LAS u32x4*)ob, ob2 = *(const LAS u32x4*)(ob + 8); const unsigned ow[8] = {oa.x, oa.y, oa.z, oa.w, ob2.x, ob2.y, ob2.z, ob2.w};
                const u32x4 ga = *(const u32x4*)(hrow + 3072), gb = *(const u32x4*)(hrow + 3072 + 8); const unsigned gw[8] = {ga.x, ga.y, ga.z, ga.w, gb.x, gb.y, gb.z, gb.w};
                float o[16]; float ss = 0.f;
#pragma unroll
                for (int j = 0; j < 16; ++j) { o[j] = (j & 1) ? bfhi(ow[j >> 1]) : bflo(ow[j >> 1]); ss += o[j] * o[j]; }
                ss += __shfl_xor(ss, 1); ss += __shfl_xor(ss, 2); ss += __shfl_xor(ss, 4);
                const float rs = rsqrtf(ss * (1.0f / 128.0f) + 1e-6f);
                u32x4 w0, w1; float v[16];
#pragma unroll
                for (int j = 0; j < 16; ++j) v[j] = o[j] * rs * onorm[c0 + j] * ((j & 1) ? bfhi(gw[j >> 1]) : bflo(gw[j >> 1]));
                w0.x = cvt_pk_bf16(v[0], v[1]); w0.y = cvt_pk_bf16(v[2], v[3]); w0.z = cvt_pk_bf16(v[4], v[5]); w0.w = cvt_pk_bf16(v[6], v[7]);
                w1.x = cvt_pk_bf16(v[8], v[9]); w1.y = cvt_pk_bf16(v[10], v[11]); w1.z = cvt_pk_bf16(v[12], v[13]); w1.w = cvt_pk_bf16(v[14], v[15]);
                bf16_t* og = OG + (row0 + t1) * DM + h * 128 + c0; *(u32x4*)og = w0; *(u32x4*)(og + 8) = w1;
                __syncthreads();
            }
        }
        if (!FULL) {
            float* sl = SLOC + (size_t)unit * 16384;
#pragma unroll
            for (int kt = 0; kt < 8; ++kt)
#pragma unroll
                for (int r = 0; r < 4; ++r) sl[(kt * 16 + fkq * 4 + r) * 128 + wave * 16 + fi] = S[kt][r];
            if (tq == 3) DSEG[(size_t)unit * 128 + k2] = __expf(lseg);
        }
    }
}

typedef float f32x16 __attribute__((ext_vector_type(16)));
__device__ __forceinline__ void sel_scores(const bf16_t* kp, const bf16x8 (&qf)[4], f32x16 (&S)[2]) {
#pragma unroll
    for (int h = 0; h < 2; ++h) { bf16x8 kf[4];
#pragma unroll
        for (int s = 0; s < 4; ++s) kf[s] = *(const bf16x8*)(kp + h * 2048 + s * 8);
        S[h] = (f32x16){0.f};
#pragma unroll
        for (int s = 0; s < 4; ++s) S[h] = __builtin_amdgcn_mfma_f32_32x32x16_bf16(kf[s], qf[s], S[h], 0, 0, 0); }
}
__device__ __forceinline__ float row_bound(const bf16x8 (&qf)[4], float gmax) {
    float ss = 0.f;
#pragma unroll
    for (int s = 0; s < 4; ++s)
#pragma unroll
        for (int j = 0; j < 8; ++j) { const float v = bf2f((unsigned short)qf[s][j]); ss += v * v; }
    ss += __shfl_xor(ss, 32);
    return sqrtf(ss) * 8.08f * gmax;
}
__device__ __forceinline__ float dpp_quad_sum(float v) {
    v += __int_as_float(__builtin_amdgcn_update_dpp(0, __float_as_int(v), 0xB1, 0xF, 0xF, true));
    v += __int_as_float(__builtin_amdgcn_update_dpp(0, __float_as_int(v), 0x4E, 0xF, 0xF, true));
    return v; }
__device__ __forceinline__ void phase_sel2(PK p, LAS unsigned char* ldsb, int wid_s) {
    const int tid = opaque_tid(wid_s), lane = tid & 63, wave = __builtin_amdgcn_readfirstlane(tid >> 6);
    const bf16_t* Q = (const bf16_t*)(p->ws + WS_Q); const bf16_t* KC = (const bf16_t*)(p->ws + WS_KC); unsigned* SELM = (unsigned*)(p->ws + WS_SELM);
    LAS float* imp = (LAS float*)(ldsb + wave * 8448);
    const int n = lane & 31, hi = lane >> 5, ql = n >> 2, g = n & 3;
    const int pim = (n & ~12) | ((n & 4) << 1) | ((n & 8) >> 1);
    const float gmax0 = wave_max(fabsf(p->in[14][lane]));
    for (int u = blockIdx.x; u < 2048; u += gridDim.x) {
        const int bh = u >> 8, ii = u & 255, qb = (bh & 1) ? 255 - ii : ii, b = bh >> 2, kvh = bh & 3;
        const int tq = qb * 64 + wave * 8 + ql, hd = kvh * 4 + g, row = b * SEQ + tq;
        const int nvq = tq >= 31 ? ((tq - 31) >> 4) + 1 : 0;
        const int tmaxw = qb * 64 + wave * 8 + 7; const int nvmaxw = tmaxw >= 31 ? ((tmaxw - 31) >> 4) + 1 : 0; const int ncb = (qb >= 16) ? (nvmaxw + 63) >> 6 : 0;
        bf16x8 qf[4];
#pragma unroll
        for (int s = 0; s < 4; ++s) qf[s] = *(const bf16x8*)(Q + (size_t)row * DM + hd * 64 + 32 * hi + 8 * s);
        const bf16_t* kbase = KC + (size_t)bh * 65536 + pim * 64 + 32 * hi;
        for (int i = lane; i < 8 * 264; i += 64) imp[i] = 0.f;
        const float mfix = row_bound(qf, gmax0);
        float l = 0.f;
        for (int blk = 0; blk < ncb; ++blk) { f32x16 S[2]; sel_scores(kbase + (size_t)blk * 4096, qf, S);
            f32x2v ls2 = (f32x2v){0.f, 0.f};
#pragma unroll
            for (int h = 0; h < 2; ++h)
#pragma unroll
                for (int r = 0; r < 16; r += 2) { const int kpos = blk * 64 + 32 * h + 16 * (r >> 3) + 8 * hi + (r & 7);
                    f32x2v pv; pv.x = (kpos < nvq) ? __builtin_amdgcn_exp2f(S[h][r] - mfix) : 0.f; pv.y = (kpos + 1 < nvq) ? __builtin_amdgcn_exp2f(S[h][r + 1] - mfix) : 0.f; ls2 += pv; }
            l += ls2.x + ls2.y; }
        l += __shfl_xor(l, 32);
        const float mfn = l > 0.f ? mfix + log2f(l) : INFINITY;
        for (int blk = 0; blk < ncb; ++blk) { f32x16 S[2]; sel_scores(kbase + (size_t)blk * 4096, qf, S);
#pragma unroll
            for (int h = 0; h < 2; ++h)
#pragma unroll
                for (int rg = 0; rg < 2; ++rg) { float pv[8];
#pragma unroll
                    for (int e = 0; e < 8; ++e) { const int kpos = blk * 64 + 32 * h + 16 * rg + 8 * hi + e; pv[e] = (kpos < nvq) ? __builtin_amdgcn_exp2f(S[h][8 * rg + e] - mfn) : 0.f; }
                    float s0 = (pv[0] + pv[1]) + (pv[2] + pv[3]), s1 = pv[3] + (pv[4] + pv[5]) + (pv[6] + pv[7]), s2 = pv[7];
                    s0 = dpp_quad_sum(s0); s1 = dpp_quad_sum(s1); s2 = dpp_quad_sum(s2);
                    if (g == 0) { const int j0 = (blk * 64 + 32 * h + 16 * rg + 8 * hi) >> 2; LAS float* ip = imp + ql * 264 + j0;
                        atomicAdd((float*)ip, s0); atomicAdd((float*)(ip + 1), s1); atomicAdd((float*)(ip + 2), s2); } } }
        const int cur = qb;
#pragma unroll 1
        for (int q = 0; q < 8; ++q) {
            unsigned bits[4]; bool valid[4], sel[4];
#pragma unroll
            for (int i2 = 0; i2 < 4; ++i2) { const int j = lane + 64 * i2; valid[i2] = j <= cur; const float im = imp[q * 264 + j];
                const bool forced = (j == 0) || (j == cur) || (j == cur - 1);
                bits[i2] = valid[i2] ? __float_as_uint(forced ? 1e9f : im) : 0u; sel[i2] = valid[i2]; }
            if (cur + 1 > 16) {
                unsigned T = 0u;
#define TK_SEARCH(NI2) for (int bit = 30; bit >= 0; --bit) { const unsigned cand = T | (1u << bit); int cnt = 0; \
                    _Pragma("unroll") for (int i2 = 0; i2 < NI2; ++i2) cnt += __popcll(__ballot(bits[i2] >= cand)); \
                    if (cnt >= 16) T = cand; }
                const int ni2 = (cur >> 6) + 1;
                if (ni2 == 1) { TK_SEARCH(1) } else if (ni2 == 2) { TK_SEARCH(2) } else if (ni2 == 3) { TK_SEARCH(3) } else { TK_SEARCH(4) }
#undef TK_SEARCH
                int cgt = 0;
#pragma unroll
                for (int i2 = 0; i2 < 4; ++i2) cgt += __popcll(__ballot(bits[i2] > T));
                int remaining = 16 - cgt;
                const unsigned long long ltmask = (1ull << lane) - 1ull;
#pragma unroll
                for (int i2 = 0; i2 < 4; ++i2) { const bool eq = (bits[i2] == T) && valid[i2]; const unsigned long long ball = __ballot(eq); const int rank = __popcll(ball & ltmask);
                    sel[i2] = valid[i2] && ((bits[i2] > T) || (eq && rank < remaining)); remaining -= min(remaining, (int)__popcll(ball)); }
            }
            const size_t item = (size_t)bh * SEQ + qb * 64 + wave * 8 + q;
#pragma unroll
            for (int i2 = 0; i2 < 4; ++i2) { const unsigned long long ball = __ballot(sel[i2]);
                if (lane == 0) { SELM[item * 8 + 2 * i2] = (unsigned)ball; SELM[item * 8 + 2 * i2 + 1] = (unsigned)(ball >> 32); } }
        }
    }
}

__device__ __forceinline__ void fc_ldk(LAS const unsigned char* tb, int kro, bf16x8 (&kf)[2][4]) {
#pragma unroll
    for (int h = 0; h < 2; ++h)
#pragma unroll
        for (int s = 0; s < 4; ++s) kf[h][s] = *(LAS const bf16x8*)(tb + kro + h * 32 * 144 + s * 16);
}
__device__ __forceinline__ void fc_ldv(LAS const unsigned char* tb, int vro, bf16x8 (&vf)[2][2][2]) {
#pragma unroll
    for (int h = 0; h < 2; ++h)
#pragma unroll
        for (int ks = 0; ks < 2; ++ks)
#pragma unroll
            for (int dh = 0; dh < 2; ++dh) vf[h][ks][dh] = *(LAS const bf16x8*)(tb + vro + dh * 32 * 144 + (h * 32 + ks * 16) * 2);
}
template <int MODE> __device__ __forceinline__ void flash_compute1(LAS const unsigned char* tb, int blk, bool edge, int kro, int vro, bool rowsel, const bf16x8 (&qf)[4], int tq, int nvq, int hi, float mfix, f32x16 (&O)[2], float& l) {
    f32x16 S[2];
    { bf16x8 kf[2][4]; fc_ldk(tb, kro, kf);
#pragma unroll
      for (int h = 0; h < 2; ++h) { S[h] = (f32x16){0.f};
#pragma unroll
          for (int s = 0; s < 4; ++s) S[h] = __builtin_amdgcn_mfma_f32_32x32x16_bf16(kf[h][s], qf[s], S[h], 0, 0, 0); } }
    bf16x8 vf[2][2][2]; fc_ldv(tb, vro, vf);
    if (edge) {
#pragma unroll
        for (int h = 0; h < 2; ++h)
#pragma unroll
            for (int r = 0; r < 16; ++r) { const int kpos = blk * 64 + 32 * h + 16 * (r >> 3) + 8 * hi + (r & 7); bool valid;
                if (MODE == 0) valid = kpos < nvq; else if (MODE == 1) valid = (kpos <= tq); else valid = (kpos <= tq) && (kpos > tq - 512);
                S[h][r] = valid ? S[h][r] : -INFINITY; }
    }
    const float mu = (MODE == 1) ? (rowsel ? mfix : INFINITY) : mfix;
    const f32x2v mu2 = (f32x2v){mu, mu};
    f32x2v ls2 = (f32x2v){0.f, 0.f};
#pragma unroll
    for (int h = 0; h < 2; ++h)
#pragma unroll
        for (int r = 0; r < 16; r += 2) { const f32x2v d = (f32x2v){S[h][r], S[h][r + 1]} - mu2; f32x2v pv; pv.x = __builtin_amdgcn_exp2f(d.x); pv.y = __builtin_amdgcn_exp2f(d.y);
            S[h][r] = pv.x; S[h][r + 1] = pv.y; ls2 += pv; }
    l += ls2.x + ls2.y;
#pragma unroll
    for (int h = 0; h < 2; ++h)
#pragma unroll
        for (int ks = 0; ks < 2; ++ks) { u32x4 w; w.x = cvt_pk_bf16(S[h][8 * ks], S[h][8 * ks + 1]); w.y = cvt_pk_bf16(S[h][8 * ks + 2], S[h][8 * ks + 3]); w.z = cvt_pk_bf16(S[h][8 * ks + 4], S[h][8 * ks + 5]); w.w = cvt_pk_bf16(S[h][8 * ks + 6], S[h][8 * ks + 7]);
            const bf16x8 pf = __builtin_bit_cast(bf16x8, w);
#pragma unroll
            for (int dh = 0; dh < 2; ++dh) O[dh] = __builtin_amdgcn_mfma_f32_32x32x16_bf16(vf[h][ks][dh], pf, O[dh], 0, 0, 0); }
}
constexpr int AL_KV = 0, AL_SLOT = 18432, AL_WU = 55296  , AL_WAVE = 55808  , AL_ACC = 68096  ;
template <int MODE> __device__ __forceinline__ void flash_blocks(const bf16_t* Kb, const bf16_t* Vt, int ldv, int base, int nblk, LAS const int* list, LAS const unsigned* qm, LAS const unsigned* wun,
                                                                LAS unsigned char* ldsb, int tid, const bf16x8 (&qf)[4], int tq, int nvq, int qb, int wave, int ql, int lane, float mfix, f32x16 (&O)[2], float& l) {
    const int m_ = lane & 31, hi = lane >> 5;
    const int pim = (m_ & ~12) | ((m_ & 4) << 1) | ((m_ & 8) >> 1);
    const int kro = pim * 144 + 64 * hi;
    const int vro = 9216 + m_ * 144 + 16 * hi;
    const int srow = tid >> 3, sch = tid & 7;
    const bf16_t* kg = Kb + (size_t)tid * 8;
    const bf16_t* vg = Vt + (size_t)srow * ldv + sch * 8;
    const int sdst = srow * 144 + sch * 16;
    const int tminw = qb * 64 + wave * 8, tmaxw = tminw + 7;
    const int nvminw = tminw >= 31 ? ((tminw - 31) >> 4) + 1 : 0, nvmaxw = tmaxw >= 31 ? ((tmaxw - 31) >> 4) + 1 : 0;
#define FB_BLK(i) ((MODE == 1) ? list[(i)] : base + (i))
    u32x4 ra[3], rb[3];
#pragma unroll
    for (int k = 0; k < 3; ++k) { ra[k] = (u32x4){0u, 0u, 0u, 0u}; rb[k] = ra[k]; if (k < nblk) { const int nb = FB_BLK(k); ra[k] = *(const u32x4*)(kg + (size_t)nb * 4096); rb[k] = *(const u32x4*)(vg + (size_t)nb * 64); } }
    for (int i0 = 0; i0 < nblk; i0 += 3) {
        __syncthreads();
#pragma unroll
        for (int k = 0; k < 3; ++k) if (i0 + k < nblk) { LAS unsigned char* sl = ldsb + AL_KV + k * AL_SLOT; *(LAS u32x4*)(sl + sdst) = ra[k]; *(LAS u32x4*)(sl + 9216 + sdst) = rb[k]; }
        __syncthreads();
#pragma unroll
        for (int k = 0; k < 3; ++k) if (i0 + 3 + k < nblk) { const int nb = FB_BLK(i0 + 3 + k); ra[k] = *(const u32x4*)(kg + (size_t)nb * 4096); rb[k] = *(const u32x4*)(vg + (size_t)nb * 64); }
#pragma unroll 1
        for (int k = 0; k < 3; ++k) { if (i0 + k >= nblk) break;
            const int blk = FB_BLK(i0 + k); bool need = true, edge;
            if (MODE == 0) { need = blk * 64 < nvmaxw; edge = !(blk * 64 + 63 < nvminw); }
            else if (MODE == 1) { need = (wun[blk >> 5] >> (blk & 31)) & 1u; edge = (blk == qb); }
            else edge = (blk == qb) || (blk == qb - 8);
            if (need) { bool rs = true; if (MODE == 1) rs = (qm[ql * 8 + (blk >> 5)] >> (blk & 31)) & 1u;
                flash_compute1<MODE>(ldsb + AL_KV + k * AL_SLOT, blk, edge, kro, vro, rs, qf, tq, nvq, hi, mfix, O, l); } }
    }
#undef FB_BLK
}
__device__ __forceinline__ void phase_att(PK p, LAS unsigned char* ldsb, int wid_s) {
    const int tid = opaque_tid(wid_s), lane = tid & 63, wave = __builtin_amdgcn_readfirstlane(tid >> 6);
    const bf16_t* Q = (const bf16_t*)(p->ws + WS_Q); const bf16_t* QR = (const bf16_t*)(p->ws + WS_QR); bf16_t* AO = (bf16_t*)(p->ws + WS_AO);
    const float* GATES = (const float*)(p->ws + WS_GATES); const unsigned* SELM = (const unsigned*)(p->ws + WS_SELM);
    const bf16_t* KC = (const bf16_t*)(p->ws + WS_KC); const bf16_t* VCt = (const bf16_t*)(p->ws + WS_VC);
    const bf16_t* KS = (const bf16_t*)(p->ws + WS_KV + 32 * MiB); const bf16_t* VSt = (const bf16_t*)(p->ws + WS_KV + 48 * MiB);
    const bf16_t* KW = (const bf16_t*)(p->ws + WS_KV + 64 * MiB); const bf16_t* VWt = (const bf16_t*)(p->ws + WS_KV + 80 * MiB);
    LAS unsigned* wu = (LAS unsigned*)(ldsb + AL_WU);
    LAS unsigned* qm = (LAS unsigned*)(ldsb + AL_WAVE + wave * 1536); LAS unsigned* wun = qm + 64; LAS int* list = (LAS int*)(qm + 128);
    const int n = lane & 31, hi = lane >> 5, ql = n >> 2, g = n & 3;
    const float* kn_ = p->in[14];
    const float gmax0 = wave_max(fabsf(kn_[lane])), gmax12 = wave_max(fmaxf(fabsf(kn_[64 + lane]), fabsf(kn_[128 + lane])));
    for (int u = blockIdx.x; u < 2048; u += gridDim.x) {
        const int bh = u >> 8, ii = u & 255, qb = (bh & 1) ? 255 - ii : ii, b = bh >> 2, kvh = bh & 3;
        const int tq = qb * 64 + wave * 8 + ql, hd = kvh * 4 + g, row = b * SEQ + tq;
        const int nvq = tq >= 31 ? ((tq - 31) >> 4) + 1 : 0;
        const int tmaxw = qb * 64 + wave * 8 + 7; const int nvmaxw = tmaxw >= 31 ? ((tmaxw - 31) >> 4) + 1 : 0;
        { const unsigned mw = SELM[((size_t)bh * SEQ + qb * 64 + wave * 8 + (lane >> 3)) * 8 + (lane & 7)];
          qm[lane] = mw;
          unsigned uw = mw; uw |= __shfl_xor(uw, 8); uw |= __shfl_xor(uw, 16); uw |= __shfl_xor(uw, 32);
          if (lane < 8) { wun[lane] = uw; wu[wave * 8 + lane] = uw; } }
        __syncthreads();
        int nsel = 0;
        { unsigned bu = 0u;
#pragma unroll
          for (int w2 = 0; w2 < 8; ++w2) bu |= wu[w2 * 8 + (lane & 7)];
          const int cnt = __popc(bu); int pre = 0;
#pragma unroll
          for (int w2 = 0; w2 < 8; ++w2) { const int c2 = __shfl(cnt, w2); if (w2 < (lane & 7)) pre += c2; nsel += c2; }
          if (lane < 8) { unsigned ww = bu; int k = pre; while (ww) { const int bpos = __ffs(ww) - 1; list[k++] = lane * 32 + bpos; ww &= ww - 1; } } }
        nsel = __builtin_amdgcn_readfirstlane(nsel);
        float gate[3];
#pragma unroll
        for (int br = 0; br < 3; ++br) gate[br] = GATES[(size_t)row * 48 + br * 16 + hd];
        LAS float* oacc = (LAS float*)(ldsb + AL_ACC + wave * 8192) + lane;
        bf16x8 qf[4];
#pragma unroll
        for (int s = 0; s < 4; ++s) qf[s] = *(const bf16x8*)(Q + (size_t)row * DM + hd * 64 + 32 * hi + 8 * s);
        float mfix = row_bound(qf, gmax0);
        { f32x16 O[2]; O[0] = (f32x16){0.f}; O[1] = (f32x16){0.f}; float l = 0.f;
          const int tmax = qb * 64 + 63; const int nvmax = ((tmax - 31) >> 4) + 1; const int ncb = (nvmax + 63) >> 6;
          flash_blocks<0>(KC + (size_t)bh * 65536, VCt + (size_t)bh * 65536, 1024, 0, ncb, list, qm, wun, ldsb, tid, qf, tq, nvq, qb, wave, ql, lane, mfix, O, l);
          l += __shfl_xor(l, 32); const float sc = l > 0.f ? gate[0] / l : 0.f;
#pragma unroll
          for (int dh = 0; dh < 2; ++dh)
#pragma unroll
              for (int r = 0; r < 16; ++r) oacc[(dh * 16 + r) * 64] = O[dh][r] * sc; }
#pragma unroll
        for (int s = 0; s < 4; ++s) qf[s] = *(const bf16x8*)(QR + (size_t)row * DM + hd * 64 + 32 * hi + 8 * s);
        mfix = row_bound(qf, gmax12);
        { f32x16 O[2]; O[0] = (f32x16){0.f}; O[1] = (f32x16){0.f}; float l = 0.f;
          flash_blocks<1>(KS + (size_t)bh * SEQ * 64, VSt + (size_t)bh * SEQ * 64, SEQ, 0, nsel, list, qm, wun, ldsb, tid, qf, tq, nvq, qb, wave, ql, lane, mfix, O, l);
          l += __shfl_xor(l, 32); const float sc = l > 0.f ? gate[1] / l : 0.f;
#pragma unroll
          for (int dh = 0; dh < 2; ++dh)
#pragma unroll
              for (int r = 0; r < 16; ++r) oacc[(dh * 16 + r) * 64] += O[dh][r] * sc; }
        { f32x16 O[2]; O[0] = (f32x16){0.f}; O[1] = (f32x16){0.f}; float l = 0.f;
          const int b0 = max(0, qb - 8);
          flash_blocks<2>(KW + (size_t)bh * SEQ * 64, VWt + (size_t)bh * SEQ * 64, SEQ, b0, qb - b0 + 1, list, qm, wun, ldsb, tid, qf, tq, nvq, qb, wave, ql, lane, mfix, O, l);
          l += __shfl_xor(l, 32); const float sc = l > 0.f ? gate[2] / l : 0.f;
          bf16_t* op = AO + (size_t)row * DM + hd * 64 + 4 * hi;
#pragma unroll
          for (int dh = 0; dh < 2; ++dh)
#pragma unroll
              for (int rq = 0; rq < 4; ++rq) { float v[4];
#pragma unroll
                  for (int e = 0; e < 4; ++e) v[e] = oacc[(dh * 16 + rq * 4 + e) * 64] + O[dh][rq * 4 + e] * sc;
                  u32x2 w; w.x = cvt_pk_bf16(v[0], v[1]); w.y = cvt_pk_bf16(v[2], v[3]); *(u32x2*)(op + 32 * dh + 8 * rq) = w; } }
    }
}

#define XB_TMO      128
#define XB_XCNT(j)  (256  + 64 * (j))
#define XB_XSUB(j)  (1280 + 64 * (j))
#define XB_XGEN(j)  (2304 + 64 * (j))
#define XB_TOP      3328
#define XB_TOPGEN   3392
#define XCD_BAR_WORDS 3456
#define XB_SPIN_CAP (1u << 18)

__device__ __forceinline__ unsigned xb_ld(unsigned* p)              { return __hip_atomic_load(p, __ATOMIC_RELAXED, __HIP_MEMORY_SCOPE_AGENT); }
__device__ __forceinline__ unsigned xb_add(unsigned* p, unsigned v) { return __hip_atomic_fetch_add(p, v, __ATOMIC_RELAXED, __HIP_MEMORY_SCOPE_AGENT); }
__device__ __forceinline__ unsigned xb_xcc_id() { return (unsigned)__builtin_amdgcn_s_getreg((3 << 11) | 20) & 0xFu; }
#define XB_SPIN(cond, bar) do { unsigned _sp = 0; while (cond) { __builtin_amdgcn_s_sleep(1); \
    if ((++_sp & 255u) == 0u) { if (xb_ld(&(bar)[XB_TMO])) break; if (_sp > XB_SPIN_CAP) { atomicAdd(&(bar)[XB_TMO], 1u); break; } } } } while (0)

struct XcdBarrier {
    unsigned* bar; unsigned x;
    volatile LAS unsigned* st;
};

__device__ __forceinline__ XcdBarrier xcd_barrier_post(unsigned* bar, volatile LAS unsigned* st, bool is0) {
    XcdBarrier b; b.bar = bar; b.x = xb_xcc_id(); b.st = st;
    if (is0) (void)xb_add(&bar[XB_XCNT(b.x)], 1u);
    return b;
}
__device__ __forceinline__ void xcd_barrier_complete(unsigned* bar, unsigned x, unsigned& nloc, unsigned& nx) {
    const unsigned G = gridDim.x * gridDim.y * gridDim.z;
    unsigned sum, cnt, mine, sp = 0u;
    for (;;) {
        sum = 0u; cnt = 0u; mine = 0u;
#pragma unroll
        for (unsigned j = 0; j < 16; ++j) { const unsigned c = xb_ld(&bar[XB_XCNT(j)]); sum += c; cnt += (c > 0u) ? 1u : 0u; mine = (j == x) ? c : mine; }
        if (sum == G) break;
        __builtin_amdgcn_s_sleep(1);
        if ((++sp & 255u) == 0u) { if (xb_ld(&bar[XB_TMO])) break; if (sp > XB_SPIN_CAP) { atomicAdd(&bar[XB_TMO], 1u); break; } }
    }
    nloc = mine > 0u ? mine : 1u; nx = cnt > 0u ? cnt : 1u;
}

__device__ __attribute__((noinline)) void xcd_barrier(const XcdBarrier b, bool is0) {
    asm volatile("s_waitcnt vmcnt(0)" ::: "memory");
    __syncthreads();
    if (is0) {
        unsigned* bar = b.bar;
        __builtin_amdgcn_s_waitcnt(0);
        unsigned nloc = b.st[0], nx = b.st[1];
        if (nloc == 0u) { xcd_barrier_complete(bar, b.x, nloc, nx); b.st[0] = nloc; b.st[1] = nx; }
        const unsigned old = xb_add(&bar[XB_XSUB(b.x)], 1u);
        const unsigned gen = old / nloc;
        if (old + 1u == (gen + 1u) * nloc) {
            __builtin_amdgcn_fence(__ATOMIC_RELEASE, "agent");
            asm volatile("s_waitcnt vmcnt(0)" ::: "memory");
            const unsigned og = xb_add(&bar[XB_TOP], 1u);
            const unsigned tg = og / nx;
            if (og + 1u == (tg + 1u) * nx) xb_add(&bar[XB_TOPGEN], 1u);
            else XB_SPIN(xb_ld(&bar[XB_TOPGEN]) == tg, bar);
            __builtin_amdgcn_fence(__ATOMIC_ACQUIRE, "agent");
            xb_add(&bar[XB_XGEN(b.x)], 1u);
            asm volatile("s_waitcnt vmcnt(0)" ::: "memory");
        } else {
            XB_SPIN(xb_ld(&bar[XB_XGEN(b.x)]) == gen, bar);
            __builtin_amdgcn_fence(__ATOMIC_ACQUIRE, "agent");
            asm volatile("s_waitcnt vmcnt(0)" ::: "memory");
        }
    }
    __syncthreads();
}

__global__ void __launch_bounds__(NTHR, 2) yoco_fwd(Params p_unused) {
    extern __shared__ __attribute__((aligned(16))) unsigned char lds_raw[];
    LAS unsigned char* ldsb = (LAS unsigned char*)lds_raw;
    cg::grid_group grid = cg::this_grid();
    const int wid_s = __builtin_amdgcn_readfirstlane((int)threadIdx.x >> 6);
    volatile LAS unsigned* bst = (volatile LAS unsigned*)(ldsb + LDS_BYTES - 16);
    { const int t0_ = opaque_tid(wid_s); if (t0_ == 0) { bst[0] = 0u; bst[1] = 0u; } __syncthreads(); }
    XcdBarrier xbar; { PK pk = fresh_pk(); xbar = xcd_barrier_post((unsigned*)(pk->ws + WS_BAR), bst, opaque_tid(wid_s) == 0); }
#define GSYNC() xcd_barrier(xbar, opaque_tid(wid_s) == 0)
#define FRESH() PK pk = fresh_pk(); unsigned char* ws = pk->ws; float* mods = (float*)(ws + WS_MODS); float* SS = (float*)(ws + WS_SS); const float* BIAS = (const float*)(ws + WS_BIAS); \
    const f32x2v* cs = (const f32x2v*)(ws + WS_CS); bf16_t* XB = (bf16_t*)(ws + WS_XB); bf16_t* XB2 = (bf16_t*)(ws + WS_XB2); bf16_t* HB = (bf16_t*)(ws + WS_HB); bf16_t* OB = (bf16_t*)(ws + WS_OB); bf16_t* HID = (bf16_t*)(ws + WS_HID); \
    float* xout = pk->out; (void)mods; (void)SS; (void)BIAS; (void)cs; (void)XB; (void)XB2; (void)HB; (void)OB; (void)HID; (void)xout;

    { PK pk = fresh_pk(); phase0(pk, ldsb, wid_s); }
    GSYNC();
    if (fresh_pk()->out == nullptr) grid.sync();
    { PK pk = fresh_pk(); phase1(pk, ldsb, wid_s); }
    GSYNC();

#pragma unroll 1
    for (int layer = 0; layer < 4; ++layer) {
        if (layer < 2) {
            { FRESH(); EpiHin E{HB, SS + (size_t)(2 * layer) * MR, BIAS + BO_HIN + layer * 8192};
              RUN_GEMM(EpiHin, E, XB, ws + WS_WHIN + (size_t)layer * 4096 * 1024 * 2, MR, 4096, 1024, 1024); }
            GSYNC();
            { FRESH(); phase_hgrn<false>(HB, OB, (float*)(ws + WS_SLOC), (float*)(ws + WS_DSEG), pk->in[7], pk->in[8] + layer * 128, layer, ldsb, wid_s); }
            GSYNC();
            { FRESH(); phase_hgrn<true>(HB, OB, (float*)(ws + WS_SLOC), (float*)(ws + WS_DSEG), pk->in[7], pk->in[8] + layer * 128, layer, ldsb, wid_s); }
            GSYNC();
            { FRESH(); const float* xold = (layer == 0) ? pk->in[0] : xout;
              EpiRes<false> E{xold, xout, mods + (2 * layer) * 6144 + 2048, SS + (size_t)(2 * layer + 1) * MR, XB, BIAS + BO_GM + (2 * layer + 1) * 2048, nullptr, nullptr};
              RUN_GEMM(EpiRes<false>, E, OB, ws + WS_WHOUT + (size_t)layer * 1024 * 1024 * 2, MR, 1024, 1024, 1024); }
            GSYNC();
        } else {
            const int bl = layer - 2;
            if (bl == 0) {
                { FRESH(); EpiKV E{(bf16_t*)(ws + WS_KV), SS + (size_t)4 * MR, BIAS + BO_KV, pk->in[14], cs};
                  RUN_GEMM(EpiKV, E, XB2, ws + WS_WKV, MR, 1536, 1024, 1024); }
            }
            { FRESH(); EpiQ E{(bf16_t*)(ws + WS_Q), (bf16_t*)(ws + WS_QR), (float*)(ws + WS_GATES), SS + (size_t)(2 * layer) * MR, BIAS + BO_Q + bl * 2560, pk->in[19] + bl * 64, cs};
              RUN_GEMM(EpiQ, E, XB, ws + WS_WQ + (size_t)bl * 1280 * 1024 * 2, MR, 1280, 1024, 1024); }
            GSYNC();
            if (bl == 0) {
#pragma unroll 1
                for (int j = 0; j < 2; ++j) { FRESH(); EpiC1 E{(bf16_t*)(ws + WS_CHID) + (size_t)j * 8192 * 256, BIAS + BO_C1 + j * 256};
                    RUN_GEMM_AT(EpiC1, E, ws + WS_KV + (size_t)j * 16 * MiB, ws + WS_WC1 + (size_t)j * 256 * 2048 * 2, 8192, 256, 2048, 1024, (gridDim.x >= 64) ? 32 * j : 0); }
                GSYNC();
#pragma unroll 1
                for (int j = 0; j < 2; ++j) { FRESH(); EpiC2 E{(bf16_t*)(ws + (j == 0 ? WS_KC : WS_VC)), j == 0 ? pk->in[14] : nullptr, j};
                    RUN_GEMM_AT(EpiC2, E, ws + WS_CHID + (size_t)j * 8192 * 256 * 2, ws + WS_WC2 + (size_t)j * 256 * 256 * 2, 8192, 256, 256, 256, (gridDim.x >= 64) ? 32 * j : 0); }
                GSYNC();
            }
            { PK pk = fresh_pk(); phase_sel2(pk, ldsb, wid_s); }
            GSYNC();
            { PK pk = fresh_pk(); phase_att(pk, ldsb, wid_s); }
            GSYNC();
            { FRESH(); EpiRes<false> E{xout, xout, mods + (2 * layer) * 6144 + 2048, SS + (size_t)(2 * layer + 1) * MR, XB, BIAS + BO_GM + (2 * layer + 1) * 2048, nullptr, nullptr};
              RUN_GEMM(EpiRes<false>, E, ws + WS_AO, ws + WS_WAO + (size_t)bl * 1024 * 1024 * 2, MR, 1024, 1024, 1024); }
            GSYNC();
        }
        { FRESH(); EpiFin E{HID, SS + (size_t)(2 * layer + 1) * MR, BIAS + BO_FIN + layer * 11264};
          RUN_GEMM(EpiFin, E, XB, ws + WS_WFIN + (size_t)layer * 5632 * 1024 * 2, MR, 5632, 1024, 1024); }
        GSYNC();
        { FRESH(); const bool last = (layer == 3);
          float* sso = last ? SS : SS + (size_t)(2 * layer + 2) * MR; const float* gmn = BIAS + BO_GM + (last ? 0 : (2 * layer + 2) * 2048);
          const bf16_t* Wt = (const bf16_t*)(ws + WS_WFOUT + (size_t)layer * 1024 * 2816 * 2);
          if (layer == 1) { EpiRes<true> E{xout, xout, mods + (2 * layer + 1) * 6144 + 2048, sso, XB, gmn, XB2, BIAS + BO_GM + 8 * 2048};
              RUN_GEMM(EpiRes<true>, E, HID, Wt, MR, 1024, 2816, 2816); }
          else { EpiRes<false> E{xout, xout, mods + (2 * layer + 1) * 6144 + 2048, sso, XB, gmn, nullptr, nullptr};
              RUN_GEMM(EpiRes<false>, E, HID, Wt, MR, 1024, 2816, 2816); } }
        if (layer < 3) GSYNC();
    }
}

extern "C" void kernel_launch(void* const* d_in, const int* in_sizes, int n_in, void* d_out, int out_size, void* d_ws, size_t ws_size, hipStream_t stream) {
    static int grid = 0;
    if (grid == 0) {
        if (n_in != 23 || out_size != MR * DM || ws_size < WS_END) { fprintf(stderr, "kernel_launch: unexpected problem (n_in %d out %d ws %zu)\n", n_in, out_size, ws_size); grid = -1; return; }
        int dev = 0, cus = 0, per_cu = 0;
        hipGetDevice(&dev); hipDeviceGetAttribute(&cus, hipDeviceAttributeMultiprocessorCount, dev);
        hipFuncSetAttribute((const void*)yoco_fwd, hipFuncAttributeMaxDynamicSharedMemorySize, LDS_BYTES);
        hipOccupancyMaxActiveBlocksPerMultiprocessor(&per_cu, (const void*)yoco_fwd, NTHR, LDS_BYTES);
        if (per_cu < 1) per_cu = 1;
        grid = cus * per_cu;
        fprintf(stderr, "kernel_launch: grid %d (cus %d x %d)\n", grid, cus, per_cu);
    }
    if (grid < 0) return;
    (void)hipMemsetAsync((char*)d_ws + WS_BAR, 0, 16384, stream);
    Params p{};
    for (int i = 0; i < 23; ++i) p.in[i] = (const float*)d_in[i];
    p.out = (float*)d_out; p.ws = (unsigned char*)d_ws;
    void* args[] = {&p};
    hipError_t e = hipLaunchCooperativeKernel((const void*)yoco_fwd, dim3(grid), dim3(NTHR), args, LDS_BYTES, stream);
    if (e != hipSuccess) fprintf(stderr, "cooperative launch failed: %s (grid %d)\n", hipGetErrorString(e), grid);
}
```

```cpp
#include <hip/hip_runtime.h>
#include <hip/hip_cooperative_groups.h>
#include <cstdio>
#include <cstdint>
namespace cg = cooperative_groups;
__device__ __forceinline__ int opaque_tid(int wid) { int l; asm volatile("v_mbcnt_lo_u32_b32 %0, -1, 0\n\tv_mbcnt_hi_u32_b32 %0, -1, %0" : "=v"(l)); int w = wid; asm volatile("" : "+s"(w)); return (w << 6) | l; }
namespace pg8 {
#define PG8_LAS __attribute__((address_space(3)))
typedef unsigned short bf16_t;
typedef short bf16x8 __attribute__((ext_vector_type(8)));
typedef float f32x4 __attribute__((ext_vector_type(4)));
typedef unsigned u32x4 __attribute__((ext_vector_type(4)));
constexpr int BM = 256, BK = 64, HALF = 128, HTB = HALF * BK * 2  , STAGE_BYTES = 8 * HTB, NXCD = 8, WGM = 8;

__host__ __device__ __forceinline__ int lds_byte(int r, int c) { const int st = (r >> 4) * 2 + (c >> 5), rr = r & 15, cc = c & 31, ob = rr * 64 + cc * 2; return st * 1024 + (ob ^ (((ob >> 9) & 1) << 5)); }
__host__ __device__ __forceinline__ void stage_rc(int b, int& R, int& C) { const int st = b / 1024, sb = b % 1024, swz = sb ^ (((sb >> 9) & 1) << 5); R = (st >> 1) * 16 + swz / 64; C = (st & 1) * 32 + (swz % 64) / 2; }
__host__ __device__ __forceinline__ int perm32(int rho) { const int n = rho >> 4, i = rho & 15; return 8 * (i >> 2) + 4 * n + (i & 3); }

struct Unit { int pm, pn; };
struct Gemm { const bf16_t* A; const bf16_t* Bt; int M, N, K, lda; };

struct StaticOrder {
    int nM, nN, nwg, G, c;
    __host__ __device__ void init(int M, int N, int G_, int c_) { nM = M / BM; nN = N / BM; nwg = nM * nN; G = G_; c = c_; }
    __host__ __device__ bool next(int i, Unit& u) const {
        const long L = (long)i * G + c; if (c < 0 || L >= nwg) return false;
        int wgid = (int)L; { const int q = nwg / NXCD, r = nwg % NXCD, xcd = wgid % NXCD, off = wgid / NXCD; wgid = (xcd < r ? xcd * (q + 1) : r * (q + 1) + (xcd - r) * q) + off; }
        const int nig = WGM * nN, gid = wgid / nig, fm = gid * WGM, gsz = (nM - fm) < WGM ? (nM - fm) : WGM;
        u.pm = fm + ((wgid % nig) % gsz); u.pn = (wgid % nig) / gsz; return true;
    }
    __device__ __forceinline__ void a_ready(const Unit&) const {}
    __device__ __forceinline__ void done(const Unit&) const {}
};

typedef float f32x2c __attribute__((ext_vector_type(2))); typedef __bf16 bf16x2c __attribute__((ext_vector_type(2)));
__device__ __forceinline__ unsigned cvt_pk_bf16(float lo, float hi) { f32x2c v = {lo, hi}; bf16x2c b = __builtin_convertvector(v, bf16x2c); return __builtin_bit_cast(unsigned, b); }
typedef float f32x2 __attribute__((ext_vector_type(2)));
template <class Epi, class Sched, bool ALIGN_EPI = false, bool SP2 = false>
__device__ __forceinline__ void gemm_phase(PG8_LAS unsigned char* lds, const Gemm g, const Sched& S, const Epi& E, int wid_) {
    const int tid = opaque_tid(wid_), wid = __builtin_amdgcn_readfirstlane(tid >> 6), lane = tid & 63, wr = wid >> 2, wc = wid & 3, fr = lane & 15, fq = lane >> 4;
    const int K = g.K, nt = K / BK;
    unsigned voffA, voffB;
    { int R, C; stage_rc(tid * 16, R, C); const int Rb = Epi::PERM ? ((R & ~31) + perm32(R & 31)) : R;
      voffA = (unsigned)(R * g.lda + C) * 2u; voffB = (unsigned)(Rb * K + C) * 2u; }
    const size_t stepA = (size_t)64 * g.lda * 2, stepB = (size_t)64 * K * 2;
    const size_t kstep = (size_t)(BK * 2);
    const size_t hstepA = (size_t)HALF * g.lda * 2, hstepB = (size_t)HALF * K * 2;
    const size_t tstepA = 2 * hstepA, tstepB = 2 * hstepB;
    const unsigned ldsw = (unsigned)wid * 1024u;
    const int aoff = lds_byte(wr * 64 + fr, fq * 8), boff = lds_byte(wc * 32 + fr, fq * 8);
#define PG8_SA(b, h) (((b) * 2 + (h)) * HTB)
#define PG8_SB(b, h) ((4 + (b) * 2 + (h)) * HTB)
#define PG8_STAGE(bufoff, gbase, voff, rstep) do { _Pragma("unroll") for (int _i = 0; _i < 2; ++_i) \
        __builtin_amdgcn_global_load_lds((const unsigned*)((const char*)(gbase) + (size_t)_i * (rstep) + (voff)), (PG8_LAS unsigned*)(lds + (bufoff) + ldsw + _i * 8192), 16, 0, 0); } while (0)
#define PG8_LDA(dst, b, h) do { _Pragma("unroll") for (int m = 0; m < 4; ++m) _Pragma("unroll") for (int k = 0; k < 2; ++k) dst[m][k] = *(const PG8_LAS bf16x8*)(lds + PG8_SA(b, h) + aoff + m * 2048 + k * 1024); } while (0)
#define PG8_LDB(dst, b, h) do { _Pragma("unroll") for (int n = 0; n < 2; ++n) _Pragma("unroll") for (int k = 0; k < 2; ++k) dst[n][k] = *(const PG8_LAS bf16x8*)(lds + PG8_SB(b, h) + boff + n * 2048 + k * 1024); } while (0)
#define PG8_MMA(ai, bj, At, Bt) do { __builtin_amdgcn_s_setprio(1); _Pragma("unroll") for (int m = 0; m < 4; ++m) _Pragma("unroll") for (int n = 0; n < 2; ++n) _Pragma("unroll") for (int k = 0; k < 2; ++k) \
        acc[ai][bj][m][n] = __builtin_amdgcn_mfma_f32_16x16x32_bf16(Bt[n][k], At[m][k], acc[ai][bj][m][n], 0, 0, 0); __builtin_amdgcn_s_setprio(0); } while (0)
#define PG8_WAIT_V(n) asm volatile("s_waitcnt vmcnt(" #n ")" ::: "memory")
#define PG8_WAIT_L(n) asm volatile("s_waitcnt lgkmcnt(" #n ")" ::: "memory")
#define PG8_BAR __builtin_amdgcn_s_barrier()
#define PG8_SCHED __builtin_amdgcn_sched_barrier(0)
    Unit cur, nxt; int ui = 0;
    if (!S.next(0, cur)) return;
    f32x4 acc[2][2][4][2];
#pragma unroll
    for (int a = 0; a < 2; ++a)
#pragma unroll
        for (int b = 0; b < 2; ++b)
#pragma unroll
            for (int m = 0; m < 4; ++m)
#pragma unroll
                for (int n = 0; n < 2; ++n) acc[a][b][m][n] = (f32x4){0.f, 0.f, 0.f, 0.f};
    bf16x8 At[4][2], B0[2][2], B1[2][2];
    const char* cA = (const char*)g.A + (size_t)cur.pm * tstepA; const char* cB = (const char*)g.Bt + (size_t)cur.pn * tstepB;
    S.a_ready(cur);
    if constexpr (SP2) {
        PG8_STAGE(PG8_SB(0, 0), cB, voffB, stepB); PG8_STAGE(PG8_SB(0, 1), cB + hstepB, voffB, stepB); PG8_STAGE(PG8_SA(0, 0), cA, voffA, stepA); PG8_STAGE(PG8_SA(0, 1), cA + hstepA, voffA, stepA);
        if (wr == 1) PG8_BAR;
        PG8_WAIT_V(2); PG8_BAR;
        PG8_STAGE(PG8_SB(1, 0), cB + kstep, voffB, stepB); PG8_STAGE(PG8_SA(1, 0), cA + kstep, voffA, stepA); PG8_STAGE(PG8_SB(1, 1), cB + hstepB + kstep, voffB, stepB);
        PG8_WAIT_V(6); PG8_BAR;
    } else {
        PG8_STAGE(PG8_SB(0, 0), cB, voffB, stepB); PG8_STAGE(PG8_SA(0, 0), cA, voffA, stepA); PG8_STAGE(PG8_SB(0, 1), cB + hstepB, voffB, stepB); PG8_STAGE(PG8_SA(0, 1), cA + hstepA, voffA, stepA);
        if (wr == 1) PG8_BAR;
        PG8_WAIT_V(4); PG8_BAR;
        PG8_STAGE(PG8_SB(1, 0), cB + kstep, voffB, stepB); PG8_STAGE(PG8_SA(1, 0), cA + kstep, voffA, stepA); PG8_STAGE(PG8_SB(1, 1), cB + hstepB + kstep, voffB, stepB);
        PG8_WAIT_V(6); PG8_BAR;
    }
    for (;;) {
        const bool has_next = S.next(ui + 1, nxt);
        const char* nA = has_next ? (const char*)g.A + (size_t)nxt.pm * tstepA : cA; const char* nB = has_next ? (const char*)g.Bt + (size_t)nxt.pn * tstepB : cB;
        for (int t = 0; t < nt; t += 2) {
            const bool last = (t == nt - 2);
            const char* a1 = cA + (size_t)(t + 1) * kstep;
            const char* a2 = last ? nA : cA + (size_t)(t + 2) * kstep; const char* b2 = last ? nB : cB + (size_t)(t + 2) * kstep;
            const char* a3 = a2 + kstep; const char* b3 = b2 + kstep;
            if (last && has_next) S.a_ready(nxt);
            if constexpr (SP2) {
            PG8_LDB(B0, 0, 0); PG8_LDB(B1, 0, 1); PG8_SCHED; PG8_LDA(At, 0, 0); PG8_STAGE(PG8_SA(1, 1), a1 + hstepA, voffA, stepA);
            PG8_WAIT_V(8); PG8_WAIT_L(0); PG8_BAR; PG8_MMA(0, 0, At, B0); PG8_MMA(0, 1, At, B1); PG8_BAR; PG8_SCHED;
            PG8_LDA(At, 0, 1); PG8_STAGE(PG8_SB(0, 0), b2, voffB, stepB); PG8_STAGE(PG8_SB(0, 1), b2 + hstepB, voffB, stepB); PG8_STAGE(PG8_SA(0, 0), a2, voffA, stepA);
            PG8_WAIT_V(8); PG8_WAIT_L(0); PG8_BAR; PG8_MMA(1, 0, At, B0); PG8_MMA(1, 1, At, B1); PG8_BAR; PG8_SCHED;
            PG8_LDB(B0, 1, 0); PG8_LDB(B1, 1, 1); PG8_SCHED; PG8_LDA(At, 1, 0); PG8_STAGE(PG8_SA(0, 1), a2 + hstepA, voffA, stepA);
            PG8_WAIT_V(8); PG8_WAIT_L(0); PG8_BAR; PG8_MMA(0, 0, At, B0); PG8_MMA(0, 1, At, B1); PG8_BAR; PG8_SCHED;
            PG8_LDA(At, 1, 1); PG8_STAGE(PG8_SB(1, 0), b3, voffB, stepB); PG8_STAGE(PG8_SB(1, 1), b3 + hstepB, voffB, stepB); PG8_STAGE(PG8_SA(1, 0), a3, voffA, stepA);
            PG8_WAIT_V(8); PG8_WAIT_L(0); PG8_BAR; PG8_MMA(1, 0, At, B0); PG8_MMA(1, 1, At, B1); PG8_BAR; PG8_SCHED;
            } else {
            PG8_LDB(B0, 0, 0); PG8_SCHED; PG8_LDA(At, 0, 0); PG8_STAGE(PG8_SA(1, 1), a1 + hstepA, voffA, stepA);
            PG8_WAIT_L(8); PG8_BAR; PG8_WAIT_L(0); PG8_MMA(0, 0, At, B0); PG8_BAR; PG8_SCHED;
            PG8_LDB(B1, 0, 1); PG8_STAGE(PG8_SB(0, 0), b2, voffB, stepB);
            PG8_BAR; PG8_WAIT_L(0); PG8_MMA(0, 1, At, B1); PG8_BAR;
            PG8_LDA(At, 0, 1); PG8_STAGE(PG8_SA(0, 0), a2, voffA, stepA);
            PG8_BAR; PG8_WAIT_L(0); PG8_MMA(1, 0, At, B0); PG8_BAR; PG8_SCHED;
            PG8_STAGE(PG8_SB(0, 1), b2 + hstepB, voffB, stepB);
            PG8_WAIT_V(6); PG8_BAR; PG8_MMA(1, 1, At, B1); PG8_BAR;
            PG8_LDB(B0, 1, 0); PG8_SCHED; PG8_LDA(At, 1, 0); PG8_STAGE(PG8_SA(0, 1), a2 + hstepA, voffA, stepA);
            PG8_WAIT_L(8); PG8_BAR; PG8_WAIT_L(0); PG8_MMA(0, 0, At, B0); PG8_BAR; PG8_SCHED;
            PG8_LDB(B1, 1, 1); PG8_STAGE(PG8_SB(1, 0), b3, voffB, stepB);
            PG8_BAR; PG8_WAIT_L(0); PG8_MMA(0, 1, At, B1); PG8_BAR;
            PG8_LDA(At, 1, 1); PG8_STAGE(PG8_SA(1, 0), a3, voffA, stepA);
            PG8_BAR; PG8_WAIT_L(0); PG8_MMA(1, 0, At, B0); PG8_BAR; PG8_SCHED;
            PG8_STAGE(PG8_SB(1, 1), b3 + hstepB, voffB, stepB);
            PG8_WAIT_V(6); PG8_BAR; PG8_MMA(1, 1, At, B1); PG8_BAR;
            }
        }
        if constexpr (ALIGN_EPI) { if (wr == 0) PG8_BAR; }
        if constexpr (!Epi::AFTER_DRAIN) { E(acc, cur, wr, wc, fr, fq); S.done(cur); }
        if (!has_next) break;
#pragma unroll
        for (int a = 0; a < 2; ++a)
#pragma unroll
            for (int b = 0; b < 2; ++b)
#pragma unroll
                for (int m = 0; m < 4; ++m)
#pragma unroll
                    for (int n = 0; n < 2; ++n) acc[a][b][m][n] = (f32x4){0.f, 0.f, 0.f, 0.f};
        cur = nxt; cA = nA; cB = nB; ++ui;
        if constexpr (ALIGN_EPI) { if (wr == 1) PG8_BAR; }
    }
    PG8_WAIT_V(0);
    if constexpr (!ALIGN_EPI) { if (wr == 0) PG8_BAR; }
    PG8_BAR;
    if constexpr (Epi::AFTER_DRAIN) { E.fused(acc, cur, wr, wc, fr, fq, lds, wid, lane); S.done(cur); }
#undef PG8_SA
#undef PG8_SB
#undef PG8_STAGE
#undef PG8_LDA
#undef PG8_LDB
#undef PG8_MMA
#undef PG8_WAIT_V
#undef PG8_WAIT_L
#undef PG8_BAR
#undef PG8_SCHED
}
}

#define LAS __attribute__((address_space(3)))
using pg8::bf16_t; using pg8::f32x4; using pg8::u32x4; using pg8::cvt_pk_bf16; using pg8::Unit; using pg8::bf16x8;
typedef unsigned u32x2 __attribute__((ext_vector_type(2)));
typedef float f32x2v __attribute__((ext_vector_type(2)));
constexpr int NB = 2, SEQ = 16384, DM = 1024, MR = NB * SEQ, FFH = 2816, NTHR = 512;
constexpr size_t MiB = 1u << 20;
constexpr size_t WS_MODS = 0, WS_KVMODS = 256 * 1024, WS_SS = 1 * MiB, WS_BIAS = 2 * MiB, WS_CS = 3 * MiB;
constexpr size_t WS_WHIN = 8 * MiB, WS_WHOUT = 24 * MiB, WS_WFIN = 28 * MiB, WS_WFOUT = 72 * MiB, WS_WQ = 94 * MiB, WS_WKV = 99 * MiB, WS_WAO = 102 * MiB, WS_WC1 = 106 * MiB, WS_WC2 = 108 * MiB;
constexpr size_t WS_XB = 112 * MiB, WS_R = 176 * MiB;
constexpr size_t WS_HB = WS_R, WS_OB = 432 * MiB, WS_HID = WS_R, WS_Q = WS_R, WS_QR = 240 * MiB, WS_AO = 304 * MiB, WS_XB2 = 352 * MiB, WS_GATES = 370 * MiB, WS_SELM = 376 * MiB, WS_SLOC = 496 * MiB, WS_DSEG = 2 * MiB + 512 * 1024, WS_BAR = 768 * 1024;
constexpr size_t WS_KC = 406 * MiB, WS_VC = 407 * MiB, WS_CHID = 408 * MiB, WS_KV = 416 * MiB;
constexpr size_t WS_END = 512 * MiB;
constexpr int BO_HIN = 0, BO_FIN = 16384, BO_Q = BO_FIN + 45056, BO_KV = BO_Q + 5120, BO_C1 = BO_KV + 3072, BO_GM = BO_C1 + 512;
constexpr int LDS_BYTES = 147456;

struct Params { const float* in[23]; float* out; unsigned char* ws; };
typedef const __attribute__((address_space(4))) Params* PK;
__device__ __forceinline__ PK fresh_pk() { PK k = (PK)__builtin_amdgcn_kernarg_segment_ptr(); asm volatile("" : "+s"(k)); return k; }

__device__ __forceinline__ float bf2f(unsigned short v) { return __uint_as_float(((unsigned)v) << 16); }
__device__ __forceinline__ float bflo(unsigned w) { return __uint_as_float(w << 16); }
__device__ __forceinline__ float bfhi(unsigned w) { return __uint_as_float(w & 0xffff0000u); }
__device__ __forceinline__ float fsigmoid(float v) { return __builtin_amdgcn_rcpf(1.f + __expf(-v)); }
__device__ __forceinline__ float fsilu(float v) { return v * fsigmoid(v); }
__device__ __forceinline__ float wave_sum(float v) {
#pragma unroll
    for (int o = 32; o >= 1; o >>= 1) v += __shfl_xor(v, o);
    return v; }
__device__ __forceinline__ float wave_max(float v) {
#pragma unroll
    for (int o = 32; o >= 1; o >>= 1) v = fmaxf(v, __shfl_xor(v, o));
    return v; }

__device__ __forceinline__ int opaque_lane() { int l; asm volatile("v_mbcnt_lo_u32_b32 %0, -1, 0\n\tv_mbcnt_hi_u32_b32 %0, -1, %0" : "=v"(l)); return l; }
__device__ __forceinline__ float shx(float v, int lane, int mask) { return __int_as_float(__builtin_amdgcn_ds_bpermute((lane ^ mask) << 2, __float_as_int(v))); }
__device__ __forceinline__ bf16_t f2bf(float v) { return (bf16_t)(cvt_pk_bf16(v, 0.f) & 0xffffu); }

struct TJob { const float* W; bf16_t* Wt; int K, Nsrc, Npad, kind, ntiles; };
__device__ __forceinline__ int map_col(int kind, int r) {
    if (kind == 0) return r;
    const int tile = r >> 8, w = r & 255;
    if (kind == 1) { const int j = tile * 128 + (w & 127); return (w < 128) ? j : FFH + j; }
    const int bj = w >> 7, wc = (w >> 5) & 3, jj = w & 31;
    if (kind == 2) { if (r < 1024) return tile * 256 + wc * 64 + bj * 32 + jj; const int g = r - 1024; return g < 48 ? 1024 + g : -1; }
    if (kind == 4) return tile * 256 + wc * 64 + bj * 32 + jj;
    return (wc == 0) ? bj * 32 + jj : -1;
}
__device__ __forceinline__ void get_tjob(PK p, int j, TJob& o) {
    unsigned char* ws = p->ws;
    if (j < 2) { o.W = p->in[6] + (size_t)j * 1024 * 4096; o.Wt = (bf16_t*)(ws + WS_WHIN) + (size_t)j * 4096 * 1024; o.K = 1024; o.Nsrc = 4096; o.Npad = 4096; o.kind = 0; }
    else if (j < 4) { const int l = j - 2; o.W = p->in[9] + (size_t)l * 1024 * 1024; o.Wt = (bf16_t*)(ws + WS_WHOUT) + (size_t)l * 1024 * 1024; o.K = 1024; o.Nsrc = 1024; o.Npad = 1024; o.kind = 0; }
    else if (j < 8) { const int l = j - 4; o.W = p->in[21] + (size_t)l * 1024 * 5632; o.Wt = (bf16_t*)(ws + WS_WFIN) + (size_t)l * 5632 * 1024; o.K = 1024; o.Nsrc = 5632; o.Npad = 5632; o.kind = 1; }
    else if (j < 12) { const int l = j - 8; o.W = p->in[22] + (size_t)l * 2816 * 1024; o.Wt = (bf16_t*)(ws + WS_WFOUT) + (size_t)l * 1024 * 2816; o.K = 2816; o.Nsrc = 1024; o.Npad = 1024; o.kind = 0; }
    else if (j < 14) { const int l = j - 12; o.W = p->in[18] + (size_t)l * 1024 * 1072; o.Wt = (bf16_t*)(ws + WS_WQ) + (size_t)l * 1280 * 1024; o.K = 1024; o.Nsrc = 1072; o.Npad = 1280; o.kind = 2; }
    else if (j == 14) { o.W = p->in[13]; o.Wt = (bf16_t*)(ws + WS_WKV); o.K = 1024; o.Nsrc = 1536; o.Npad = 1536; o.kind = 4; }
    else if (j < 17) { const int l = j - 15; o.W = p->in[20] + (size_t)l * 1024 * 1024; o.Wt = (bf16_t*)(ws + WS_WAO) + (size_t)l * 1024 * 1024; o.K = 1024; o.Nsrc = 1024; o.Npad = 1024; o.kind = 0; }
    else if (j < 19) { const int l = j - 17; o.W = p->in[16] + (size_t)l * 2048 * 256; o.Wt = (bf16_t*)(ws + WS_WC1) + (size_t)l * 256 * 2048; o.K = 2048; o.Nsrc = 256; o.Npad = 256; o.kind = 0; }
    else { const int l = j - 19; o.W = p->in[17] + (size_t)l * 256 * 64; o.Wt = (bf16_t*)(ws + WS_WC2) + (size_t)l * 256 * 256; o.K = 256; o.Nsrc = 64; o.Npad = 256; o.kind = 3; }
    o.ntiles = (o.K / 64) * (o.Npad / 64);
}
__device__ __forceinline__ void transpose_tiles(const TJob& J, int tile0, int G, LAS float* scr, int tid) {
    const int nrt = J.Npad / 64; const int rl = tid & 63, kl = tid >> 6; const int rr = tid >> 3, kc = tid & 7;
    float v[4][8];
#pragma unroll
    for (int t = 0; t < 4; ++t) { const int tile = tile0 + t * G;
        if (tile < J.ntiles) { const int kt = tile / nrt, rt = tile % nrt; const int sc = map_col(J.kind, rt * 64 + rl);
#pragma unroll
            for (int i = 0; i < 8; ++i) v[t][i] = sc >= 0 ? J.W[(size_t)(kt * 64 + kl + 8 * i) * J.Nsrc + sc] : 0.f; } }
#pragma unroll
    for (int t = 0; t < 4; ++t) if (tile0 + t * G < J.ntiles) {
#pragma unroll
        for (int i = 0; i < 8; ++i) scr[t * 4160 + (kl + 8 * i) * 65 + rl] = v[t][i]; }
    __syncthreads();
#pragma unroll
    for (int t = 0; t < 4; ++t) { const int tile = tile0 + t * G; if (tile >= J.ntiles) continue;
        const int kt = tile / nrt, rt = tile % nrt;
        LAS const float* sp = scr + t * 4160 + (kc * 8) * 65 + rr;
        u32x4 o; o.x = cvt_pk_bf16(sp[0], sp[65]); o.y = cvt_pk_bf16(sp[130], sp[195]); o.z = cvt_pk_bf16(sp[260], sp[325]); o.w = cvt_pk_bf16(sp[390], sp[455]);
        *(u32x4*)(J.Wt + (size_t)(rt * 64 + rr) * J.K + kt * 64 + kc * 8) = o; }
    __syncthreads();
}

__device__ __forceinline__ void phase0(PK p, LAS unsigned char* ldsb, int wid_s) {
    const int tid = opaque_tid(wid_s), G = gridDim.x;
    float* mods = (float*)(p->ws + WS_MODS); float* kvmods = (float*)(p->ws + WS_KVMODS); float* SS = (float*)(p->ws + WS_SS);
    for (int i = blockIdx.x * NTHR + tid; i < 8 * MR; i += G * NTHR) SS[i] = 0.f;
    LAS float* ca = (LAS float*)ldsb; LAS float* red = ca + 2048;
    for (int i = tid; i < 2048; i += NTHR) ca[i] = fsilu(p->in[1][i]);
    __syncthreads();
    for (int item = blockIdx.x; item < 208; item += G) {
        const float* W; const float* bias; float* out; int ld, col0, ostride;
        if (item < 192) { const int l = item / 24, cb = item % 24; W = p->in[2] + (size_t)l * 1024 * 3072; ld = 3072; col0 = cb * 128; bias = p->in[3] + l * 3072; out = mods + l * 6144; ostride = 3072; }
        else { W = p->in[10]; ld = 2048; col0 = (item - 192) * 128; bias = p->in[11]; out = kvmods; ostride = 2048; }
        const int ks = tid >> 5, cq = tid & 31;
        f32x4 a0 = (f32x4){0.f, 0.f, 0.f, 0.f}, a1 = a0;
        const float* wp = W + (size_t)(ks * 64) * ld + col0 + cq * 4;
#pragma unroll 8
        for (int k = 0; k < 64; ++k) { const f32x4 w = *(const f32x4*)(wp + (size_t)k * ld); a0 += w * ca[ks * 64 + k]; a1 += w * ca[1024 + ks * 64 + k]; }
        LAS f32x4* red4 = (LAS f32x4*)red;
        red4[(ks * 32 + cq) * 2] = a0; red4[(ks * 32 + cq) * 2 + 1] = a1;
        __syncthreads();
        if (tid < 256) { const int col = tid & 127, bb = tid >> 7; float sum = 0.f;
#pragma unroll
            for (int q = 0; q < 16; ++q) sum += red[((q * 32 + (col >> 2)) * 2 + bb) * 4 + (col & 3)];
            out[bb * ostride + col0 + col] = sum + bias[col0 + col]; }
        __syncthreads();
    }
    f32x2v* cs = (f32x2v*)(p->ws + WS_CS);
    for (int i = blockIdx.x * NTHR + tid; i < SEQ * 32; i += G * NTHR) {
        const int t = i >> 5, d = i & 31;
        const float e = (float)(2 * d) / 64.f; const float invf = 1.0f / exp2f(e * 13.287712379549449f);
        const float ang = (float)t * invf;
        double r = (double)ang * 0.15915494309189535; r -= rint(r);
        const float rf = (float)r;
        cs[i] = (f32x2v){__builtin_amdgcn_cosf(rf), __builtin_amdgcn_sinf(rf)};
    }
    LAS float* scr = (LAS float*)ldsb + 4096;
    int base = 0;
#pragma unroll 1
    for (int j = 0; j < 21; ++j) { TJob J; get_tjob(p, j, J);
        int first = ((int)blockIdx.x - base) % G; if (first < 0) first += G;
        for (int tile = first; tile < J.ntiles; tile += 4 * G) transpose_tiles(J, tile, G, scr, tid);
        base += J.ntiles; }
}

__device__ __forceinline__ void phase1(PK p, LAS unsigned char* ldsb, int wid_s) {
    const int tid = opaque_tid(wid_s), G = gridDim.x, lane = tid & 63, wave = tid >> 6;
    const float* mods = (const float*)(p->ws + WS_MODS); const float* kvmods = (const float*)(p->ws + WS_KVMODS); float* BIAS = (float*)(p->ws + WS_BIAS);
    for (int gr = blockIdx.x * 8 + wave; gr < 35328; gr += G * 8) {
        const bf16_t* wr; const float* s0; const float* s1; float* out; int K, ostride; int r = gr;
        if (r < 8192) { const int l = r >> 12; r &= 4095; wr = (const bf16_t*)(p->ws + WS_WHIN) + ((size_t)l * 4096 + r) * 1024; K = 1024; s0 = mods + (2 * l) * 6144; s1 = s0 + 3072; out = BIAS + BO_HIN + l * 8192 + r; ostride = 4096; }
        else if ((r -= 8192) < 22528) { const int l = r / 5632; r -= l * 5632; wr = (const bf16_t*)(p->ws + WS_WFIN) + ((size_t)l * 5632 + r) * 1024; K = 1024; s0 = mods + (2 * l + 1) * 6144; s1 = s0 + 3072; out = BIAS + BO_FIN + l * 11264 + r; ostride = 5632; }
        else if ((r -= 22528) < 2560) { const int l = r / 1280; r -= l * 1280; wr = (const bf16_t*)(p->ws + WS_WQ) + ((size_t)l * 1280 + r) * 1024; K = 1024; s0 = mods + (2 * (l + 2)) * 6144; s1 = s0 + 3072; out = BIAS + BO_Q + l * 2560 + r; ostride = 1280; }
        else if ((r -= 2560) < 1536) { wr = (const bf16_t*)(p->ws + WS_WKV) + (size_t)r * 1024; K = 1024; s0 = kvmods; s1 = kvmods + 2048; out = BIAS + BO_KV + r; ostride = 1536; }
        else { r -= 1536; const int l = r >> 8; r &= 255; wr = (const bf16_t*)(p->ws + WS_WC1) + ((size_t)l * 256 + r) * 2048; K = 2048; s0 = p->in[15] + l * 2048; s1 = s0; out = BIAS + BO_C1 + l * 256 + r; ostride = 0; }
        float a0 = 0.f, a1 = 0.f;
        for (int k = lane * 8; k < K; k += 512) { const u32x4 w = *(const u32x4*)(wr + k);
            const f32x4 x0 = *(const f32x4*)(s0 + k), x1 = *(const f32x4*)(s0 + k + 4), y0 = *(const f32x4*)(s1 + k), y1 = *(const f32x4*)(s1 + k + 4);
            const float wf[8] = {bflo(w.x), bfhi(w.x), bflo(w.y), bfhi(w.y), bflo(w.z), bfhi(w.z), bflo(w.w), bfhi(w.w)};
            a0 += (x0.x * wf[0] + x0.y * wf[1]) + (x0.z * wf[2] + x0.w * wf[3]) + (x1.x * wf[4] + x1.y * wf[5]) + (x1.z * wf[6] + x1.w * wf[7]);
            a1 += (y0.x * wf[0] + y0.y * wf[1]) + (y0.z * wf[2] + y0.w * wf[3]) + (y1.x * wf[4] + y1.y * wf[5]) + (y1.z * wf[6] + y1.w * wf[7]); }
        a0 = wave_sum(a0); a1 = wave_sum(a1);
        if (lane == 0) { out[0] = a0; if (ostride) out[ostride] = a1; }
    }
    for (int i = blockIdx.x * NTHR + tid; i < 9 * 2048; i += G * NTHR) { const int l2 = i >> 11, b = (i >> 10) & 1, k = i & 1023;
        float g, sc; if (l2 < 8) { g = ((l2 & 1) ? p->in[5] : p->in[4])[(l2 >> 1) * 1024 + k]; sc = mods[l2 * 6144 + b * 3072 + 1024 + k]; } else { g = p->in[12][k]; sc = kvmods[b * 2048 + 1024 + k]; }
        BIAS[BO_GM + i] = g * (1.0f + sc); }
    const float* x = p->in[0]; bf16_t* XB = (bf16_t*)(p->ws + WS_XB); float* SS0 = (float*)(p->ws + WS_SS);
    const float* ng = p->in[4]; const float* scl = mods + 1024;
    for (int row = blockIdx.x * 8 + wave; row < MR; row += G * 8) {
        const int b = row >> 14; f32x4 v[4]; float ss = 0.f;
#pragma unroll
        for (int j = 0; j < 4; ++j) { v[j] = *(const f32x4*)(x + (size_t)row * DM + j * 256 + lane * 4); ss += (v[j].x * v[j].x + v[j].y * v[j].y) + (v[j].z * v[j].z + v[j].w * v[j].w); }
        ss = wave_sum(ss); if (lane == 0) SS0[row] = ss;
#pragma unroll
        for (int j = 0; j < 4; ++j) { const int col = j * 256 + lane * 4; const f32x4 g = *(const f32x4*)(ng + col); const f32x4 s = *(const f32x4*)(scl + b * 3072 + col);
            const f32x4 o = v[j] * (g * (s + 1.0f)); u32x2 w; w.x = cvt_pk_bf16(o.x, o.y); w.y = cvt_pk_bf16(o.z, o.w); *(u32x2*)(XB + (size_t)row * DM + col) = w; }
    }
}

#define EPI_ROWS(ai, m) (u.pm * 256 + (ai) * 128 + wr * 64 + (m) * 16 + fr)
__device__ __forceinline__ float rstd_of(const float* ss, int row) { return rsqrtf(ss[row] * (1.0f / 1024.0f) + 1e-6f); }

struct EpiHin {
    static constexpr bool PERM = true, AFTER_DRAIN = false;
    bf16_t* HB; const float* ss; const float* bias;
    __device__ __forceinline__ void operator()(const f32x4 (&acc)[2][2][4][2], const Unit& u, int wr, int wc, int fr_, int fq_) const {
        const int lane_ = opaque_lane(), fr = lane_ & 15, fq = lane_ >> 4;
        const int seg = u.pn >> 2; const bool act = (seg == 0) || (seg == 3);
#pragma unroll
        for (int ai = 0; ai < 2; ++ai)
#pragma unroll
            for (int m = 0; m < 4; ++m) { asm volatile("" ::: "memory"); const int row = EPI_ROWS(ai, m), b = row >> 14; const float rs = rstd_of(ss, row);
#pragma unroll
                for (int bj = 0; bj < 2; ++bj) { const int c0 = u.pn * 256 + bj * 128 + wc * 32 + fq * 8;
                    f32x4 v0 = acc[ai][bj][m][0] * rs + *(const f32x4*)(bias + b * 4096 + c0), v1 = acc[ai][bj][m][1] * rs + *(const f32x4*)(bias + b * 4096 + c0 + 4);
                    if (act) { v0 = (f32x4){fsilu(v0.x), fsilu(v0.y), fsilu(v0.z), fsilu(v0.w)}; v1 = (f32x4){fsilu(v1.x), fsilu(v1.y), fsilu(v1.z), fsilu(v1.w)}; }
                    u32x4 w; w.x = cvt_pk_bf16(v0.x, v0.y); w.y = cvt_pk_bf16(v0.z, v0.w); w.z = cvt_pk_bf16(v1.x, v1.y); w.w = cvt_pk_bf16(v1.z, v1.w);
                    *(u32x4*)(HB + (size_t)row * 4096 + c0) = w; } }
    }
};
struct EpiFin {
    static constexpr bool PERM = true, AFTER_DRAIN = false;
    bf16_t* HID; const float* ss; const float* bias;
    __device__ __forceinline__ void operator()(const f32x4 (&acc)[2][2][4][2], const Unit& u, int wr, int wc, int fr_, int fq_) const {
        const int lane_ = opaque_lane(), fr = lane_ & 15, fq = lane_ >> 4;
        const int ca = u.pn * 256 + wc * 32 + fq * 8, cb = ca + 128, co = u.pn * 128 + wc * 32 + fq * 8;
#pragma unroll
        for (int ai = 0; ai < 2; ++ai)
#pragma unroll
            for (int m = 0; m < 4; ++m) { asm volatile("" ::: "memory"); const int row = EPI_ROWS(ai, m), b = row >> 14; const float rs = rstd_of(ss, row);
                const f32x4 a0 = acc[ai][0][m][0] * rs + *(const f32x4*)(bias + b * 5632 + ca), a1 = acc[ai][0][m][1] * rs + *(const f32x4*)(bias + b * 5632 + ca + 4);
                const f32x4 b0 = acc[ai][1][m][0] * rs + *(const f32x4*)(bias + b * 5632 + cb), b1 = acc[ai][1][m][1] * rs + *(const f32x4*)(bias + b * 5632 + cb + 4);
                u32x4 w; w.x = cvt_pk_bf16(fsilu(a0.x) * b0.x, fsilu(a0.y) * b0.y); w.y = cvt_pk_bf16(fsilu(a0.z) * b0.z, fsilu(a0.w) * b0.w);
                w.z = cvt_pk_bf16(fsilu(a1.x) * b1.x, fsilu(a1.y) * b1.y); w.w = cvt_pk_bf16(fsilu(a1.z) * b1.z, fsilu(a1.w) * b1.w);
                *(u32x4*)(HID + (size_t)row * FFH + co) = w; }
    }
};
template <bool XB2> struct EpiRes {
    static constexpr bool PERM = true, AFTER_DRAIN = false;
    const float* xold; float* xout; const float* gate;
    float* ssout; bf16_t* xb; const float* gm1;
    bf16_t* xb2; const float* gm2;
    __device__ __forceinline__ void operator()(const f32x4 (&acc)[2][2][4][2], const Unit& u, int wr, int wc, int fr_, int fq_) const {
        const int lane_ = opaque_lane(), fr = lane_ & 15, fq = lane_ >> 4;
#pragma unroll
        for (int ai = 0; ai < 2; ++ai)
#pragma unroll
            for (int m = 0; m < 4; ++m) { const int row = EPI_ROWS(ai, m), b = row >> 14; float sq = 0.f;
#pragma unroll
                for (int bj = 0; bj < 2; ++bj)
#pragma unroll
                    for (int n = 0; n < 2; ++n) { asm volatile("" ::: "memory");
                        const int c0 = u.pn * 256 + bj * 128 + wc * 32 + fq * 8 + n * 4; const size_t off = (size_t)row * DM + c0;
                        const f32x4 x0 = *(const f32x4*)(xold + off) + *(const f32x4*)(gate + b * 3072 + c0) * acc[ai][bj][m][n];
                        *(f32x4*)(xout + off) = x0;
                        sq += (x0.x * x0.x + x0.y * x0.y) + (x0.z * x0.z + x0.w * x0.w);
                        { const f32x4 o0 = x0 * *(const f32x4*)(gm1 + b * 1024 + c0); u32x2 w; w.x = cvt_pk_bf16(o0.x, o0.y); w.y = cvt_pk_bf16(o0.z, o0.w); *(u32x2*)(xb + off) = w; }
                        if (XB2) { const f32x4 o0 = x0 * *(const f32x4*)(gm2 + b * 1024 + c0); u32x2 w; w.x = cvt_pk_bf16(o0.x, o0.y); w.y = cvt_pk_bf16(o0.z, o0.w); *(u32x2*)(xb2 + off) = w; } }
                sq += shx(sq, lane_, 16); sq += shx(sq, lane_, 32);
                if (fq == 0) atomicAdd(ssout + row, sq); }
    }
};
__device__ __forceinline__ void head_norm(float (&v0)[8], float (&v1)[8], const float* gain, int fq, int lane_) {
    float s = 0.f;
#pragma unroll
    for (int i = 0; i < 8; ++i) s += v0[i] * v0[i] + v1[i] * v1[i];
    s += shx(s, lane_, 16); s += shx(s, lane_, 32);
    const float r = rsqrtf(s * (1.0f / 64.0f) + 1e-6f);
#pragma unroll
    for (int i = 0; i < 8; ++i) { v0[i] = v0[i] * r * gain[fq * 8 + i]; v1[i] = v1[i] * r * gain[32 + fq * 8 + i]; }
}
__device__ __forceinline__ void store8(bf16_t* p, const float (&v)[8]) { u32x4 w; w.x = cvt_pk_bf16(v[0], v[1]); w.y = cvt_pk_bf16(v[2], v[3]); w.z = cvt_pk_bf16(v[4], v[5]); w.w = cvt_pk_bf16(v[6], v[7]); *(u32x4*)p = w; }
__device__ __forceinline__ void rope8(const float (&v0)[8], const float (&v1)[8], const f32x2v* cs, int t, int fq, float (&r0)[8], float (&r1)[8]) {
#pragma unroll
    for (int i = 0; i < 8; ++i) { const f32x2v c = cs[t * 32 + fq * 8 + i]; r0[i] = v0[i] * c.x - v1[i] * c.y; r1[i] = v1[i] * c.x + v0[i] * c.y; }
}
struct EpiQ {
    static constexpr bool PERM = true, AFTER_DRAIN = false;
    bf16_t* Q; bf16_t* QR; float* GATES; const float* ss; const float* bias; const float* qn; const f32x2v* cs;
    __device__ __forceinline__ void operator()(const f32x4 (&acc)[2][2][4][2], const Unit& u, int wr, int wc, int fr_, int fq_) const {
        const int lane_ = opaque_lane(), fr = lane_ & 15, fq = lane_ >> 4;
#pragma unroll
        for (int ai = 0; ai < 2; ++ai)
#pragma unroll
            for (int m = 0; m < 4; ++m) { asm volatile("" ::: "memory"); const int row = EPI_ROWS(ai, m), b = row >> 14, t = row & (SEQ - 1); const float rs = rstd_of(ss, row);
                const float* bp = bias + b * 1280 + u.pn * 256 + wc * 32 + fq * 8;
                float v0[8], v1[8];
#pragma unroll
                for (int i = 0; i < 8; ++i) { v0[i] = acc[ai][0][m][i >> 2][i & 3] * rs + bp[i]; v1[i] = acc[ai][1][m][i >> 2][i & 3] * rs + bp[128 + i]; }
                if (u.pn < 4) { const int hd = u.pn * 4 + wc;
                    head_norm(v0, v1, qn, fq, lane_);
#pragma unroll
                    for (int i = 0; i < 8; ++i) { v0[i] *= 0.18033688011112042f; v1[i] *= 0.18033688011112042f; }
                    bf16_t* qp = Q + (size_t)row * DM + hd * 64 + fq * 8; store8(qp, v0); store8(qp + 32, v1);
                    float r0[8], r1[8]; rope8(v0, v1, cs, t, fq, r0, r1);
                    bf16_t* rp = QR + (size_t)row * DM + hd * 64 + fq * 8; store8(rp, r0); store8(rp + 32, r1);
                } else {
                    const int cg = wc * 32 + fq * 8;
#pragma unroll
                    for (int i = 0; i < 8; ++i) if (cg + i < 48) GATES[(size_t)row * 48 + cg + i] = fsigmoid(v0[i]);
                } }
    }
};
struct EpiKV {
    static constexpr bool PERM = true, AFTER_DRAIN = false;
    bf16_t* KV; const float* ss; const float* bias; const float* kn; const f32x2v* cs;
    __device__ __forceinline__ void operator()(const f32x4 (&acc)[2][2][4][2], const Unit& u, int wr, int wc, int fr_, int fq_) const {
        const int lane_ = opaque_lane(), fr = lane_ & 15, fq = lane_ >> 4;
        bf16_t* dst = KV + (size_t)u.pn * (8u << 20);
        const bool nr = (u.pn == 2) || (u.pn == 4);
#pragma unroll
        for (int ai = 0; ai < 2; ++ai)
#pragma unroll
            for (int m = 0; m < 4; ++m) { asm volatile("" ::: "memory"); const int row = EPI_ROWS(ai, m), b = row >> 14, t = row & (SEQ - 1); const float rs = rstd_of(ss, row);
                const float* bp = bias + b * 1536 + u.pn * 256 + wc * 32 + fq * 8;
                float v0[8], v1[8];
#pragma unroll
                for (int i = 0; i < 8; ++i) { v0[i] = acc[ai][0][m][i >> 2][i & 3] * rs + bp[i]; v1[i] = acc[ai][1][m][i >> 2][i & 3] * rs + bp[128 + i]; }
                bf16_t* op = dst + ((size_t)(b * 4 + wc) * SEQ + t) * 64 + fq * 8;
                if (nr) { head_norm(v0, v1, kn + (u.pn >> 1) * 64, fq, lane_); float r0[8], r1[8]; rope8(v0, v1, cs, t, fq, r0, r1); store8(op, r0); store8(op + 32, r1); }
                else if (u.pn == 3 || u.pn == 5) {
                    bf16_t* tp = dst + ((size_t)(b * 4 + wc) * 64 + fq * 8) * SEQ + t;
#pragma unroll
                    for (int i = 0; i < 8; ++i) { tp[(size_t)i * SEQ] = f2bf(v0[i]); tp[(size_t)(32 + i) * SEQ] = f2bf(v1[i]); } }
                else { store8(op, v0); store8(op + 32, v1); } }
    }
};
struct EpiC1 {
    static constexpr bool PERM = true, AFTER_DRAIN = false;
    bf16_t* H; const float* bias;
    __device__ __forceinline__ void operator()(const f32x4 (&acc)[2][2][4][2], const Unit& u, int wr, int wc, int fr_, int fq_) const {
        const int lane_ = opaque_lane(), fr = lane_ & 15, fq = lane_ >> 4;
#pragma unroll
        for (int ai = 0; ai < 2; ++ai)
#pragma unroll
            for (int m = 0; m < 4; ++m) { asm volatile("" ::: "memory"); const int row = EPI_ROWS(ai, m);
#pragma unroll
                for (int bj = 0; bj < 2; ++bj) { const int c0 = bj * 128 + wc * 32 + fq * 8; float v[8];
#pragma unroll
                    for (int i = 0; i < 8; ++i) v[i] = fsilu(acc[ai][bj][m][i >> 2][i & 3] + bias[c0 + i]);
                    store8(H + (size_t)row * 256 + c0, v); } }
    }
};
struct EpiC2 {
    static constexpr bool PERM = true, AFTER_DRAIN = false;
    bf16_t* O; const float* kn; int tr;
    __device__ __forceinline__ void operator()(const f32x4 (&acc)[2][2][4][2], const Unit& u, int wr, int wc, int fr_, int fq_) const {
        const int lane_ = opaque_lane(), fr = lane_ & 15, fq = lane_ >> 4;
        if (wc != 0) return;
#pragma unroll
        for (int ai = 0; ai < 2; ++ai)
#pragma unroll
            for (int m = 0; m < 4; ++m) { asm volatile("" ::: "memory"); const int row = EPI_ROWS(ai, m); float v0[8], v1[8];
#pragma unroll
                for (int i = 0; i < 8; ++i) { v0[i] = acc[ai][0][m][i >> 2][i & 3]; v1[i] = acc[ai][1][m][i >> 2][i & 3]; }
                if (kn) head_norm(v0, v1, kn, fq, lane_);
                if (tr) { bf16_t* tp = O + ((size_t)(row >> 10) * 64 + fq * 8) * 1024 + (row & 1023);
#pragma unroll
                    for (int i = 0; i < 8; ++i) { tp[i * 1024] = f2bf(v0[i]); tp[(32 + i) * 1024] = f2bf(v1[i]); } }
                else { bf16_t* op = O + (size_t)row * 64 + fq * 8; store8(op, v0); store8(op + 32, v1); } }
    }
};
#define RUN_GEMM(EpiT, E, Aptr, Btptr, Mv, Nv, Kv, ldav) do { pg8::Gemm g_{(const bf16_t*)(Aptr), (const bf16_t*)(Btptr), (Mv), (Nv), (Kv), (ldav)}; pg8::StaticOrder S_; int g_x_ = (int)gridDim.x, b_x_ = (int)blockIdx.x; asm volatile("" : "+s"(g_x_), "+s"(b_x_)); S_.init((Mv), (Nv), g_x_, b_x_); \
    pg8::gemm_phase<EpiT, pg8::StaticOrder, true, true>(ldsb, g_, S_, (E), wid_s); } while (0)
#define RUN_GEMM_AT(EpiT, E, Aptr, Btptr, Mv, Nv, Kv, ldav, cshift) do { pg8::Gemm g_{(const bf16_t*)(Aptr), (const bf16_t*)(Btptr), (Mv), (Nv), (Kv), (ldav)}; pg8::StaticOrder S_; int g_x_ = (int)gridDim.x, b_x_ = (int)blockIdx.x - (cshift); asm volatile("" : "+s"(g_x_), "+s"(b_x_)); S_.init((Mv), (Nv), g_x_, b_x_); \
    pg8::gemm_phase<EpiT, pg8::StaticOrder, true, true>(ldsb, g_, S_, (E), wid_s); } while (0)

constexpr int HL_G = 0, HL_ATT = 0, HL_OBUF = 9216, HL_QX = 32768, HL_KX = 50176, HL_KXT = 67584, HL_IT = 86016, HL_ST = 104448, HL_VEC = 139264;
template <bool FULL> __device__ __forceinline__ void phase_hgrn(const bf16_t* HB, bf16_t* OG, float* SLOC, float* DSEG, const float* lbraw, const float* onorm, int layer, LAS unsigned char* ldsb, int wid_s) {
    const int tid = opaque_tid(wid_s), lane = tid & 63, wave = __builtin_amdgcn_readfirstlane(tid >> 6);
    const int t1 = tid >> 3, c0 = (tid & 7) * 16;
    const int k2 = tid & 127, tq = tid >> 7;
    const int fi = lane & 15, fkq = lane >> 4;
    LAS float* Gs = (LAS float*)(ldsb + HL_G); LAS float* vec = (LAS float*)(ldsb + HL_VEC);
    LAS float* eg31 = vec, *e2v = vec + 128, *decv = vec + 256, *lbv = vec + 384, *tot = vec + 512;
    for (int unit = blockIdx.x; unit < 256; unit += gridDim.x) {
        const int b = unit >> 7, h = (unit >> 4) & 7, seg = unit & 15;
        if (!FULL && seg == 15) continue;
        if (tid < 128) { float lb = 0.f; if (layer == 1) lb = 1.0f / (1.0f + __expf(lbraw[h * 128 + tid] - lbraw[1024 + h * 128 + tid])); lbv[tid] = lb; }
        f32x4 S[8];
#pragma unroll
        for (int kt = 0; kt < 8; ++kt) S[kt] = (f32x4){0.f, 0.f, 0.f, 0.f};
        if (FULL) {
            for (int sp = 0; sp < seg; ++sp) { const float* sl = SLOC + (size_t)(unit - seg + sp) * 16384; const float* ds = DSEG + (size_t)(unit - seg + sp) * 128;
#pragma unroll
                for (int kt = 0; kt < 8; ++kt)
#pragma unroll
                    for (int r = 0; r < 4; ++r) { const int k = kt * 16 + fkq * 4 + r; S[kt][r] = ds[k] * S[kt][r] + sl[k * 128 + wave * 16 + fi]; } }
        }
        float lseg = 0.f;
        u32x4 pfa, pfb, pia, pib;
        { const bf16_t* h0 = HB + ((size_t)b * SEQ + seg * 1024 + t1) * 4096 + h * 128 + c0;
          pfa = *(const u32x4*)(h0 + 1024); pfb = *(const u32x4*)(h0 + 1024 + 8); pia = *(const u32x4*)(h0 + 2048); pib = *(const u32x4*)(h0 + 2048 + 8);
        }
        __syncthreads();
#pragma unroll 1
        for (int ch = 0; ch < 16; ++ch) {
            const size_t row0 = (size_t)b * SEQ + seg * 1024 + ch * 64;
            const bf16_t* hrow = HB + (row0 + t1) * 4096 + h * 128 + c0;
            const bf16_t* hnext = hrow + (size_t)64 * 4096; const bool more = (ch + 1 < 16);
            float kk[16];
            { const u32x4 fa = pfa, fb = pfb;
              if (more) { pfa = *(const u32x4*)(hnext + 1024); pfb = *(const u32x4*)(hnext + 1024 + 8); }
              const unsigned fw[8] = {fa.x, fa.y, fa.z, fa.w, fb.x, fb.y, fb.z, fb.w};
              float lg[16];
#pragma unroll
              for (int j = 0; j < 16; ++j) { const float f = fmaxf((j & 1) ? bfhi(fw[j >> 1]) : bflo(fw[j >> 1]), -80.f); const float lb = lbv[c0 + j], om = 1.f - lb;
                  const float e = __expf(-f), sg = __builtin_amdgcn_rcpf(1.f + e); kk[j] = om * (e * sg); lg[j] = __logf(lb + om * sg); }
#pragma unroll
              for (int j = 0; j < 16; j += 4) *(LAS f32x4*)(Gs + t1 * 128 + c0 + j) = (f32x4){lg[j], lg[j + 1], lg[j + 2], lg[j + 3]}; }
            __syncthreads();
            { float loc[16]; float run = 0.f;
#pragma unroll
              for (int j = 0; j < 16; ++j) { run += Gs[(tq * 16 + j) * 128 + k2]; loc[j] = run; }
              tot[tq * 128 + k2] = run;
              __syncthreads();
              float off = 0.f;
#pragma unroll
              for (int q = 0; q < 3; ++q) if (q < tq) off += tot[q * 128 + k2];
#pragma unroll
              for (int j = 0; j < 16; ++j) Gs[(tq * 16 + j) * 128 + k2] = loc[j] + off;
              if (!FULL && tq == 3) lseg += loc[15] + off; }
            __syncthreads();
            { float g31[16], gt[16];
#pragma unroll
              for (int j = 0; j < 16; j += 4) { const f32x4 a = *(LAS const f32x4*)(Gs + 31 * 128 + c0 + j), c = *(LAS const f32x4*)(Gs + t1 * 128 + c0 + j);
                  g31[j] = a.x; g31[j + 1] = a.y; g31[j + 2] = a.z; g31[j + 3] = a.w; gt[j] = c.x; gt[j + 1] = c.y; gt[j + 2] = c.z; gt[j + 3] = c.w; }
              float kx[16];
#pragma unroll
              for (int j = 0; j < 16; ++j) kx[j] = kk[j] * __expf(fminf(g31[j] - gt[j], 80.f));
              LAS bf16_t* kxt = (LAS bf16_t*)(ldsb + HL_KXT);
#pragma unroll
              for (int j = 0; j < 16; ++j) kxt[(c0 + j) * 72 + ((((t1 >> 3) ^ (tid & 7)) << 3) | (t1 & 7))] = f2bf(kx[j]);
              { const u32x4 ia = pia, ib = pib; const unsigned iw[8] = {ia.x, ia.y, ia.z, ia.w, ib.x, ib.y, ib.z, ib.w};
                if (more) { pia = *(const u32x4*)(hnext + 2048); pib = *(const u32x4*)(hnext + 2048 + 8); }
                LAS bf16_t* it = (LAS bf16_t*)(ldsb + HL_IT);
#pragma unroll
                for (int j = 0; j < 16; ++j) it[(c0 + j) * 72 + ((((t1 >> 3) ^ (tid & 7)) << 3) | (t1 & 7))] = (bf16_t)((j & 1) ? (iw[j >> 1] >> 16) : (iw[j >> 1] & 0xffffu)); }
              if (t1 == 0) {
#pragma unroll
                  for (int j = 0; j < 16; ++j) { const float g63 = Gs[63 * 128 + c0 + j]; e2v[c0 + j] = __expf(g63 - g31[j]); decv[c0 + j] = __expf(g63); } }
              if (FULL) {
                  const u32x4 qa = *(const u32x4*)(hrow), qb = *(const u32x4*)(hrow + 8); const unsigned qw[8] = {qa.x, qa.y, qa.z, qa.w, qb.x, qb.y, qb.z, qb.w};
                  float qx[16];
#pragma unroll
                  for (int j = 0; j < 16; ++j) qx[j] = ((j & 1) ? bfhi(qw[j >> 1]) : bflo(qw[j >> 1])) * __expf(fminf(gt[j] - g31[j], 80.f));
                  LAS bf16_t* qxp = (LAS bf16_t*)(ldsb + HL_QX) + t1 * 136 + c0; LAS bf16_t* kxp = (LAS bf16_t*)(ldsb + HL_KX) + t1 * 136 + c0;
                  u32x4 w0, w1;
                  w0.x = cvt_pk_bf16(qx[0], qx[1]); w0.y = cvt_pk_bf16(qx[2], qx[3]); w0.z = cvt_pk_bf16(qx[4], qx[5]); w0.w = cvt_pk_bf16(qx[6], qx[7]);
                  w1.x = cvt_pk_bf16(qx[8], qx[9]); w1.y = cvt_pk_bf16(qx[10], qx[11]); w1.z = cvt_pk_bf16(qx[12], qx[13]); w1.w = cvt_pk_bf16(qx[14], qx[15]);
                  *(LAS u32x4*)qxp = w0; *(LAS u32x4*)(qxp + 8) = w1;
                  w0.x = cvt_pk_bf16(kx[0], kx[1]); w0.y = cvt_pk_bf16(kx[2], kx[3]); w0.z = cvt_pk_bf16(kx[4], kx[5]); w0.w = cvt_pk_bf16(kx[6], kx[7]);
                  w1.x = cvt_pk_bf16(kx[8], kx[9]); w1.y = cvt_pk_bf16(kx[10], kx[11]); w1.z = cvt_pk_bf16(kx[12], kx[13]); w1.w = cvt_pk_bf16(kx[14], kx[15]);
                  *(LAS u32x4*)kxp = w0; *(LAS u32x4*)(kxp + 8) = w1;
                  LAS bf16_t* stp = (LAS bf16_t*)(ldsb + HL_ST) + (wave * 16 + fi) * 136;
#pragma unroll
                  for (int kt = 0; kt < 8; ++kt) { const int k = kt * 16 + fkq * 4; const f32x4 gg = *(LAS const f32x4*)(Gs + 31 * 128 + k);
                      u32x2 w; w.x = cvt_pk_bf16(S[kt][0] * __expf(gg.x), S[kt][1] * __expf(gg.y)); w.y = cvt_pk_bf16(S[kt][2] * __expf(gg.z), S[kt][3] * __expf(gg.w));
                      *(LAS u32x2*)(stp + k) = w; }
              } }
            __syncthreads();
            if (FULL) {
                { const int tt = wave >> 1; LAS bf16_t* att = (LAS bf16_t*)(ldsb + HL_ATT);
                  const LAS bf16_t* qxa = (const LAS bf16_t*)(ldsb + HL_QX) + (tt * 16 + fi) * 136 + fkq * 8;
#pragma unroll
                  for (int u2 = 0; u2 < 2; ++u2) { const int st = 2 * (wave & 1) + u2; f32x4 acc = (f32x4){0.f, 0.f, 0.f, 0.f};
                      if (st <= tt) { const LAS bf16_t* kxb = (const LAS bf16_t*)(ldsb + HL_KX) + (st * 16 + fi) * 136 + fkq * 8;
#pragma unroll
                          for (int ks = 0; ks < 4; ++ks) acc = __builtin_amdgcn_mfma_f32_16x16x32_bf16(*(const LAS bf16x8*)(qxa + ks * 32), *(const LAS bf16x8*)(kxb + ks * 32), acc, 0, 0, 0);
                          if (st == tt) {
#pragma unroll
                              for (int r = 0; r < 4; ++r) if (fi > fkq * 4 + r) acc[r] = 0.f; } }
#pragma unroll
                      for (int r = 0; r < 4; ++r) att[(tt * 16 + fkq * 4 + r) * 72 + st * 16 + fi] = f2bf(acc[r]); } }
                __syncthreads();
                { LAS bf16_t* obuf = (LAS bf16_t*)(ldsb + HL_OBUF);
                  const LAS bf16_t* stb = (const LAS bf16_t*)(ldsb + HL_ST) + (wave * 16 + fi) * 136 + fkq * 8;
                  const LAS bf16_t* itb = (const LAS bf16_t*)(ldsb + HL_IT) + (wave * 16 + fi) * 72;
                  f32x4 oacc[4];
#pragma unroll
                  for (int tt = 0; tt < 4; ++tt) { f32x4 acc = (f32x4){0.f, 0.f, 0.f, 0.f};
                      const LAS bf16_t* qxa = (const LAS bf16_t*)(ldsb + HL_QX) + (tt * 16 + fi) * 136 + fkq * 8;
                      const LAS bf16_t* ata = (const LAS bf16_t*)(ldsb + HL_ATT) + (tt * 16 + fi) * 72 + fkq * 8;
#pragma unroll
                      for (int ks = 0; ks < 4; ++ks) acc = __builtin_amdgcn_mfma_f32_16x16x32_bf16(*(const LAS bf16x8*)(qxa + ks * 32), *(const LAS bf16x8*)(stb + ks * 32), acc, 0, 0, 0);
#pragma unroll
                      for (int ks = 0; ks < 2; ++ks) acc = __builtin_amdgcn_mfma_f32_16x16x32_bf16(*(const LAS bf16x8*)(ata + ks * 32), *(const LAS bf16x8*)(itb + (((ks * 4 + fkq) ^ (wave & 7)) << 3)), acc, 0, 0, 0);
                      oacc[tt] = acc; }
                  __syncthreads();
#pragma unroll
                  for (int tt = 0; tt < 4; ++tt)
#pragma unroll
                      for (int r = 0; r < 4; ++r) obuf[(tt * 16 + fkq * 4 + r) * 136 + wave * 16 + fi] = f2bf(oacc[tt][r]); }
            }
            { const LAS bf16_t* itb = (const LAS bf16_t*)(ldsb + HL_IT) + (wave * 16 + fi) * 72;
#pragma unroll
              for (int kt = 0; kt < 8; ++kt) { f32x4 acc = (f32x4){0.f, 0.f, 0.f, 0.f};
                  const LAS bf16_t* ka = (const LAS bf16_t*)(ldsb + HL_KXT) + (kt * 16 + fi) * 72;
#pragma unroll
                  for (int ks = 0; ks < 2; ++ks) acc = __builtin_amdgcn_mfma_f32_16x16x32_bf16(*(const LAS bf16x8*)(ka + (((ks * 4 + fkq) ^ (kt & 7)) << 3)), *(const LAS bf16x8*)(itb + (((ks * 4 + fkq) ^ (wave & 7)) << 3)), acc, 0, 0, 0);
                  const f32x4 dv = *(LAS const f32x4*)(decv + kt * 16 + fkq * 4), ev = *(LAS const f32x4*)(e2v + kt * 16 + fkq * 4);
                  S[kt] = dv * S[kt] + ev * acc; } }
            __syncthreads();
            if (FULL) {
                const LAS bf16_t* ob = (const LAS bf16_t*)(ldsb + HL_OBUF) + t1 * 136 + c0;
                const u32x4 oa = *(const LAS u32x4*)ob, ob2 = *(const LAS u32x4*)(ob + 8); const unsigned ow[8] = {oa.x, oa.y, oa.z, oa.w, ob2.x, ob2.y, ob2.z, ob2.w};
                const u32x4 ga = *(const u32x4*)(hrow + 3072), gb = *(const u32x4*)(hrow + 3072 + 8); const unsigned gw[8] = {ga.x, ga.y, ga.z, ga.w, gb.x, gb.y, gb.z, gb.w};
                float o[16]; float ss = 0.f;
#pragma unroll
                for (int j = 0; j < 16; ++j) { o[j] = (j & 1) ? bfhi(ow[j >> 1]) : bflo(ow[j >> 1]); ss += o[j] * o[j]; }
                ss += __shfl_xor(ss, 1); ss += __shfl_xor(ss, 2); ss += __shfl_xor(ss, 4);
                const float rs = rsqrtf(ss * (1.0f / 128.0f) + 1e-6f);
                u32x4 w0, w1; float v[16];
#pragma unroll
                for (int j = 0; j < 16; ++j) v[j] = o[j] * rs * onorm[c0 + j] * ((j & 1) ? bfhi(gw[j >> 1]) : bflo(gw[j >> 1]));
                w0.x = cvt_pk_bf16(v[0], v[1]); w0.y = cvt_pk_bf16(v[2], v[3]); w0.z = cvt_pk_bf16(v[4], v[5]); w0.w = cvt_pk_bf16(v[6], v[7]);
                w1.x = cvt_pk_bf16(v[8], v[9]); w1.y = cvt_pk_bf16(v[10], v[11]); w1.z = cvt_pk_bf16(v[12], v[13]); w1.w = cvt_pk_bf16(v[14], v[15]);
                bf16_t* og = OG + (row0 + t1) * DM + h * 128 + c0; *(u32x4*)og = w0; *(u32x4*)(og + 8) = w1;
                __syncthreads();
            }
        }
        if (!FULL) {
            float* sl = SLOC + (size_t)unit * 16384;
#pragma unroll
            for (int kt = 0; kt < 8; ++kt)
#pragma unroll
                for (int r = 0; r < 4; ++r) sl[(kt * 16 + fkq * 4 + r) * 128 + wave * 16 + fi] = S[kt][r];
            if (tq == 3) DSEG[(size_t)unit * 128 + k2] = __expf(lseg);
        }
    }
}

typedef float f32x16 __attribute__((ext_vector_type(16)));
__device__ __forceinline__ void sel_scores(const bf16_t* kp, const bf16x8 (&qf)[4], f32x16 (&S)[2]) {
#pragma unroll
    for (int h = 0; h < 2; ++h) { bf16x8 kf[4];
#pragma unroll
        for (int s = 0; s < 4; ++s) kf[s] = *(const bf16x8*)(kp + h * 2048 + s * 8);
        S[h] = (f32x16){0.f};
#pragma unroll
        for (int s = 0; s < 4; ++s) S[h] = __builtin_amdgcn_mfma_f32_32x32x16_bf16(kf[s], qf[s], S[h], 0, 0, 0); }
}
__device__ __forceinline__ float row_bound(const bf16x8 (&qf)[4], float gmax) {
    float ss = 0.f;
#pragma unroll
    for (int s = 0; s < 4; ++s)
#pragma unroll
        for (int j = 0; j < 8; ++j) { const float v = bf2f((unsigned short)qf[s][j]); ss += v * v; }
    ss += __shfl_xor(ss, 32);
    return sqrtf(ss) * 8.08f * gmax;
}
__device__ __forceinline__ float dpp_quad_sum(float v) {
    v += __int_as_float(__builtin_amdgcn_update_dpp(0, __float_as_int(v), 0xB1, 0xF, 0xF, true));
    v += __int_as_float(__builtin_amdgcn_update_dpp(0, __float_as_int(v), 0x4E, 0xF, 0xF, true));
    return v; }
__device__ __forceinline__ void phase_sel2(PK p, LAS unsigned char* ldsb, int wid_s) {
    const int tid = opaque_tid(wid_s), lane = tid & 63, wave = __builtin_amdgcn_readfirstlane(tid >> 6);
    const bf16_t* Q = (const bf16_t*)(p->ws + WS_Q); const bf16_t* KC = (const bf16_t*)(p->ws + WS_KC); unsigned* SELM = (unsigned*)(p->ws + WS_SELM);
    LAS float* imp = (LAS float*)(ldsb + wave * 8448);
    const int n = lane & 31, hi = lane >> 5, ql = n >> 2, g = n & 3;
    const int pim = (n & ~12) | ((n & 4) << 1) | ((n & 8) >> 1);
    const float gmax0 = wave_max(fabsf(p->in[14][lane]));
    for (int u = blockIdx.x; u < 2048; u += gridDim.x) {
        const int bh = u >> 8, ii = u & 255, qb = (bh & 1) ? 255 - ii : ii, b = bh >> 2, kvh = bh & 3;
        const int tq = qb * 64 + wave * 8 + ql, hd = kvh * 4 + g, row = b * SEQ + tq;
        const int nvq = tq >= 31 ? ((tq - 31) >> 4) + 1 : 0;
        const int tmaxw = qb * 64 + wave * 8 + 7; const int nvmaxw = tmaxw >= 31 ? ((tmaxw - 31) >> 4) + 1 : 0; const int ncb = (qb >= 16) ? (nvmaxw + 63) >> 6 : 0;
        bf16x8 qf[4];
#pragma unroll
        for (int s = 0; s < 4; ++s) qf[s] = *(const bf16x8*)(Q + (size_t)row * DM + hd * 64 + 32 * hi + 8 * s);
        const bf16_t* kbase = KC + (size_t)bh * 65536 + pim * 64 + 32 * hi;
        for (int i = lane; i < 8 * 264; i += 64) imp[i] = 0.f;
        const float mfix = row_bound(qf, gmax0);
        float l = 0.f;
        for (int blk = 0; blk < ncb; ++blk) { f32x16 S[2]; sel_scores(kbase + (size_t)blk * 4096, qf, S);
            f32x2v ls2 = (f32x2v){0.f, 0.f};
#pragma unroll
            for (int h = 0; h < 2; ++h)
#pragma unroll
                for (int r = 0; r < 16; r += 2) { const int kpos = blk * 64 + 32 * h + 16 * (r >> 3) + 8 * hi + (r & 7);
                    f32x2v pv; pv.x = (kpos < nvq) ? __builtin_amdgcn_exp2f(S[h][r] - mfix) : 0.f; pv.y = (kpos + 1 < nvq) ? __builtin_amdgcn_exp2f(S[h][r + 1] - mfix) : 0.f; ls2 += pv; }
            l += ls2.x + ls2.y; }
        l += __shfl_xor(l, 32);
        const float mfn = l > 0.f ? mfix + log2f(l) : INFINITY;
        for (int blk = 0; blk < ncb; ++blk) { f32x16 S[2]; sel_scores(kbase + (size_t)blk * 4096, qf, S);
#pragma unroll
            for (int h = 0; h < 2; ++h)
#pragma unroll
                for (int rg = 0; rg < 2; ++rg) { float pv[8];
#pragma unroll
                    for (int e = 0; e < 8; ++e) { const int kpos = blk * 64 + 32 * h + 16 * rg + 8 * hi + e; pv[e] = (kpos < nvq) ? __builtin_amdgcn_exp2f(S[h][8 * rg + e] - mfn) : 0.f; }
                    float s0 = (pv[0] + pv[1]) + (pv[2] + pv[3]), s1 = pv[3] + (pv[4] + pv[5]) + (pv[6] + pv[7]), s2 = pv[7];
                    s0 = dpp_quad_sum(s0); s1 = dpp_quad_sum(s1); s2 = dpp_quad_sum(s2);
                    if (g == 0) { const int j0 = (blk * 64 + 32 * h + 16 * rg + 8 * hi) >> 2; LAS float* ip = imp + ql * 264 + j0;
                        atomicAdd((float*)ip, s0); atomicAdd((float*)(ip + 1), s1); atomicAdd((float*)(ip + 2), s2); } } }
        const int cur = qb;
#pragma unroll 1
        for (int q = 0; q < 8; ++q) {
            unsigned bits[4]; bool valid[4], sel[4];
#pragma unroll
            for (int i2 = 0; i2 < 4; ++i2) { const int j = lane + 64 * i2; valid[i2] = j <= cur; const float im = imp[q * 264 + j];
                const bool forced = (j == 0) || (j == cur) || (j == cur - 1);
                bits[i2] = valid[i2] ? __float_as_uint(forced ? 1e9f : im) : 0u; sel[i2] = valid[i2]; }
            if (cur + 1 > 16) {
                unsigned T = 0u;
#define TK_SEARCH(NI2) for (int bit = 29; bit >= 0; --bit) {     const unsigned cand = T | (1u << bit); int cnt = 0; \
                    _Pragma("unroll") for (int i2 = 0; i2 < NI2; ++i2) cnt += __popcll(__ballot(bits[i2] >= cand)); \
                    if (cnt >= 16) T = cand; }
                const int ni2 = (cur >> 6) + 1;
                if (ni2 == 1) { TK_SEARCH(1) } else if (ni2 == 2) { TK_SEARCH(2) } else if (ni2 == 3) { TK_SEARCH(3) } else { TK_SEARCH(4) }
#undef TK_SEARCH
                int cgt = 0;
#pragma unroll
                for (int i2 = 0; i2 < 4; ++i2) cgt += __popcll(__ballot(bits[i2] > T));
                int remaining = 16 - cgt;
                const unsigned long long ltmask = (1ull << lane) - 1ull;
#pragma unroll
                for (int i2 = 0; i2 < 4; ++i2) { const bool eq = (bits[i2] == T) && valid[i2]; const unsigned long long ball = __ballot(eq); const int rank = __popcll(ball & ltmask);
                    sel[i2] = valid[i2] && ((bits[i2] > T) || (eq && rank < remaining)); remaining -= min(remaining, (int)__popcll(ball)); }
            }
            const size_t item = (size_t)bh * SEQ + qb * 64 + wave * 8 + q;
#pragma unroll
            for (int i2 = 0; i2 < 4; ++i2) { const unsigned long long ball = __ballot(sel[i2]);
                if (lane == 0) { SELM[item * 8 + 2 * i2] = (unsigned)ball; SELM[item * 8 + 2 * i2 + 1] = (unsigned)(ball >> 32); } }
        }
    }
}

__device__ __forceinline__ void fc_ldk(LAS const unsigned char* tb, int kro, bf16x8 (&kf)[2][4]) {
#pragma unroll
    for (int h = 0; h < 2; ++h)
#pragma unroll
        for (int s = 0; s < 4; ++s) kf[h][s] = *(LAS const bf16x8*)(tb + kro + h * 32 * 144 + s * 16);
}
__device__ __forceinline__ void fc_ldv(LAS const unsigned char* tb, int vro, bf16x8 (&vf)[2][2][2]) {
#pragma unroll
    for (int h = 0; h < 2; ++h)
#pragma unroll
        for (int ks = 0; ks < 2; ++ks)
#pragma unroll
            for (int dh = 0; dh < 2; ++dh) vf[h][ks][dh] = *(LAS const bf16x8*)(tb + vro + dh * 32 * 144 + (h * 32 + ks * 16) * 2);
}
template <int MODE> __device__ __forceinline__ void flash_compute1(LAS const unsigned char* tb, int blk, bool edge, int kro, int vro, bool rowsel, const bf16x8 (&qf)[4], int tq, int nvq, int hi, float mfix, f32x16 (&O)[2], float& l) {
    f32x16 S[2];
    { bf16x8 kf[2][4]; fc_ldk(tb, kro, kf);
#pragma unroll
      for (int h = 0; h < 2; ++h) { S[h] = (f32x16){0.f};
#pragma unroll
          for (int s = 0; s < 4; ++s) S[h] = __builtin_amdgcn_mfma_f32_32x32x16_bf16(kf[h][s], qf[s], S[h], 0, 0, 0); } }
    bf16x8 vf[2][2][2]; fc_ldv(tb, vro, vf);
    if (edge) {
#pragma unroll
        for (int h = 0; h < 2; ++h)
#pragma unroll
            for (int r = 0; r < 16; ++r) { const int kpos = blk * 64 + 32 * h + 16 * (r >> 3) + 8 * hi + (r & 7); bool valid;
                if (MODE == 0) valid = kpos < nvq; else if (MODE == 1) valid = (kpos <= tq); else valid = (kpos <= tq) && (kpos > tq - 512);
                S[h][r] = valid ? S[h][r] : -INFINITY; }
    }
    const float mu = (MODE == 1) ? (rowsel ? mfix : INFINITY) : mfix;
    const f32x2v mu2 = (f32x2v){mu, mu};
    f32x2v ls2 = (f32x2v){0.f, 0.f};
#pragma unroll
    for (int h = 0; h < 2; ++h)
#pragma unroll
        for (int r = 0; r < 16; r += 2) { const f32x2v d = (f32x2v){S[h][r], S[h][r + 1]} - mu2; f32x2v pv; pv.x = __builtin_amdgcn_exp2f(d.x); pv.y = __builtin_amdgcn_exp2f(d.y);
            S[h][r] = pv.x; S[h][r + 1] = pv.y; ls2 += pv; }
    l += ls2.x + ls2.y;
#pragma unroll
    for (int h = 0; h < 2; ++h)
#pragma unroll
        for (int ks = 0; ks < 2; ++ks) { u32x4 w; w.x = cvt_pk_bf16(S[h][8 * ks], S[h][8 * ks + 1]); w.y = cvt_pk_bf16(S[h][8 * ks + 2], S[h][8 * ks + 3]); w.z = cvt_pk_bf16(S[h][8 * ks + 4], S[h][8 * ks + 5]); w.w = cvt_pk_bf16(S[h][8 * ks + 6], S[h][8 * ks + 7]);
            const bf16x8 pf = __builtin_bit_cast(bf16x8, w);
#pragma unroll
            for (int dh = 0; dh < 2; ++dh) O[dh] = __builtin_amdgcn_mfma_f32_32x32x16_bf16(vf[h][ks][dh], pf, O[dh], 0, 0, 0); }
}
constexpr int AL_KV = 0, AL_SLOT = 18432, AL_WU = 55296  , AL_WAVE = 55808  , AL_ACC = 68096  ;
template <int MODE> __device__ __forceinline__ void flash_blocks(const bf16_t* Kb, const bf16_t* Vt, int ldv, int base, int nblk, LAS const int* list, LAS const unsigned* qm, LAS const unsigned* wun,
                                                                LAS unsigned char* ldsb, int tid, const bf16x8 (&qf)[4], int tq, int nvq, int qb, int wave, int ql, int lane, float mfix, f32x16 (&O)[2], float& l) {
    const int m_ = lane & 31, hi = lane >> 5;
    const int pim = (m_ & ~12) | ((m_ & 4) << 1) | ((m_ & 8) >> 1);
    const int kro = pim * 144 + 64 * hi;
    const int vro = 9216 + m_ * 144 + 16 * hi;
    const int srow = tid >> 3, sch = tid & 7;
    const bf16_t* kg = Kb + (size_t)tid * 8;
    const bf16_t* vg = Vt + (size_t)srow * ldv + sch * 8;
    const int sdst = srow * 144 + sch * 16;
    const int tminw = qb * 64 + wave * 8, tmaxw = tminw + 7;
    const int nvminw = tminw >= 31 ? ((tminw - 31) >> 4) + 1 : 0, nvmaxw = tmaxw >= 31 ? ((tmaxw - 31) >> 4) + 1 : 0;
#define FB_BLK(i) ((MODE == 1) ? list[(i)] : base + (i))
    u32x4 ra[3], rb[3];
#pragma unroll
    for (int k = 0; k < 3; ++k) { ra[k] = (u32x4){0u, 0u, 0u, 0u}; rb[k] = ra[k]; if (k < nblk) { const int nb = FB_BLK(k); ra[k] = *(const u32x4*)(kg + (size_t)nb * 4096); rb[k] = *(const u32x4*)(vg + (size_t)nb * 64); } }
    for (int i0 = 0; i0 < nblk; i0 += 3) {
        __syncthreads();
#pragma unroll
        for (int k = 0; k < 3; ++k) if (i0 + k < nblk) { LAS unsigned char* sl = ldsb + AL_KV + k * AL_SLOT; *(LAS u32x4*)(sl + sdst) = ra[k]; *(LAS u32x4*)(sl + 9216 + sdst) = rb[k]; }
        __syncthreads();
#pragma unroll
        for (int k = 0; k < 3; ++k) if (i0 + 3 + k < nblk) { const int nb = FB_BLK(i0 + 3 + k); ra[k] = *(const u32x4*)(kg + (size_t)nb * 4096); rb[k] = *(const u32x4*)(vg + (size_t)nb * 64); }
#pragma unroll 1
        for (int k = 0; k < 3; ++k) { if (i0 + k >= nblk) break;
            const int blk = FB_BLK(i0 + k); bool need = true, edge;
            if (MODE == 0) { need = blk * 64 < nvmaxw; edge = !(blk * 64 + 63 < nvminw); }
            else if (MODE == 1) { need = (wun[blk >> 5] >> (blk & 31)) & 1u; edge = (blk == qb); }
            else edge = (blk == qb) || (blk == qb - 8);
            if (need) { bool rs = true; if (MODE == 1) rs = (qm[ql * 8 + (blk >> 5)] >> (blk & 31)) & 1u;
                flash_compute1<MODE>(ldsb + AL_KV + k * AL_SLOT, blk, edge, kro, vro, rs, qf, tq, nvq, hi, mfix, O, l); } }
    }
#undef FB_BLK
}
__device__ __forceinline__ void phase_att(PK p, LAS unsigned char* ldsb, int wid_s) {
    const int tid = opaque_tid(wid_s), lane = tid & 63, wave = __builtin_amdgcn_readfirstlane(tid >> 6);
    const bf16_t* Q = (const bf16_t*)(p->ws + WS_Q); const bf16_t* QR = (const bf16_t*)(p->ws + WS_QR); bf16_t* AO = (bf16_t*)(p->ws + WS_AO);
    const float* GATES = (const float*)(p->ws + WS_GATES); const unsigned* SELM = (const unsigned*)(p->ws + WS_SELM);
    const bf16_t* KC = (const bf16_t*)(p->ws + WS_KC); const bf16_t* VCt = (const bf16_t*)(p->ws + WS_VC);
    const bf16_t* KS = (const bf16_t*)(p->ws + WS_KV + 32 * MiB); const bf16_t* VSt = (const bf16_t*)(p->ws + WS_KV + 48 * MiB);
    const bf16_t* KW = (const bf16_t*)(p->ws + WS_KV + 64 * MiB); const bf16_t* VWt = (const bf16_t*)(p->ws + WS_KV + 80 * MiB);
    LAS unsigned* wu = (LAS unsigned*)(ldsb + AL_WU);
    LAS unsigned* qm = (LAS unsigned*)(ldsb + AL_WAVE + wave * 1536); LAS unsigned* wun = qm + 64; LAS int* list = (LAS int*)(qm + 128);
    const int n = lane & 31, hi = lane >> 5, ql = n >> 2, g = n & 3;
    const float* kn_ = p->in[14];
    const float gmax0 = wave_max(fabsf(kn_[lane])), gmax12 = wave_max(fmaxf(fabsf(kn_[64 + lane]), fabsf(kn_[128 + lane])));
    for (int u = blockIdx.x; u < 2048; u += gridDim.x) {
        const int bh = u >> 8, ii = u & 255, qb = (bh & 1) ? 255 - ii : ii, b = bh >> 2, kvh = bh & 3;
        const int tq = qb * 64 + wave * 8 + ql, hd = kvh * 4 + g, row = b * SEQ + tq;
        const int nvq = tq >= 31 ? ((tq - 31) >> 4) + 1 : 0;
        const int tmaxw = qb * 64 + wave * 8 + 7; const int nvmaxw = tmaxw >= 31 ? ((tmaxw - 31) >> 4) + 1 : 0;
        { const unsigned mw = SELM[((size_t)bh * SEQ + qb * 64 + wave * 8 + (lane >> 3)) * 8 + (lane & 7)];
          qm[lane] = mw;
          unsigned uw = mw; uw |= __shfl_xor(uw, 8); uw |= __shfl_xor(uw, 16); uw |= __shfl_xor(uw, 32);
          if (lane < 8) { wun[lane] = uw; wu[wave * 8 + lane] = uw; } }
        __syncthreads();
        int nsel = 0;
        { unsigned bu = 0u;
#pragma unroll
          for (int w2 = 0; w2 < 8; ++w2) bu |= wu[w2 * 8 + (lane & 7)];
          const int cnt = __popc(bu); int pre = 0;
#pragma unroll
          for (int w2 = 0; w2 < 8; ++w2) { const int c2 = __shfl(cnt, w2); if (w2 < (lane & 7)) pre += c2; nsel += c2; }
          if (lane < 8) { unsigned ww = bu; int k = pre; while (ww) { const int bpos = __ffs(ww) - 1; list[k++] = lane * 32 + bpos; ww &= ww - 1; } } }
        nsel = __builtin_amdgcn_readfirstlane(nsel);
        float gate[3];
#pragma unroll
        for (int br = 0; br < 3; ++br) gate[br] = GATES[(size_t)row * 48 + br * 16 + hd];
        LAS float* oacc = (LAS float*)(ldsb + AL_ACC + wave * 8192) + lane;
        bf16x8 qf[4];
#pragma unroll
        for (int s = 0; s < 4; ++s) qf[s] = *(const bf16x8*)(Q + (size_t)row * DM + hd * 64 + 32 * hi + 8 * s);
        float mfix = row_bound(qf, gmax0);
        { f32x16 O[2]; O[0] = (f32x16){0.f}; O[1] = (f32x16){0.f}; float l = 0.f;
          const int tmax = qb * 64 + 63; const int nvmax = ((tmax - 31) >> 4) + 1; const int ncb = (nvmax + 63) >> 6;
          flash_blocks<0>(KC + (size_t)bh * 65536, VCt + (size_t)bh * 65536, 1024, 0, ncb, list, qm, wun, ldsb, tid, qf, tq, nvq, qb, wave, ql, lane, mfix, O, l);
          l += __shfl_xor(l, 32); const float sc = l > 0.f ? gate[0] / l : 0.f;
#pragma unroll
          for (int dh = 0; dh < 2; ++dh)
#pragma unroll
              for (int r = 0; r < 16; ++r) oacc[(dh * 16 + r) * 64] = O[dh][r] * sc; }
#pragma unroll
        for (int s = 0; s < 4; ++s) qf[s] = *(const bf16x8*)(QR + (size_t)row * DM + hd * 64 + 32 * hi + 8 * s);
        mfix = row_bound(qf, gmax12);
        { f32x16 O[2]; O[0] = (f32x16){0.f}; O[1] = (f32x16){0.f}; float l = 0.f;
          flash_blocks<1>(KS + (size_t)bh * SEQ * 64, VSt + (size_t)bh * SEQ * 64, SEQ, 0, nsel, list, qm, wun, ldsb, tid, qf, tq, nvq, qb, wave, ql, lane, mfix, O, l);
          l += __shfl_xor(l, 32); const float sc = l > 0.f ? gate[1] / l : 0.f;
#pragma unroll
          for (int dh = 0; dh < 2; ++dh)
#pragma unroll
              for (int r = 0; r < 16; ++r) oacc[(dh * 16 + r) * 64] += O[dh][r] * sc; }
        { f32x16 O[2]; O[0] = (f32x16){0.f}; O[1] = (f32x16){0.f}; float l = 0.f;
          const int b0 = max(0, qb - 8);
          flash_blocks<2>(KW + (size_t)bh * SEQ * 64, VWt + (size_t)bh * SEQ * 64, SEQ, b0, qb - b0 + 1, list, qm, wun, ldsb, tid, qf, tq, nvq, qb, wave, ql, lane, mfix, O, l);
          l += __shfl_xor(l, 32); const float sc = l > 0.f ? gate[2] / l : 0.f;
          bf16_t* op = AO + (size_t)row * DM + hd * 64 + 4 * hi;
#pragma unroll
          for (int dh = 0; dh < 2; ++dh)
#pragma unroll
              for (int rq = 0; rq < 4; ++rq) { float v[4];
#pragma unroll
                  for (int e = 0; e < 4; ++e) v[e] = oacc[(dh * 16 + rq * 4 + e) * 64] + O[dh][rq * 4 + e] * sc;
                  u32x2 w; w.x = cvt_pk_bf16(v[0], v[1]); w.y = cvt_pk_bf16(v[2], v[3]); *(u32x2*)(op + 32 * dh + 8 * rq) = w; } }
    }
}

#define XB_TMO      128
#define XB_XCNT(j)  (256  + 64 * (j))
#define XB_XSUB(j)  (1280 + 64 * (j))
#define XB_XGEN(j)  (2304 + 64 * (j))
#define XB_TOP      3328
#define XB_TOPGEN   3392
#define XCD_BAR_WORDS 3456
#define XB_SPIN_CAP (1u << 18)

__device__ __forceinline__ unsigned xb_ld(unsigned* p)              { return __hip_atomic_load(p, __ATOMIC_RELAXED, __HIP_MEMORY_SCOPE_AGENT); }
__device__ __forceinline__ unsigned xb_add(unsigned* p, unsigned v) { return __hip_atomic_fetch_add(p, v, __ATOMIC_RELAXED, __HIP_MEMORY_SCOPE_AGENT); }
__device__ __forceinline__ unsigned xb_xcc_id() { return (unsigned)__builtin_amdgcn_s_getreg((3 << 11) | 20) & 0xFu; }
#define XB_SPIN(cond, bar) do { unsigned _sp = 0; while (cond) { __builtin_amdgcn_s_sleep(1); \
    if ((++_sp & 255u) == 0u) { if (xb_ld(&(bar)[XB_TMO])) break; if (_sp > XB_SPIN_CAP) { atomicAdd(&(bar)[XB_TMO], 1u); break; } } } } while (0)

struct XcdBarrier {
    unsigned* bar; unsigned x;
    volatile LAS unsigned* st;
};

__device__ __forceinline__ XcdBarrier xcd_barrier_post(unsigned* bar, volatile LAS unsigned* st, bool is0) {
    XcdBarrier b; b.bar = bar; b.x = xb_xcc_id(); b.st = st;
    if (is0) (void)xb_add(&bar[XB_XCNT(b.x)], 1u);
    return b;
}
__device__ __forceinline__ void xcd_barrier_complete(unsigned* bar, unsigned x, unsigned& nloc, unsigned& nx) {
    const unsigned G = gridDim.x * gridDim.y * gridDim.z;
    unsigned sum, cnt, mine, sp = 0u;
    for (;;) {
        sum = 0u; cnt = 0u; mine = 0u;
#pragma unroll
        for (unsigned j = 0; j < 16; ++j) { const unsigned c = xb_ld(&bar[XB_XCNT(j)]); sum += c; cnt += (c > 0u) ? 1u : 0u; mine = (j == x) ? c : mine; }
        if (sum == G) break;
        __builtin_amdgcn_s_sleep(1);
        if ((++sp & 255u) == 0u) { if (xb_ld(&bar[XB_TMO])) break; if (sp > XB_SPIN_CAP) { atomicAdd(&bar[XB_TMO], 1u); break; } }
    }
    nloc = mine > 0u ? mine : 1u; nx = cnt > 0u ? cnt : 1u;
}

__device__ __attribute__((noinline)) void xcd_barrier(const XcdBarrier b, bool is0) {
    asm volatile("s_waitcnt vmcnt(0)" ::: "memory");
    __syncthreads();
    if (is0) {
        unsigned* bar = b.bar;
        __builtin_amdgcn_s_waitcnt(0);
        unsigned nloc = b.st[0], nx = b.st[1];
        if (nloc == 0u) { xcd_barrier_complete(bar, b.x, nloc, nx); b.st[0] = nloc; b.st[1] = nx; }
        const unsigned old = xb_add(&bar[XB_XSUB(b.x)], 1u);
        const unsigned gen = old / nloc;
        if (old + 1u == (gen + 1u) * nloc) {
            __builtin_amdgcn_fence(__ATOMIC_RELEASE, "agent");
            asm volatile("s_waitcnt vmcnt(0)" ::: "memory");
            const unsigned og = xb_add(&bar[XB_TOP], 1u);
            const unsigned tg = og / nx;
            if (og + 1u == (tg + 1u) * nx) xb_add(&bar[XB_TOPGEN], 1u);
            else XB_SPIN(xb_ld(&bar[XB_TOPGEN]) == tg, bar);
            __builtin_amdgcn_fence(__ATOMIC_ACQUIRE, "agent");
            xb_add(&bar[XB_XGEN(b.x)], 1u);
            asm volatile("s_waitcnt vmcnt(0)" ::: "memory");
        } else {
            XB_SPIN(xb_ld(&bar[XB_XGEN(b.x)]) == gen, bar);
            __builtin_amdgcn_fence(__ATOMIC_ACQUIRE, "agent");
            asm volatile("s_waitcnt vmcnt(0)" ::: "memory");
        }
    }
    __syncthreads();
}

__global__ void __launch_bounds__(NTHR, 2) yoco_fwd(Params p_unused) {
    extern __shared__ __attribute__((aligned(16))) unsigned char lds_raw[];
    LAS unsigned char* ldsb = (LAS unsigned char*)lds_raw;
    cg::grid_group grid = cg::this_grid();
    const int wid_s = __builtin_amdgcn_readfirstlane((int)threadIdx.x >> 6);
    volatile LAS unsigned* bst = (volatile LAS unsigned*)(ldsb + LDS_BYTES - 16);
    { const int t0_ = opaque_tid(wid_s); if (t0_ == 0) { bst[0] = 0u; bst[1] = 0u; } __syncthreads(); }
    XcdBarrier xbar; { PK pk = fresh_pk(); xbar = xcd_barrier_post((unsigned*)(pk->ws + WS_BAR), bst, opaque_tid(wid_s) == 0); }
#define GSYNC() xcd_barrier(xbar, opaque_tid(wid_s) == 0)
#define FRESH() PK pk = fresh_pk(); unsigned char* ws = pk->ws; float* mods = (float*)(ws + WS_MODS); float* SS = (float*)(ws + WS_SS); const float* BIAS = (const float*)(ws + WS_BIAS); \
    const f32x2v* cs = (const f32x2v*)(ws + WS_CS); bf16_t* XB = (bf16_t*)(ws + WS_XB); bf16_t* XB2 = (bf16_t*)(ws + WS_XB2); bf16_t* HB = (bf16_t*)(ws + WS_HB); bf16_t* OB = (bf16_t*)(ws + WS_OB); bf16_t* HID = (bf16_t*)(ws + WS_HID); \
    float* xout = pk->out; (void)mods; (void)SS; (void)BIAS; (void)cs; (void)XB; (void)XB2; (void)HB; (void)OB; (void)HID; (void)xout;

    { PK pk = fresh_pk(); phase0(pk, ldsb, wid_s); }
    GSYNC();
    if (fresh_pk()->out == nullptr) grid.sync();
    { PK pk = fresh_pk(); phase1(pk, ldsb, wid_s); }
    GSYNC();

#pragma unroll 1
    for (int layer = 0; layer < 4; ++layer) {
        if (layer < 2) {
            { FRESH(); EpiHin E{HB, SS + (size_t)(2 * layer) * MR, BIAS + BO_HIN + layer * 8192};
              RUN_GEMM(EpiHin, E, XB, ws + WS_WHIN + (size_t)layer * 4096 * 1024 * 2, MR, 4096, 1024, 1024); }
            GSYNC();
            { FRESH(); phase_hgrn<false>(HB, OB, (float*)(ws + WS_SLOC), (float*)(ws + WS_DSEG), pk->in[7], pk->in[8] + layer * 128, layer, ldsb, wid_s); }
            GSYNC();
            { FRESH(); phase_hgrn<true>(HB, OB, (float*)(ws + WS_SLOC), (float*)(ws + WS_DSEG), pk->in[7], pk->in[8] + layer * 128, layer, ldsb, wid_s); }
            GSYNC();
            { FRESH(); const float* xold = (layer == 0) ? pk->in[0] : xout;
              EpiRes<false> E{xold, xout, mods + (2 * layer) * 6144 + 2048, SS + (size_t)(2 * layer + 1) * MR, XB, BIAS + BO_GM + (2 * layer + 1) * 2048, nullptr, nullptr};
              RUN_GEMM(EpiRes<false>, E, OB, ws + WS_WHOUT + (size_t)layer * 1024 * 1024 * 2, MR, 1024, 1024, 1024); }
            GSYNC();
        } else {
            const int bl = layer - 2;
            if (bl == 0) {
                { FRESH(); EpiKV E{(bf16_t*)(ws + WS_KV), SS + (size_t)4 * MR, BIAS + BO_KV, pk->in[14], cs};
                  RUN_GEMM(EpiKV, E, XB2, ws + WS_WKV, MR, 1536, 1024, 1024); }
            }
            { FRESH(); EpiQ E{(bf16_t*)(ws + WS_Q), (bf16_t*)(ws + WS_QR), (float*)(ws + WS_GATES), SS + (size_t)(2 * layer) * MR, BIAS + BO_Q + bl * 2560, pk->in[19] + bl * 64, cs};
              RUN_GEMM(EpiQ, E, XB, ws + WS_WQ + (size_t)bl * 1280 * 1024 * 2, MR, 1280, 1024, 1024); }
            GSYNC();
            if (bl == 0) {
#pragma unroll 1
                for (int j = 0; j < 2; ++j) { FRESH(); EpiC1 E{(bf16_t*)(ws + WS_CHID) + (size_t)j * 8192 * 256, BIAS + BO_C1 + j * 256};
                    RUN_GEMM_AT(EpiC1, E, ws + WS_KV + (size_t)j * 16 * MiB, ws + WS_WC1 + (size_t)j * 256 * 2048 * 2, 8192, 256, 2048, 1024, (gridDim.x >= 64) ? 32 * j : 0); }
                GSYNC();
#pragma unroll 1
                for (int j = 0; j < 2; ++j) { FRESH(); EpiC2 E{(bf16_t*)(ws + (j == 0 ? WS_KC : WS_VC)), j == 0 ? pk->in[14] : nullptr, j};
                    RUN_GEMM_AT(EpiC2, E, ws + WS_CHID + (size_t)j * 8192 * 256 * 2, ws + WS_WC2 + (size_t)j * 256 * 256 * 2, 8192, 256, 256, 256, (gridDim.x >= 64) ? 32 * j : 0); }
                GSYNC();
            }
            { PK pk = fresh_pk(); phase_sel2(pk, ldsb, wid_s); }
            GSYNC();
            { PK pk = fresh_pk(); phase_att(pk, ldsb, wid_s); }
            GSYNC();
            { FRESH(); EpiRes<false> E{xout, xout, mods + (2 * layer) * 6144 + 2048, SS + (size_t)(2 * layer + 1) * MR, XB, BIAS + BO_GM + (2 * layer + 1) * 2048, nullptr, nullptr};
              RUN_GEMM(EpiRes<false>, E, ws + WS_AO, ws + WS_WAO + (size_t)bl * 1024 * 1024 * 2, MR, 1024, 1024, 1024); }
            GSYNC();
        }
        { FRESH(); EpiFin E{HID, SS + (size_t)(2 * layer + 1) * MR, BIAS + BO_FIN + layer * 11264};
          RUN_GEMM(EpiFin, E, XB, ws + WS_WFIN + (size_t)layer * 5632 * 1024 * 2, MR, 5632, 1024, 1024); }
        GSYNC();
        { FRESH(); const bool last = (layer == 3);
          float* sso = last ? SS : SS + (size_t)(2 * layer + 2) * MR; const float* gmn = BIAS + BO_GM + (last ? 0 : (2 * layer + 2) * 2048);
          const bf16_t* Wt = (const bf16_t*)(ws + WS_WFOUT + (size_t)layer * 1024 * 2816 * 2);
          if (layer == 1) { EpiRes<true> E{xout, xout, mods + (2 * layer + 1) * 6144 + 2048, sso, XB, gmn, XB2, BIAS + BO_GM + 8 * 2048};
              RUN_GEMM(EpiRes<true>, E, HID, Wt, MR, 1024, 2816, 2816); }
          else { EpiRes<false> E{xout, xout, mods + (2 * layer + 1) * 6144 + 2048, sso, XB, gmn, nullptr, nullptr};
              RUN_GEMM(EpiRes<false>, E, HID, Wt, MR, 1024, 2816, 2816); } }
        if (layer < 3) GSYNC();
    }
}

extern "C" void kernel_launch(void* const* d_in, const int* in_sizes, int n_in, void* d_out, int out_size, void* d_ws, size_t ws_size, hipStream_t stream) {
    static int grid = 0;
    if (grid == 0) {
        if (n_in != 23 || out_size != MR * DM || ws_size < WS_END) { fprintf(stderr, "kernel_launch: unexpected problem (n_in %d out %d ws %zu)\n", n_in, out_size, ws_size); grid = -1; return; }
        int dev = 0, cus = 0, per_cu = 0;
        hipGetDevice(&dev); hipDeviceGetAttribute(&cus, hipDeviceAttributeMultiprocessorCount, dev);
        hipFuncSetAttribute((const void*)yoco_fwd, hipFuncAttributeMaxDynamicSharedMemorySize, LDS_BYTES);
        hipOccupancyMaxActiveBlocksPerMultiprocessor(&per_cu, (const void*)yoco_fwd, NTHR, LDS_BYTES);
        if (per_cu < 1) per_cu = 1;
        grid = cus * per_cu;
        fprintf(stderr, "kernel_launch: grid %d (cus %d x %d)\n", grid, cus, per_cu);
    }
    if (grid < 0) return;
    (void)hipMemsetAsync((char*)d_ws + WS_BAR, 0, 16384, stream);
    Params p{};
    for (int i = 0; i < 23; ++i) p.in[i] = (const float*)d_in[i];
    p.out = (float*)d_out; p.ws = (unsigned char*)d_ws;
    void* args[] = {&p};
    hipError_t e = hipLaunchCooperativeKernel((const void*)yoco_fwd, dim3(grid), dim3(NTHR), args, LDS_BYTES, stream);
    if (e != hipSuccess) fprintf(stderr, "cooperative launch failed: %s (grid %d)\n", hipGetErrorString(e), grid);
}
```

```cpp
#include <hip/hip_runtime.h>
#include <hip/hip_cooperative_groups.h>
#include <cstdio>
#include <cstdint>
namespace cg = cooperative_groups;
__device__ __forceinline__ int opaque_tid(int wid) { int l; asm volatile("v_mbcnt_lo_u32_b32 %0, -1, 0\n\tv_mbcnt_hi_u32_b32 %0, -1, %0" : "=v"(l)); int w = wid; asm volatile("" : "+s"(w)); return (w << 6) | l; }
namespace pg8 {
#define PG8_LAS __attribute__((address_space(3)))
typedef unsigned short bf16_t;
typedef short bf16x8 __attribute__((ext_vector_type(8)));
typedef float f32x4 __attribute__((ext_vector_type(4)));
typedef unsigned u32x4 __attribute__((ext_vector_type(4)));
constexpr int BM = 256, BK = 64, HALF = 128, HTB = HALF * BK * 2  , STAGE_BYTES = 8 * HTB, NXCD = 8, WGM = 8;

__host__ __device__ __forceinline__ int lds_byte(int r, int c) { const int st = (r >> 4) * 2 + (c >> 5), rr = r & 15, cc = c & 31, ob = rr * 64 + cc * 2; return st * 1024 + (ob ^ (((ob >> 9) & 1) << 5)); }
__host__ __device__ __forceinline__ void stage_rc(int b, int& R, int& C) { const int st = b / 1024, sb = b % 1024, swz = sb ^ (((sb >> 9) & 1) << 5); R = (st >> 1) * 16 + swz / 64; C = (st & 1) * 32 + (swz % 64) / 2; }
__host__ __device__ __forceinline__ int perm32(int rho) { const int n = rho >> 4, i = rho & 15; return 8 * (i >> 2) + 4 * n + (i & 3); }

struct Unit { int pm, pn; };
struct Gemm { const bf16_t* A; const bf16_t* Bt; int M, N, K, lda; };

struct StaticOrder {
    int nM, nN, nwg, G, c;
    __host__ __device__ void init(int M, int N, int G_, int c_) { nM = M / BM; nN = N / BM; nwg = nM * nN; G = G_; c = c_; }
    __host__ __device__ bool next(int i, Unit& u) const {
        const long L = (long)i * G + c; if (c < 0 || L >= nwg) return false;
        int wgid = (int)L; { const int q = nwg / NXCD, r = nwg % NXCD, xcd = wgid % NXCD, off = wgid / NXCD; wgid = (xcd < r ? xcd * (q + 1) : r * (q + 1) + (xcd - r) * q) + off; }
        const int nig = WGM * nN, gid = wgid / nig, fm = gid * WGM, gsz = (nM - fm) < WGM ? (nM - fm) : WGM;
        u.pm = fm + ((wgid % nig) % gsz); u.pn = (wgid % nig) / gsz; return true;
    }
    __device__ __forceinline__ void a_ready(const Unit&) const {}
    __device__ __forceinline__ void done(const Unit&) const {}
};

typedef float f32x2c __attribute__((ext_vector_type(2))); typedef __bf16 bf16x2c __attribute__((ext_vector_type(2)));
__device__ __forceinline__ unsigned cvt_pk_bf16(float lo, float hi) { f32x2c v = {lo, hi}; bf16x2c b = __builtin_convertvector(v, bf16x2c); return __builtin_bit_cast(unsigned, b); }
typedef float f32x2 __attribute__((ext_vector_type(2)));
template <class Epi, class Sched, bool ALIGN_EPI = false, bool SP2 = false>
__device__ __forceinline__ void gemm_phase(PG8_LAS unsigned char* lds, const Gemm g, const Sched& S, const Epi& E, int wid_) {
    const int tid = opaque_tid(wid_), wid = __builtin_amdgcn_readfirstlane(tid >> 6), lane = tid & 63, wr = wid >> 2, wc = wid & 3, fr = lane & 15, fq = lane >> 4;
    const int K = g.K, nt = K / BK;
    unsigned voffA, voffB;
    { int R, C; stage_rc(tid * 16, R, C); const int Rb = Epi::PERM ? ((R & ~31) + perm32(R & 31)) : R;
      voffA = (unsigned)(R * g.lda + C) * 2u; voffB = (unsigned)(Rb * K + C) * 2u; }
    const size_t stepA = (size_t)64 * g.lda * 2, stepB = (size_t)64 * K * 2;
    const size_t kstep = (size_t)(BK * 2);
    const size_t hstepA = (size_t)HALF * g.lda * 2, hstepB = (size_t)HALF * K * 2;
    const size_t tstepA = 2 * hstepA, tstepB = 2 * hstepB;
    const unsigned ldsw = (unsigned)wid * 1024u;
    const int aoff = lds_byte(wr * 64 + fr, fq * 8), boff = lds_byte(wc * 32 + fr, fq * 8);
#define PG8_SA(b, h) (((b) * 2 + (h)) * HTB)
#define PG8_SB(b, h) ((4 + (b) * 2 + (h)) * HTB)
#define PG8_STAGE(bufoff, gbase, voff, rstep) do { _Pragma("unroll") for (int _i = 0; _i < 2; ++_i) \
        __builtin_amdgcn_global_load_lds((const unsigned*)((const char*)(gbase) + (size_t)_i * (rstep) + (voff)), (PG8_LAS unsigned*)(lds + (bufoff) + ldsw + _i * 8192), 16, 0, 0); } while (0)
#define PG8_LDA(dst, b, h) do { _Pragma("unroll") for (int m = 0; m < 4; ++m) _Pragma("unroll") for (int k = 0; k < 2; ++k) dst[m][k] = *(const PG8_LAS bf16x8*)(lds + PG8_SA(b, h) + aoff + m * 2048 + k * 1024); } while (0)
#define PG8_LDB(dst, b, h) do { _Pragma("unroll") for (int n = 0; n < 2; ++n) _Pragma("unroll") for (int k = 0; k < 2; ++k) dst[n][k] = *(const PG8_LAS bf16x8*)(lds + PG8_SB(b, h) + boff + n * 2048 + k * 1024); } while (0)
#define PG8_MMA(ai, bj, At, Bt) do { __builtin_amdgcn_s_setprio(1); _Pragma("unroll") for (int m = 0; m < 4; ++m) _Pragma("unroll") for (int n = 0; n < 2; ++n) _Pragma("unroll") for (int k = 0; k < 2; ++k) \
        acc[ai][bj][m][n] = __builtin_amdgcn_mfma_f32_16x16x32_bf16(Bt[n][k], At[m][k], acc[ai][bj][m][n], 0, 0, 0); __builtin_amdgcn_s_setprio(0); } while (0)
#define PG8_WAIT_V(n) asm volatile("s_waitcnt vmcnt(" #n ")" ::: "memory")
#define PG8_WAIT_L(n) asm volatile("s_waitcnt lgkmcnt(" #n ")" ::: "memory")
#define PG8_BAR __builtin_amdgcn_s_barrier()
#define PG8_SCHED __builtin_amdgcn_sched_barrier(0)
    Unit cur, nxt; int ui = 0;
    if (!S.next(0, cur)) return;
    f32x4 acc[2][2][4][2];
#pragma unroll
    for (int a = 0; a < 2; ++a)
#pragma unroll
        for (int b = 0; b < 2; ++b)
#pragma unroll
            for (int m = 0; m < 4; ++m)
#pragma unroll
                for (int n = 0; n < 2; ++n) acc[a][b][m][n] = (f32x4){0.f, 0.f, 0.f, 0.f};
    bf16x8 At[4][2], B0[2][2], B1[2][2];
    const char* cA = (const char*)g.A + (size_t)cur.pm * tstepA; const char* cB = (const char*)g.Bt + (size_t)cur.pn * tstepB;
    S.a_ready(cur);
    if constexpr (SP2) {
        PG8_STAGE(PG8_SB(0, 0), cB, voffB, stepB); PG8_STAGE(PG8_SB(0, 1), cB + hstepB, voffB, stepB); PG8_STAGE(PG8_SA(0, 0), cA, voffA, stepA); PG8_STAGE(PG8_SA(0, 1), cA + hstepA, voffA, stepA);
        if (wr == 1) PG8_BAR;
        PG8_WAIT_V(2); PG8_BAR;
        PG8_STAGE(PG8_SB(1, 0), cB + kstep, voffB, stepB); PG8_STAGE(PG8_SA(1, 0), cA + kstep, voffA, stepA); PG8_STAGE(PG8_SB(1, 1), cB + hstepB + kstep, voffB, stepB);
        PG8_WAIT_V(6); PG8_BAR;
    } else {
        PG8_STAGE(PG8_SB(0, 0), cB, voffB, stepB); PG8_STAGE(PG8_SA(0, 0), cA, voffA, stepA); PG8_STAGE(PG8_SB(0, 1), cB + hstepB, voffB, stepB); PG8_STAGE(PG8_SA(0, 1), cA + hstepA, voffA, stepA);
        if (wr == 1) PG8_BAR;
        PG8_WAIT_V(4); PG8_BAR;
        PG8_STAGE(PG8_SB(1, 0), cB + kstep, voffB, stepB); PG8_STAGE(PG8_SA(1, 0), cA + kstep, voffA, stepA); PG8_STAGE(PG8_SB(1, 1), cB + hstepB + kstep, voffB, stepB);
        PG8_WAIT_V(6); PG8_BAR;
    }
    for (;;) {
        const bool has_next = S.next(ui + 1, nxt);
        const char* nA = has_next ? (const char*)g.A + (size_t)nxt.pm * tstepA : cA; const char* nB = has_next ? (const char*)g.Bt + (size_t)nxt.pn * tstepB : cB;
        for (int t = 0; t < nt; t += 2) {
            const bool last = (t == nt - 2);
            const char* a1 = cA + (size_t)(t + 1) * kstep;
            const char* a2 = last ? nA : cA + (size_t)(t + 2) * kstep; const char* b2 = last ? nB : cB + (size_t)(t + 2) * kstep;
            const char* a3 = a2 + kstep; const char* b3 = b2 + kstep;
            if (last && has_next) S.a_ready(nxt);
            if constexpr (SP2) {
            PG8_LDB(B0, 0, 0); PG8_LDB(B1, 0, 1); PG8_SCHED; PG8_LDA(At, 0, 0); PG8_STAGE(PG8_SA(1, 1), a1 + hstepA, voffA, stepA);
            PG8_WAIT_V(8); PG8_WAIT_L(0); PG8_BAR; PG8_MMA(0, 0, At, B0); PG8_MMA(0, 1, At, B1); PG8_BAR; PG8_SCHED;
            PG8_LDA(At, 0, 1); PG8_STAGE(PG8_SB(0, 0), b2, voffB, stepB); PG8_STAGE(PG8_SB(0, 1), b2 + hstepB, voffB, stepB); PG8_STAGE(PG8_SA(0, 0), a2, voffA, stepA);
            PG8_WAIT_V(8); PG8_WAIT_L(0); PG8_BAR; PG8_MMA(1, 0, At, B0); PG8_MMA(1, 1, At, B1); PG8_BAR; PG8_SCHED;
            PG8_LDB(B0, 1, 0); PG8_LDB(B1, 1, 1); PG8_SCHED; PG8_LDA(At, 1, 0); PG8_STAGE(PG8_SA(0, 1), a2 + hstepA, voffA, stepA);
            PG8_WAIT_V(8); PG8_WAIT_L(0); PG8_BAR; PG8_MMA(0, 0, At, B0); PG8_MMA(0, 1, At, B1); PG8_BAR; PG8_SCHED;
            PG8_LDA(At, 1, 1); PG8_STAGE(PG8_SB(1, 0), b3, voffB, stepB); PG8_STAGE(PG8_SB(1, 1), b3 + hstepB, voffB, stepB); PG8_STAGE(PG8_SA(1, 0), a3, voffA, stepA);
            PG8_WAIT_V(8); PG8_WAIT_L(0); PG8_BAR; PG8_MMA(1, 0, At, B0); PG8_MMA(1, 1, At, B1); PG8_BAR; PG8_SCHED;
            } else {
            PG8_LDB(B0, 0, 0); PG8_SCHED; PG8_LDA(At, 0, 0); PG8_STAGE(PG8_SA(1, 1), a1 + hstepA, voffA, stepA);
            PG8_WAIT_L(8); PG8_BAR; PG8_WAIT_L(0); PG8_MMA(0, 0, At, B0); PG8_BAR; PG8_SCHED;
            PG8_LDB(B1, 0, 1); PG8_STAGE(PG8_SB(0, 0), b2, voffB, stepB);
            PG8_BAR; PG8_WAIT_L(0); PG8_MMA(0, 1, At, B1); PG8_BAR;
            PG8_LDA(At, 0, 1); PG8_STAGE(PG8_SA(0, 0), a2, voffA, stepA);
            PG8_BAR; PG8_WAIT_L(0); PG8_MMA(1, 0, At, B0); PG8_BAR; PG8_SCHED;
            PG8_STAGE(PG8_SB(0, 1), b2 + hstepB, voffB, stepB);
            PG8_WAIT_V(6); PG8_BAR; PG8_MMA(1, 1, At, B1); PG8_BAR;
            PG8_LDB(B0, 1, 0); PG8_SCHED; PG8_LDA(At, 1, 0); PG8_STAGE(PG8_SA(0, 1), a2 + hstepA, voffA, stepA);
            PG8_WAIT_L(8); PG8_BAR; PG8_WAIT_L(0); PG8_MMA(0, 0, At, B0); PG8_BAR; PG8_SCHED;
            PG8_LDB(B1, 1, 1); PG8_STAGE(PG8_SB(1, 0), b3, voffB, stepB);
            PG8_BAR; PG8_WAIT_L(0); PG8_MMA(0, 1, At, B1); PG8_BAR;
            PG8_LDA(At, 1, 1); PG8_STAGE(PG8_SA(1, 0), a3, voffA, stepA);
            PG8_BAR; PG8_WAIT_L(0); PG8_MMA(1, 0, At, B0); PG8_BAR; PG8_SCHED;
            PG8_STAGE(PG8_SB(1, 1), b3 + hstepB, voffB, stepB);
            PG8_WAIT_V(6); PG8_BAR; PG8_MMA(1, 1, At, B1); PG8_BAR;
            }
        }
        if constexpr (ALIGN_EPI) { if (wr == 0) PG8_BAR; }
        if constexpr (!Epi::AFTER_DRAIN) { E(acc, cur, wr, wc, fr, fq); S.done(cur); }
        if (!has_next) break;
#pragma unroll
        for (int a = 0; a < 2; ++a)
#pragma unroll
            for (int b = 0; b < 2; ++b)
#pragma unroll
                for (int m = 0; m < 4; ++m)
#pragma unroll
                    for (int n = 0; n < 2; ++n) acc[a][b][m][n] = (f32x4){0.f, 0.f, 0.f, 0.f};
        cur = nxt; cA = nA; cB = nB; ++ui;
        if constexpr (ALIGN_EPI) { if (wr == 1) PG8_BAR; }
    }
    PG8_WAIT_V(0);
    if constexpr (!ALIGN_EPI) { if (wr == 0) PG8_BAR; }
    PG8_BAR;
    if constexpr (Epi::AFTER_DRAIN) { E.fused(acc, cur, wr, wc, fr, fq, lds, wid, lane); S.done(cur); }
#undef PG8_SA
#undef PG8_SB
#undef PG8_STAGE
#undef PG8_LDA
#undef PG8_LDB
#undef PG8_MMA
#undef PG8_WAIT_V
#undef PG8_WAIT_L
#undef PG8_BAR
#undef PG8_SCHED
}
}

#define LAS __attribute__((address_space(3)))
using pg8::bf16_t; using pg8::f32x4; using pg8::u32x4; using pg8::cvt_pk_bf16; using pg8::Unit; using pg8::bf16x8;
typedef unsigned u32x2 __attribute__((ext_vector_type(2)));
typedef float f32x2v __attribute__((ext_vector_type(2)));
constexpr int NB = 2, SEQ = 16384, DM = 1024, MR = NB * SEQ, FFH = 2816, NTHR = 512;
constexpr size_t MiB = 1u << 20;
constexpr size_t WS_MODS = 0, WS_KVMODS = 256 * 1024, WS_SS = 1 * MiB, WS_BIAS = 2 * MiB, WS_CS = 3 * MiB;
constexpr size_t WS_WHIN = 8 * MiB, WS_WHOUT = 24 * MiB, WS_WFIN = 28 * MiB, WS_WFOUT = 72 * MiB, WS_WQ = 94 * MiB, WS_WKV = 99 * MiB, WS_WAO = 102 * MiB, WS_WC1 = 106 * MiB, WS_WC2 = 108 * MiB;
constexpr size_t WS_XB = 112 * MiB, WS_R = 176 * MiB;
constexpr size_t WS_HB = WS_R, WS_OB = 432 * MiB, WS_HID = WS_R, WS_Q = WS_R, WS_QR = 240 * MiB, WS_AO = 304 * MiB, WS_XB2 = 352 * MiB, WS_GATES = 370 * MiB, WS_SELM = 376 * MiB, WS_SLOC = 496 * MiB, WS_DSEG = 2 * MiB + 512 * 1024, WS_BAR = 768 * 1024;
constexpr size_t WS_KC = 406 * MiB, WS_VC = 407 * MiB, WS_CHID = 408 * MiB, WS_KV = 416 * MiB;
constexpr size_t WS_END = 512 * MiB;
constexpr int BO_HIN = 0, BO_FIN = 16384, BO_Q = BO_FIN + 45056, BO_KV = BO_Q + 5120, BO_C1 = BO_KV + 3072, BO_GM = BO_C1 + 512;
constexpr int LDS_BYTES = 147456;

struct Params { const float* in[23]; float* out; unsigned char* ws; };
typedef const __attribute__((address_space(4))) Params* PK;
__device__ __forceinline__ PK fresh_pk() { PK k = (PK)__builtin_amdgcn_kernarg_segment_ptr(); asm volatile("" : "+s"(k)); return k; }

__device__ __forceinline__ float bf2f(unsigned short v) { return __uint_as_float(((unsigned)v) << 16); }
__device__ __forceinline__ float bflo(unsigned w) { return __uint_as_float(w << 16); }
__device__ __forceinline__ float bfhi(unsigned w) { return __uint_as_float(w & 0xffff0000u); }
__device__ __forceinline__ float fsigmoid(float v) { return __builtin_amdgcn_rcpf(1.f + __expf(-v)); }
__device__ __forceinline__ float fsilu(float v) { return v * fsigmoid(v); }
__device__ __forceinline__ float wave_sum(float v) {
#pragma unroll
    for (int o = 32; o >= 1; o >>= 1) v += __shfl_xor(v, o);
    return v; }
__device__ __forceinline__ float wave_max(float v) {
#pragma unroll
    for (int o = 32; o >= 1; o >>= 1) v = fmaxf(v, __shfl_xor(v, o));
    return v; }

__device__ __forceinline__ int opaque_lane() { int l; asm volatile("v_mbcnt_lo_u32_b32 %0, -1, 0\n\tv_mbcnt_hi_u32_b32 %0, -1, %0" : "=v"(l)); return l; }
__device__ __forceinline__ float shx(float v, int lane, int mask) { return __int_as_float(__builtin_amdgcn_ds_bpermute((lane ^ mask) << 2, __float_as_int(v))); }
__device__ __forceinline__ bf16_t f2bf(float v) { return (bf16_t)(cvt_pk_bf16(v, 0.f) & 0xffffu); }

struct TJob { const float* W; bf16_t* Wt; int K, Nsrc, Npad, kind, ntiles; };
__device__ __forceinline__ int map_col(int kind, int r) {
    if (kind == 0) return r;
    const int tile = r >> 8, w = r & 255;
    if (kind == 1) { const int j = tile * 128 + (w & 127); return (w < 128) ? j : FFH + j; }
    const int bj = w >> 7, wc = (w >> 5) & 3, jj = w & 31;
    if (kind == 2) { if (r < 1024) return tile * 256 + wc * 64 + bj * 32 + jj; const int g = r - 1024; return g < 48 ? 1024 + g : -1; }
    if (kind == 4) return tile * 256 + wc * 64 + bj * 32 + jj;
    return (wc == 0) ? bj * 32 + jj : -1;
}
__device__ __forceinline__ void get_tjob(PK p, int j, TJob& o) {
    unsigned char* ws = p->ws;
    if (j < 2) { o.W = p->in[6] + (size_t)j * 1024 * 4096; o.Wt = (bf16_t*)(ws + WS_WHIN) + (size_t)j * 4096 * 1024; o.K = 1024; o.Nsrc = 4096; o.Npad = 4096; o.kind = 0; }
    else if (j < 4) { const int l = j - 2; o.W = p->in[9] + (size_t)l * 1024 * 1024; o.Wt = (bf16_t*)(ws + WS_WHOUT) + (size_t)l * 1024 * 1024; o.K = 1024; o.Nsrc = 1024; o.Npad = 1024; o.kind = 0; }
    else if (j < 8) { const int l = j - 4; o.W = p->in[21] + (size_t)l * 1024 * 5632; o.Wt = (bf16_t*)(ws + WS_WFIN) + (size_t)l * 5632 * 1024; o.K = 1024; o.Nsrc = 5632; o.Npad = 5632; o.kind = 1; }
    else if (j < 12) { const int l = j - 8; o.W = p->in[22] + (size_t)l * 2816 * 1024; o.Wt = (bf16_t*)(ws + WS_WFOUT) + (size_t)l * 1024 * 2816; o.K = 2816; o.Nsrc = 1024; o.Npad = 1024; o.kind = 0; }
    else if (j < 14) { const int l = j - 12; o.W = p->in[18] + (size_t)l * 1024 * 1072; o.Wt = (bf16_t*)(ws + WS_WQ) + (size_t)l * 1280 * 1024; o.K = 1024; o.Nsrc = 1072; o.Npad = 1280; o.kind = 2; }
    else if (j == 14) { o.W = p->in[13]; o.Wt = (bf16_t*)(ws + WS_WKV); o.K = 1024; o.Nsrc = 1536; o.Npad = 1536; o.kind = 4; }
    else if (j < 17) { const int l = j - 15; o.W = p->in[20] + (size_t)l * 1024 * 1024; o.Wt = (bf16_t*)(ws + WS_WAO) + (size_t)l * 1024 * 1024; o.K = 1024; o.Nsrc = 1024; o.Npad = 1024; o.kind = 0; }
    else if (j < 19) { const int l = j - 17; o.W = p->in[16] + (size_t)l * 2048 * 256; o.Wt = (bf16_t*)(ws + WS_WC1) + (size_t)l * 256 * 2048; o.K = 2048; o.Nsrc = 256; o.Npad = 256; o.kind = 0; }
    else { const int l = j - 19; o.W = p->in[17] + (size_t)l * 256 * 64; o.Wt = (bf16_t*)(ws + WS_WC2) + (size_t)l * 256 * 256; o.K = 256; o.Nsrc = 64; o.Npad = 256; o.kind = 3; }
    o.ntiles = (o.K / 64) * (o.Npad / 64);
}
__device__ __forceinline__ void transpose_tiles(const TJob& J, int tile0, int G, LAS float* scr, int tid) {
    const int nrt = J.Npad / 64; const int rl = tid & 63, kl = tid >> 6; const int rr = tid >> 3, kc = tid & 7;
    float v[4][8];
#pragma unroll
    for (int t = 0; t < 4; ++t) { const int tile = tile0 + t * G;
        if (tile < J.ntiles) { const int kt = tile / nrt, rt = tile % nrt; const int sc = map_col(J.kind, rt * 64 + rl);
#pragma unroll
            for (int i = 0; i < 8; ++i) v[t][i] = sc >= 0 ? J.W[(size_t)(kt * 64 + kl + 8 * i) * J.Nsrc + sc] : 0.f; } }
#pragma unroll
    for (int t = 0; t < 4; ++t) if (tile0 + t * G < J.ntiles) {
#pragma unroll
        for (int i = 0; i < 8; ++i) scr[t * 4160 + (kl + 8 * i) * 65 + rl] = v[t][i]; }
    __syncthreads();
#pragma unroll
    for (int t = 0; t < 4; ++t) { const int tile = tile0 + t * G; if (tile >= J.ntiles) continue;
        const int kt = tile / nrt, rt = tile % nrt;
        LAS const float* sp = scr + t * 4160 + (kc * 8) * 65 + rr;
        u32x4 o; o.x = cvt_pk_bf16(sp[0], sp[65]); o.y = cvt_pk_bf16(sp[130], sp[195]); o.z = cvt_pk_bf16(sp[260], sp[325]); o.w = cvt_pk_bf16(sp[390], sp[455]);
        *(u32x4*)(J.Wt + (size_t)(rt * 64 + rr) * J.K + kt * 64 + kc * 8) = o; }
    __syncthreads();
}

__device__ __forceinline__ void phase0(PK p, LAS unsigned char* ldsb, int wid_s) {
    const int tid = opaque_tid(wid_s), G = gridDim.x;
    float* mods = (float*)(p->ws + WS_MODS); float* kvmods = (float*)(p->ws + WS_KVMODS); float* SS = (float*)(p->ws + WS_SS);
    for (int i = blockIdx.x * NTHR + tid; i < 8 * MR; i += G * NTHR) SS[i] = 0.f;
    LAS float* ca = (LAS float*)ldsb; LAS float* red = ca + 2048;
    for (int i = tid; i < 2048; i += NTHR) ca[i] = fsilu(p->in[1][i]);
    __syncthreads();
    for (int item = blockIdx.x; item < 208; item += G) {
        const float* W; const float* bias; float* out; int ld, col0, ostride;
        if (item < 192) { const int l = item / 24, cb = item % 24; W = p->in[2] + (size_t)l * 1024 * 3072; ld = 3072; col0 = cb * 128; bias = p->in[3] + l * 3072; out = mods + l * 6144; ostride = 3072; }
        else { W = p->in[10]; ld = 2048; col0 = (item - 192) * 128; bias = p->in[11]; out = kvmods; ostride = 2048; }
        const int ks = tid >> 5, cq = tid & 31;
        f32x4 a0 = (f32x4){0.f, 0.f, 0.f, 0.f}, a1 = a0;
        const float* wp = W + (size_t)(ks * 64) * ld + col0 + cq * 4;
#pragma unroll 8
        for (int k = 0; k < 64; ++k) { const f32x4 w = *(const f32x4*)(wp + (size_t)k * ld); a0 += w * ca[ks * 64 + k]; a1 += w * ca[1024 + ks * 64 + k]; }
        LAS f32x4* red4 = (LAS f32x4*)red;
        red4[(ks * 32 + cq) * 2] = a0; red4[(ks * 32 + cq) * 2 + 1] = a1;
        __syncthreads();
        if (tid < 256) { const int col = tid & 127, bb = tid >> 7; float sum = 0.f;
#pragma unroll
            for (int q = 0; q < 16; ++q) sum += red[((q * 32 + (col >> 2)) * 2 + bb) * 4 + (col & 3)];
            out[bb * ostride + col0 + col] = sum + bias[col0 + col]; }
        __syncthreads();
    }
    f32x2v* cs = (f32x2v*)(p->ws + WS_CS);
    for (int i = blockIdx.x * NTHR + tid; i < SEQ * 32; i += G * NTHR) {
        const int t = i >> 5, d = i & 31;
        const float e = (float)(2 * d) / 64.f; const float invf = 1.0f / exp2f(e * 13.287712379549449f);
        const float ang = (float)t * invf;
        double r = (double)ang * 0.15915494309189535; r -= rint(r);
        const float rf = (float)r;
        cs[i] = (f32x2v){__builtin_amdgcn_cosf(rf), __builtin_amdgcn_sinf(rf)};
    }
    LAS float* scr = (LAS float*)ldsb + 4096;
    int base = 0;
#pragma unroll 1
    for (int j = 0; j < 21; ++j) { TJob J; get_tjob(p, j, J);
        int first = ((int)blockIdx.x - base) % G; if (first < 0) first += G;
        for (int tile = first; tile < J.ntiles; tile += 4 * G) transpose_tiles(J, tile, G, scr, tid);
        base += J.ntiles; }
}

__device__ __forceinline__ void phase1(PK p, LAS unsigned char* ldsb, int wid_s) {
    const int tid = opaque_tid(wid_s), G = gridDim.x, lane = tid & 63, wave = tid >> 6;
    const float* mods = (const float*)(p->ws + WS_MODS); const float* kvmods = (const float*)(p->ws + WS_KVMODS); float* BIAS = (float*)(p->ws + WS_BIAS);
    for (int gr = blockIdx.x * 8 + wave; gr < 35328; gr += G * 8) {
        const bf16_t* wr; const float* s0; const float* s1; float* out; int K, ostride; int r = gr;
        if (r < 8192) { const int l = r >> 12; r &= 4095; wr = (const bf16_t*)(p->ws + WS_WHIN) + ((size_t)l * 4096 + r) * 1024; K = 1024; s0 = mods + (2 * l) * 6144; s1 = s0 + 3072; out = BIAS + BO_HIN + l * 8192 + r; ostride = 4096; }
        else if ((r -= 8192) < 22528) { const int l = r / 5632; r -= l * 5632; wr = (const bf16_t*)(p->ws + WS_WFIN) + ((size_t)l * 5632 + r) * 1024; K = 1024; s0 = mods + (2 * l + 1) * 6144; s1 = s0 + 3072; out = BIAS + BO_FIN + l * 11264 + r; ostride = 5632; }
        else if ((r -= 22528) < 2560) { const int l = r / 1280; r -= l * 1280; wr = (const bf16_t*)(p->ws + WS_WQ) + ((size_t)l * 1280 + r) * 1024; K = 1024; s0 = mods + (2 * (l + 2)) * 6144; s1 = s0 + 3072; out = BIAS + BO_Q + l * 2560 + r; ostride = 1280; }
        else if ((r -= 2560) < 1536) { wr = (const bf16_t*)(p->ws + WS_WKV) + (size_t)r * 1024; K = 1024; s0 = kvmods; s1 = kvmods + 2048; out = BIAS + BO_KV + r; ostride = 1536; }
        else { r -= 1536; const int l = r >> 8; r &= 255; wr = (const bf16_t*)(p->ws + WS_WC1) + ((size_t)l * 256 + r) * 2048; K = 2048; s0 = p->in[15] + l * 2048; s1 = s0; out = BIAS + BO_C1 + l * 256 + r; ostride = 0; }
        float a0 = 0.f, a1 = 0.f;
        for (int k = lane * 8; k < K; k += 512) { const u32x4 w = *(const u32x4*)(wr + k);
            const f32x4 x0 = *(const f32x4*)(s0 + k), x1 = *(const f32x4*)(s0 + k + 4), y0 = *(const f32x4*)(s1 + k), y1 = *(const f32x4*)(s1 + k + 4);
            const float wf[8] = {bflo(w.x), bfhi(w.x), bflo(w.y), bfhi(w.y), bflo(w.z), bfhi(w.z), bflo(w.w), bfhi(w.w)};
            a0 += (x0.x * wf[0] + x0.y * wf[1]) + (x0.z * wf[2] + x0.w * wf[3]) + (x1.x * wf[4] + x1.y * wf[5]) + (x1.z * wf[6] + x1.w * wf[7]);
            a1 += (y0.x * wf[0] + y0.y * wf[1]) + (y0.z * wf[2] + y0.w * wf[3]) + (y1.x * wf[4] + y1.y * wf[5]) + (y1.z * wf[6] + y1.w * wf[7]); }
        a0 = wave_sum(a0); a1 = wave_sum(a1);
        if (lane == 0) { out[0] = a0; if (ostride) out[ostride] = a1; }
    }
    for (int i = blockIdx.x * NTHR + tid; i < 9 * 2048; i += G * NTHR) { const int l2 = i >> 11, b = (i >> 10) & 1, k = i & 1023;
        float g, sc; if (l2 < 8) { g = ((l2 & 1) ? p->in[5] : p->in[4])[(l2 >> 1) * 1024 + k]; sc = mods[l2 * 6144 + b * 3072 + 1024 + k]; } else { g = p->in[12][k]; sc = kvmods[b * 2048 + 1024 + k]; }
        BIAS[BO_GM + i] = g * (1.0f + sc); }
    const float* x = p->in[0]; bf16_t* XB = (bf16_t*)(p->ws + WS_XB); float* SS0 = (float*)(p->ws + WS_SS);
    const float* ng = p->in[4]; const float* scl = mods + 1024;
    for (int row = blockIdx.x * 8 + wave; row < MR; row += G * 8) {
        const int b = row >> 14; f32x4 v[4]; float ss = 0.f;
#pragma unroll
        for (int j = 0; j < 4; ++j) { v[j] = *(const f32x4*)(x + (size_t)row * DM + j * 256 + lane * 4); ss += (v[j].x * v[j].x + v[j].y * v[j].y) + (v[j].z * v[j].z + v[j].w * v[j].w); }
        ss = wave_sum(ss); if (lane == 0) SS0[row] = ss;
#pragma unroll
        for (int j = 0; j < 4; ++j) { const int col = j * 256 + lane * 4; const f32x4 g = *(const f32x4*)(ng + col); const f32x4 s = *(const f32x4*)(scl + b * 3072 + col);
            const f32x4 o = v[j] * (g * (s + 1.0f)); u32x2 w; w.x = cvt_pk_bf16(o.x, o.y); w.y = cvt_pk_bf16(o.z, o.w); *(u32x2*)(XB + (size_t)row * DM + col) = w; }
    }
}

#define EPI_ROWS(ai, m) (u.pm * 256 + (ai) * 128 + wr * 64 + (m) * 16 + fr)
__device__ __forceinline__ float rstd_of(const float* ss, int row) { return rsqrtf(ss[row] * (1.0f / 1024.0f) + 1e-6f); }

struct EpiHin {
    static constexpr bool PERM = true, AFTER_DRAIN = false;
    bf16_t* HB; const float* ss; const float* bias;
    __device__ __forceinline__ void operator()(const f32x4 (&acc)[2][2][4][2], const Unit& u, int wr, int wc, int fr_, int fq_) const {
        const int lane_ = opaque_lane(), fr = lane_ & 15, fq = lane_ >> 4;
        const int seg = u.pn >> 2; const bool act = (seg == 0) || (seg == 3);
#pragma unroll
        for (int ai = 0; ai < 2; ++ai)
#pragma unroll
            for (int m = 0; m < 4; ++m) { asm volatile("" ::: "memory"); const int row = EPI_ROWS(ai, m), b = row >> 14; const float rs = rstd_of(ss, row);
#pragma unroll
                for (int bj = 0; bj < 2; ++bj) { const int c0 = u.pn * 256 + bj * 128 + wc * 32 + fq * 8;
                    f32x4 v0 = acc[ai][bj][m][0] * rs + *(const f32x4*)(bias + b * 4096 + c0), v1 = acc[ai][bj][m][1] * rs + *(const f32x4*)(bias + b * 4096 + c0 + 4);
                    if (act) { v0 = (f32x4){fsilu(v0.x), fsilu(v0.y), fsilu(v0.z), fsilu(v0.w)}; v1 = (f32x4){fsilu(v1.x), fsilu(v1.y), fsilu(v1.z), fsilu(v1.w)}; }
                    u32x4 w; w.x = cvt_pk_bf16(v0.x, v0.y); w.y = cvt_pk_bf16(v0.z, v0.w); w.z = cvt_pk_bf16(v1.x, v1.y); w.w = cvt_pk_bf16(v1.z, v1.w);
                    *(u32x4*)(HB + (size_t)row * 4096 + c0) = w; } }
    }
};
struct EpiFin {
    static constexpr bool PERM = true, AFTER_DRAIN = false;
    bf16_t* HID; const float* ss; const float* bias;
    __device__ __forceinline__ void operator()(const f32x4 (&acc)[2][2][4][2], const Unit& u, int wr, int wc, int fr_, int fq_) const {
        const int lane_ = opaque_lane(), fr = lane_ & 15, fq = lane_ >> 4;
        const int ca = u.pn * 256 + wc * 32 + fq * 8, cb = ca + 128, co = u.pn * 128 + wc * 32 + fq * 8;
#pragma unroll
        for (int ai = 0; ai < 2; ++ai)
#pragma unroll
            for (int m = 0; m < 4; ++m) { asm volatile("" ::: "memory"); const int row = EPI_ROWS(ai, m), b = row >> 14; const float rs = rstd_of(ss, row);
                const f32x4 a0 = acc[ai][0][m][0] * rs + *(const f32x4*)(bias + b * 5632 + ca), a1 = acc[ai][0][m][1] * rs + *(const f32x4*)(bias + b * 5632 + ca + 4);
                const f32x4 b0 = acc[ai][1][m][0] * rs + *(const f32x4*)(bias + b * 5632 + cb), b1 = acc[ai][1][m][1] * rs + *(const f32x4*)(bias + b * 5632 + cb + 4);
                u32x4 w; w.x = cvt_pk_bf16(fsilu(a0.x) * b0.x, fsilu(a0.y) * b0.y); w.y = cvt_pk_bf16(fsilu(a0.z) * b0.z, fsilu(a0.w) * b0.w);
                w.z = cvt_pk_bf16(fsilu(a1.x) * b1.x, fsilu(a1.y) * b1.y); w.w = cvt_pk_bf16(fsilu(a1.z) * b1.z, fsilu(a1.w) * b1.w);
                *(u32x4*)(HID + (size_t)row * FFH + co) = w; }
    }
};
template <bool XB2> struct EpiRes {
    static constexpr bool PERM = true, AFTER_DRAIN = false;
    const float* xold; float* xout; const float* gate;
    float* ssout; bf16_t* xb; const float* gm1;
    bf16_t* xb2; const float* gm2;
    __device__ __forceinline__ void operator()(const f32x4 (&acc)[2][2][4][2], const Unit& u, int wr, int wc, int fr_, int fq_) const {
        const int lane_ = opaque_lane(), fr = lane_ & 15, fq = lane_ >> 4;
#pragma unroll
        for (int ai = 0; ai < 2; ++ai)
#pragma unroll
            for (int m = 0; m < 4; ++m) { const int row = EPI_ROWS(ai, m), b = row >> 14; float sq = 0.f;
#pragma unroll
                for (int bj = 0; bj < 2; ++bj)
#pragma unroll
                    for (int n = 0; n < 2; ++n) { asm volatile("" ::: "memory");
                        const int c0 = u.pn * 256 + bj * 128 + wc * 32 + fq * 8 + n * 4; const size_t off = (size_t)row * DM + c0;
                        const f32x4 x0 = *(const f32x4*)(xold + off) + *(const f32x4*)(gate + b * 3072 + c0) * acc[ai][bj][m][n];
                        *(f32x4*)(xout + off) = x0;
                        sq += (x0.x * x0.x + x0.y * x0.y) + (x0.z * x0.z + x0.w * x0.w);
                        { const f32x4 o0 = x0 * *(const f32x4*)(gm1 + b * 1024 + c0); u32x2 w; w.x = cvt_pk_bf16(o0.x, o0.y); w.y = cvt_pk_bf16(o0.z, o0.w); *(u32x2*)(xb + off) = w; }
                        if (XB2) { const f32x4 o0 = x0 * *(const f32x4*)(gm2 + b * 1024 + c0); u32x2 w; w.x = cvt_pk_bf16(o0.x, o0.y); w.y = cvt_pk_bf16(o0.z, o0.w); *(u32x2*)(xb2 + off) = w; } }
                sq += shx(sq, lane_, 16); sq += shx(sq, lane_, 32);
                if (fq == 0) atomicAdd(ssout + row, sq); }
    }
};
__device__ __forceinline__ void head_norm(float (&v0)[8], float (&v1)[8], const float* gain, int fq, int lane_) {
    float s = 0.f;
#pragma unroll
    for (int i = 0; i < 8; ++i) s += v0[i] * v0[i] + v1[i] * v1[i];
    s += shx(s, lane_, 16); s += shx(s, lane_, 32);
    const float r = rsqrtf(s * (1.0f / 64.0f) + 1e-6f);
#pragma unroll
    for (int i = 0; i < 8; ++i) { v0[i] = v0[i] * r * gain[fq * 8 + i]; v1[i] = v1[i] * r * gain[32 + fq * 8 + i]; }
}
__device__ __forceinline__ void store8(bf16_t* p, const float (&v)[8]) { u32x4 w; w.x = cvt_pk_bf16(v[0], v[1]); w.y = cvt_pk_bf16(v[2], v[3]); w.z = cvt_pk_bf16(v[4], v[5]); w.w = cvt_pk_bf16(v[6], v[7]); *(u32x4*)p = w; }
__device__ __forceinline__ void rope8(const float (&v0)[8], const float (&v1)[8], const f32x2v* cs, int t, int fq, float (&r0)[8], float (&r1)[8]) {
#pragma unroll
    for (int i = 0; i < 8; ++i) { const f32x2v c = cs[t * 32 + fq * 8 + i]; r0[i] = v0[i] * c.x - v1[i] * c.y; r1[i] = v1[i] * c.x + v0[i] * c.y; }
}
struct EpiQ {
    static constexpr bool PERM = true, AFTER_DRAIN = false;
    bf16_t* Q; bf16_t* QR; float* GATES; const float* ss; const float* bias; const float* qn; const f32x2v* cs;
    __device__ __forceinline__ void operator()(const f32x4 (&acc)[2][2][4][2], const Unit& u, int wr, int wc, int fr_, int fq_) const {
        const int lane_ = opaque_lane(), fr = lane_ & 15, fq = lane_ >> 4;
#pragma unroll
        for (int ai = 0; ai < 2; ++ai)
#pragma unroll
            for (int m = 0; m < 4; ++m) { asm volatile("" ::: "memory"); const int row = EPI_ROWS(ai, m), b = row >> 14, t = row & (SEQ - 1); const float rs = rstd_of(ss, row);
                const float* bp = bias + b * 1280 + u.pn * 256 + wc * 32 + fq * 8;
                float v0[8], v1[8];
#pragma unroll
                for (int i = 0; i < 8; ++i) { v0[i] = acc[ai][0][m][i >> 2][i & 3] * rs + bp[i]; v1[i] = acc[ai][1][m][i >> 2][i & 3] * rs + bp[128 + i]; }
                if (u.pn < 4) { const int hd = u.pn * 4 + wc;
                    head_norm(v0, v1, qn, fq, lane_);
#pragma unroll
                    for (int i = 0; i < 8; ++i) { v0[i] *= 0.18033688011112042f; v1[i] *= 0.18033688011112042f; }
                    bf16_t* qp = Q + (size_t)row * DM + hd * 64 + fq * 8; store8(qp, v0); store8(qp + 32, v1);
                    float r0[8], r1[8]; rope8(v0, v1, cs, t, fq, r0, r1);
                    bf16_t* rp = QR + (size_t)row * DM + hd * 64 + fq * 8; store8(rp, r0); store8(rp + 32, r1);
                } else {
                    const int cg = wc * 32 + fq * 8;
#pragma unroll
                    for (int i = 0; i < 8; ++i) if (cg + i < 48) GATES[(size_t)row * 48 + cg + i] = fsigmoid(v0[i]);
                } }
    }
};
struct EpiKV {
    static constexpr bool PERM = true, AFTER_DRAIN = false;
    bf16_t* KV; const float* ss; const float* bias; const float* kn; const f32x2v* cs;
    __device__ __forceinline__ void operator()(const f32x4 (&acc)[2][2][4][2], const Unit& u, int wr, int wc, int fr_, int fq_) const {
        const int lane_ = opaque_lane(), fr = lane_ & 15, fq = lane_ >> 4;
        bf16_t* dst = KV + (size_t)u.pn * (8u << 20);
        const bool nr = (u.pn == 2) || (u.pn == 4);
#pragma unroll
        for (int ai = 0; ai < 2; ++ai)
#pragma unroll
            for (int m = 0; m < 4; ++m) { asm volatile("" ::: "memory"); const int row = EPI_ROWS(ai, m), b = row >> 14, t = row & (SEQ - 1); const float rs = rstd_of(ss, row);
                const float* bp = bias + b * 1536 + u.pn * 256 + wc * 32 + fq * 8;
                float v0[8], v1[8];
#pragma unroll
                for (int i = 0; i < 8; ++i) { v0[i] = acc[ai][0][m][i >> 2][i & 3] * rs + bp[i]; v1[i] = acc[ai][1][m][i >> 2][i & 3] * rs + bp[128 + i]; }
                bf16_t* op = dst + ((size_t)(b * 4 + wc) * SEQ + t) * 64 + fq * 8;
                if (nr) { head_norm(v0, v1, kn + (u.pn >> 1) * 64, fq, lane_); float r0[8], r1[8]; rope8(v0, v1, cs, t, fq, r0, r1); store8(op, r0); store8(op + 32, r1); }
                else if (u.pn == 3 || u.pn == 5) {
                    bf16_t* tp = dst + ((size_t)(b * 4 + wc) * 64 + fq * 8) * SEQ + t;
#pragma unroll
                    for (int i = 0; i < 8; ++i) { tp[(size_t)i * SEQ] = f2bf(v0[i]); tp[(size_t)(32 + i) * SEQ] = f2bf(v1[i]); } }
                else { store8(op, v0); store8(op + 32, v1); } }
    }
};
struct EpiC1 {
    static constexpr bool PERM = true, AFTER_DRAIN = false;
    bf16_t* H; const float* bias;
    __device__ __forceinline__ void operator()(const f32x4 (&acc)[2][2][4][2], const Unit& u, int wr, int wc, int fr_, int fq_) const {
        const int lane_ = opaque_lane(), fr = lane_ & 15, fq = lane_ >> 4;
#pragma unroll
        for (int ai = 0; ai < 2; ++ai)
#pragma unroll
            for (int m = 0; m < 4; ++m) { asm volatile("" ::: "memory"); const int row = EPI_ROWS(ai, m);
#pragma unroll
                for (int bj = 0; bj < 2; ++bj) { const int c0 = bj * 128 + wc * 32 + fq * 8; float v[8];
#pragma unroll
                    for (int i = 0; i < 8; ++i) v[i] = fsilu(acc[ai][bj][m][i >> 2][i & 3] + bias[c0 + i]);
                    store8(H + (size_t)row * 256 + c0, v); } }
    }
};
struct EpiC2 {
    static constexpr bool PERM = true, AFTER_DRAIN = false;
    bf16_t* O; const float* kn; int tr;
    __device__ __forceinline__ void operator()(const f32x4 (&acc)[2][2][4][2], const Unit& u, int wr, int wc, int fr_, int fq_) const {
        const int lane_ = opaque_lane(), fr = lane_ & 15, fq = lane_ >> 4;
        if (wc != 0) return;
#pragma unroll
        for (int ai = 0; ai < 2; ++ai)
#pragma unroll
            for (int m = 0; m < 4; ++m) { asm volatile("" ::: "memory"); const int row = EPI_ROWS(ai, m); float v0[8], v1[8];
#pragma unroll
                for (int i = 0; i < 8; ++i) { v0[i] = acc[ai][0][m][i >> 2][i & 3]; v1[i] = acc[ai][1][m][i >> 2][i & 3]; }
                if (kn) head_norm(v0, v1, kn, fq, lane_);
                if (tr) { bf16_t* tp = O + ((size_t)(row >> 10) * 64 + fq * 8) * 1024 + (row & 1023);
#pragma unroll
                    for (int i = 0; i < 8; ++i) { tp[i * 1024] = f2bf(v0[i]); tp[(32 + i) * 1024] = f2bf(v1[i]); } }
                else { bf16_t* op = O + (size_t)row * 64 + fq * 8; store8(op, v0); store8(op + 32, v1); } }
    }
};
#define RUN_GEMM(EpiT, E, Aptr, Btptr, Mv, Nv, Kv, ldav) do { pg8::Gemm g_{(const bf16_t*)(Aptr), (const bf16_t*)(Btptr), (Mv), (Nv), (Kv), (ldav)}; pg8::StaticOrder S_; int g_x_ = (int)gridDim.x, b_x_ = (int)blockIdx.x; asm volatile("" : "+s"(g_x_), "+s"(b_x_)); S_.init((Mv), (Nv), g_x_, b_x_); \
    pg8::gemm_phase<EpiT, pg8::StaticOrder, true, true>(ldsb, g_, S_, (E), wid_s); } while (0)
#define RUN_GEMM_AT(EpiT, E, Aptr, Btptr, Mv, Nv, Kv, ldav, cshift) do { pg8::Gemm g_{(const bf16_t*)(Aptr), (const bf16_t*)(Btptr), (Mv), (Nv), (Kv), (ldav)}; pg8::StaticOrder S_; int g_x_ = (int)gridDim.x, b_x_ = (int)blockIdx.x - (cshift); asm volatile("" : "+s"(g_x_), "+s"(b_x_)); S_.init((Mv), (Nv), g_x_, b_x_); \
    pg8::gemm_phase<EpiT, pg8::StaticOrder, true, true>(ldsb, g_, S_, (E), wid_s); } while (0)

constexpr int HL_G = 0, HL_ATT = 0, HL_OBUF = 9216, HL_QX = 32768, HL_KX = 50176, HL_KXT = 67584, HL_IT = 86016, HL_ST = 104448, HL_VEC = 139264;
template <bool FULL> __device__ __forceinline__ void phase_hgrn(const bf16_t* HB, bf16_t* OG, float* SLOC, float* DSEG, const float* lbraw, const float* onorm, int layer, LAS unsigned char* ldsb, int wid_s) {
    const int tid = opaque_tid(wid_s), lane = tid & 63, wave = __builtin_amdgcn_readfirstlane(tid >> 6);
    const int t1 = tid >> 3, c0 = (tid & 7) * 16;
    const int k2 = tid & 127, tq = tid >> 7;
    const int fi = lane & 15, fkq = lane >> 4;
    LAS float* Gs = (LAS float*)(ldsb + HL_G); LAS float* vec = (LAS float*)(ldsb + HL_VEC);
    LAS float* eg31 = vec, *e2v = vec + 128, *decv = vec + 256, *lbv = vec + 384, *tot = vec + 512;
    for (int unit = blockIdx.x; unit < 256; unit += gridDim.x) {
        const int b = unit >> 7, h = (unit >> 4) & 7, seg = unit & 15;
        if (!FULL && seg == 15) continue;
        if (tid < 128) { float lb = 0.f; if (layer == 1) lb = 1.0f / (1.0f + __expf(lbraw[h * 128 + tid] - lbraw[1024 + h * 128 + tid])); lbv[tid] = lb; }
        f32x4 S[8];
#pragma unroll
        for (int kt = 0; kt < 8; ++kt) S[kt] = (f32x4){0.f, 0.f, 0.f, 0.f};
        if (FULL) {
            for (int sp = 0; sp < seg; ++sp) { const float* sl = SLOC + (size_t)(unit - seg + sp) * 16384; const float* ds = DSEG + (size_t)(unit - seg + sp) * 128;
#pragma unroll
                for (int kt = 0; kt < 8; ++kt)
#pragma unroll
                    for (int r = 0; r < 4; ++r) { const int k = kt * 16 + fkq * 4 + r; S[kt][r] = ds[k] * S[kt][r] + sl[k * 128 + wave * 16 + fi]; } }
        }
        float lseg = 0.f;
        u32x4 pfa, pfb, pia, pib;
        { const bf16_t* h0 = HB + ((size_t)b * SEQ + seg * 1024 + t1) * 4096 + h * 128 + c0;
          pfa = *(const u32x4*)(h0 + 1024); pfb = *(const u32x4*)(h0 + 1024 + 8); pia = *(const u32x4*)(h0 + 2048); pib = *(const u32x4*)(h0 + 2048 + 8);
        }
        __syncthreads();
#pragma unroll 1
        for (int ch = 0; ch < 16; ++ch) {
            const size_t row0 = (size_t)b * SEQ + seg * 1024 + ch * 64;
            const bf16_t* hrow = HB + (row0 + t1) * 4096 + h * 128 + c0;
            const bf16_t* hnext = hrow + (size_t)64 * 4096; const bool more = (ch + 1 < 16);
            float kk[16];
            { const u32x4 fa = pfa, fb = pfb;
              if (more) { pfa = *(const u32x4*)(hnext + 1024); pfb = *(const u32x4*)(hnext + 1024 + 8); }
              const unsigned fw[8] = {fa.x, fa.y, fa.z, fa.w, fb.x, fb.y, fb.z, fb.w};
              float lg[16];
#pragma unroll
              for (int j = 0; j < 16; ++j) { const float f = fmaxf((j & 1) ? bfhi(fw[j >> 1]) : bflo(fw[j >> 1]), -80.f); const float lb = lbv[c0 + j], om = 1.f - lb;
                  const float e = __expf(-f), sg = __builtin_amdgcn_rcpf(1.f + e); kk[j] = om * (e * sg); lg[j] = __logf(lb + om * sg); }
#pragma unroll
              for (int j = 0; j < 16; j += 4) *(LAS f32x4*)(Gs + t1 * 128 + c0 + j) = (f32x4){lg[j], lg[j + 1], lg[j + 2], lg[j + 3]}; }
            __syncthreads();
            { float loc[16]; float run = 0.f;
#pragma unroll
              for (int j = 0; j < 16; ++j) { run += Gs[(tq * 16 + j) * 128 + k2]; loc[j] = run; }
              tot[tq * 128 + k2] = run;
              __syncthreads();
              float off = 0.f;
#pragma unroll
              for (int q = 0; q < 3; ++q) if (q < tq) off += tot[q * 128 + k2];
#pragma unroll
              for (int j = 0; j < 16; ++j) Gs[(tq * 16 + j) * 128 + k2] = loc[j] + off;
              if (!FULL && tq == 3) lseg += loc[15] + off; }
            __syncthreads();
            { float g31[16], gt[16];
#pragma unroll
              for (int j = 0; j < 16; j += 4) { const f32x4 a = *(LAS const f32x4*)(Gs + 31 * 128 + c0 + j), c = *(LAS const f32x4*)(Gs + t1 * 128 + c0 + j);
                  g31[j] = a.x; g31[j + 1] = a.y; g31[j + 2] = a.z; g31[j + 3] = a.w; gt[j] = c.x; gt[j + 1] = c.y; gt[j + 2] = c.z; gt[j + 3] = c.w; }
              float kx[16];
#pragma unroll
              for (int j = 0; j < 16; ++j) kx[j] = kk[j] * __expf(fminf(g31[j] - gt[j], 80.f));
              LAS bf16_t* kxt = (LAS bf16_t*)(ldsb + HL_KXT);
#pragma unroll
              for (int j = 0; j < 16; ++j) kxt[(c0 + j) * 72 + ((((t1 >> 3) ^ (tid & 7)) << 3) | (t1 & 7))] = f2bf(kx[j]);
              { const u32x4 ia = pia, ib = pib; const unsigned iw[8] = {ia.x, ia.y, ia.z, ia.w, ib.x, ib.y, ib.z, ib.w};
                if (more) { pia = *(const u32x4*)(hnext + 2048); pib = *(const u32x4*)(hnext + 2048 + 8); }
                LAS bf16_t* it = (LAS bf16_t*)(ldsb + HL_IT);
#pragma unroll
                for (int j = 0; j < 16; ++j) it[(c0 + j) * 72 + ((((t1 >> 3) ^ (tid & 7)) << 3) | (t1 & 7))] = (bf16_t)((j & 1) ? (iw[j >> 1] >> 16) : (iw[j >> 1] & 0xffffu)); }
              if (t1 == 0) {
#pragma unroll
                  for (int j = 0; j < 16; ++j) { const float g63 = Gs[63 * 128 + c0 + j]; e2v[c0 + j] = __expf(g63 - g31[j]); decv[c0 + j] = __expf(g63); } }
              if (FULL) {
                  const u32x4 qa = *(const u32x4*)(hrow), qb = *(const u32x4*)(hrow + 8); const unsigned qw[8] = {qa.x, qa.y, qa.z, qa.w, qb.x, qb.y, qb.z, qb.w};
                  float qx[16];
#pragma unroll
                  for (int j = 0; j < 16; ++j) qx[j] = ((j & 1) ? bfhi(qw[j >> 1]) : bflo(qw[j >> 1])) * __expf(fminf(gt[j] - g31[j], 80.f));
                  LAS bf16_t* qxp = (LAS bf16_t*)(ldsb + HL_QX) + t1 * 136 + c0; LAS bf16_t* kxp = (LAS bf16_t*)(ldsb + HL_KX) + t1 * 136 + c0;
                  u32x4 w0, w1;
                  w0.x = cvt_pk_bf16(qx[0], qx[1]); w0.y = cvt_pk_bf16(qx[2], qx[3]); w0.z = cvt_pk_bf16(qx[4], qx[5]); w0.w = cvt_pk_bf16(qx[6], qx[7]);
                  w1.x = cvt_pk_bf16(qx[8], qx[9]); w1.y = cvt_pk_bf16(qx[10], qx[11]); w1.z = cvt_pk_bf16(qx[12], qx[13]); w1.w = cvt_pk_bf16(qx[14], qx[15]);
                  *(LAS u32x4*)qxp = w0; *(LAS u32x4*)(qxp + 8) = w1;
                  w0.x = cvt_pk_bf16(kx[0], kx[1]); w0.y = cvt_pk_bf16(kx[2], kx[3]); w0.z = cvt_pk_bf16(kx[4], kx[5]); w0.w = cvt_pk_bf16(kx[6], kx[7]);
                  w1.x = cvt_pk_bf16(kx[8], kx[9]); w1.y = cvt_pk_bf16(kx[10], kx[11]); w1.z = cvt_pk_bf16(kx[12], kx[13]); w1.w = cvt_pk_bf16(kx[14], kx[15]);
                  *(LAS u32x4*)kxp = w0; *(LAS u32x4*)(kxp + 8) = w1;
                  LAS bf16_t* stp = (LAS bf16_t*)(ldsb + HL_ST) + (wave * 16 + fi) * 136;
#pragma unroll
                  for (int kt = 0; kt < 8; ++kt) { const int k = kt * 16 + fkq * 4; const f32x4 gg = *(LAS const f32x4*)(Gs + 31 * 128 + k);
                      u32x2 w; w.x = cvt_pk_bf16(S[kt][0] * __expf(gg.x), S[kt][1] * __expf(gg.y)); w.y = cvt_pk_bf16(S[kt][2] * __expf(gg.z), S[kt][3] * __expf(gg.w));
                      *(LAS u32x2*)(stp + k) = w; }
              } }
            __syncthreads();
            if (FULL) {
                { const int tt = wave >> 1; LAS bf16_t* att = (LAS bf16_t*)(ldsb + HL_ATT);
                  const LAS bf16_t* qxa = (const LAS bf16_t*)(ldsb + HL_QX) + (tt * 16 + fi) * 136 + fkq * 8;
#pragma unroll
                  for (int u2 = 0; u2 < 2; ++u2) { const int st = 2 * (wave & 1) + u2; f32x4 acc = (f32x4){0.f, 0.f, 0.f, 0.f};
                      if (st <= tt) { const LAS bf16_t* kxb = (const LAS bf16_t*)(ldsb + HL_KX) + (st * 16 + fi) * 136 + fkq * 8;
#pragma unroll
                          for (int ks = 0; ks < 4; ++ks) acc = __builtin_amdgcn_mfma_f32_16x16x32_bf16(*(const LAS bf16x8*)(qxa + ks * 32), *(const LAS bf16x8*)(kxb + ks * 32), acc, 0, 0, 0);
                          if (st == tt) {
#pragma unroll
                              for (int r = 0; r < 4; ++r) if (fi > fkq * 4 + r) acc[r] = 0.f; } }
#pragma unroll
                      for (int r = 0; r < 4; ++r) att[(tt * 16 + fkq * 4 + r) * 72 + st * 16 + fi] = f2bf(acc[r]); } }
                __syncthreads();
                { LAS bf16_t* obuf = (LAS bf16_t*)(ldsb + HL_OBUF);
                  const LAS bf16_t* stb = (const LAS bf16_t*)(ldsb + HL_ST) + (wave * 16 + fi) * 136 + fkq * 8;
                  const LAS bf16_t* itb = (const LAS bf16_t*)(ldsb + HL_IT) + (wave * 16 + fi) * 72;
                  f32x4 oacc[4];
#pragma unroll
                  for (int tt = 0; tt < 4; ++tt) { f32x4 acc = (f32x4){0.f, 0.f, 0.f, 0.f};
                      const LAS bf16_t* qxa = (const LAS bf16_t*)(ldsb + HL_QX) + (tt * 16 + fi) * 136 + fkq * 8;
                      const LAS bf16_t* ata = (const LAS bf16_t*)(ldsb + HL_ATT) + (tt * 16 + fi) * 72 + fkq * 8;
#pragma unroll
                      for (int ks = 0; ks < 4; ++ks) acc = __builtin_amdgcn_mfma_f32_16x16x32_bf16(*(const LAS bf16x8*)(qxa + ks * 32), *(const LAS bf16x8*)(stb + ks * 32), acc, 0, 0, 0);
#pragma unroll
                      for (int ks = 0; ks < 2; ++ks) acc = __builtin_amdgcn_mfma_f32_16x16x32_bf16(*(const LAS bf16x8*)(ata + ks * 32), *(const LAS bf16x8*)(itb + (((ks * 4 + fkq) ^ (wave & 7)) << 3)), acc, 0, 0, 0);
                      oacc[tt] = acc; }
                  __syncthreads();
#pragma unroll
                  for (int tt = 0; tt < 4; ++tt)
#pragma unroll
                      for (int r = 0; r < 4; ++r) obuf[(tt * 16 + fkq * 4 + r) * 136 + wave * 16 + fi] = f2bf(oacc[tt][r]); }
            }
            { const LAS bf16_t* itb = (const LAS bf16_t*)(ldsb + HL_IT) + (wave * 16 + fi) * 72;
#pragma unroll
              for (int kt = 0; kt < 8; ++kt) { f32x4 acc = (f32x4){0.f, 0.f, 0.f, 0.f};
                  const LAS bf16_t* ka = (const LAS bf16_t*)(ldsb + HL_KXT) + (kt * 16 + fi) * 72;
#pragma unroll
                  for (int ks = 0; ks < 2; ++ks) acc = __builtin_amdgcn_mfma_f32_16x16x32_bf16(*(const LAS bf16x8*)(ka + (((ks * 4 + fkq) ^ (kt & 7)) << 3)), *(const LAS bf16x8*)(itb + (((ks * 4 + fkq) ^ (wave & 7)) << 3)), acc, 0, 0, 0);
                  const f32x4 dv = *(LAS const f32x4*)(decv + kt * 16 + fkq * 4), ev = *(LAS const f32x4*)(e2v + kt * 16 + fkq * 4);
                  S[kt] = dv * S[kt] + ev * acc; } }
            __syncthreads();
            if (FULL) {
                const LAS bf16_t* ob = (const LAS bf16_t*)(ldsb + HL_OBUF) + t1 * 136 + c0;
                const u32x4 oa = *(const LAS u32x4*)ob, ob2 = *(const LAS u32x4*)(ob + 8); const unsigned ow[8] = {oa.x, oa.y, oa.z, oa.w, ob2.x, ob2.y, ob2.z, ob2.w};
                const u32x4 ga = *(const u32x4*)(hrow + 3072), gb = *(const u32x4*)(hrow + 3072 + 8); const unsigned gw[8] = {ga.x, ga.y, ga.z, ga.w, gb.x, gb.y, gb.z, gb.w};
                float o[16]; float ss = 0.f;
#pragma unroll
                for (int j = 0; j < 16; ++j) { o[j] = (j & 1) ? bfhi(ow[j >> 1]) : bflo(ow[j >> 1]); ss += o[j] * o[j]; }
                ss += __shfl_xor(ss, 1); ss += __shfl_xor(ss, 2); ss += __shfl_xor(ss, 4);
                const float rs = rsqrtf(ss * (1.0f / 128.0f) + 1e-6f);
                u32x4 w0, w1; float v[16];
#pragma unroll
                for (int j = 0; j < 16; ++j) v[j] = o[j] * rs * onorm[c0 + j] * ((j & 1) ? bfhi(gw[j >> 1]) : bflo(gw[j >> 1]));
                w0.x = cvt_pk_bf16(v[0], v[1]); w0.y = cvt_pk_bf16(v[2], v[3]); w0.z = cvt_pk_bf16(v[4], v[5]); w0.w = cvt_pk_bf16(v[6], v[7]);
                w1.x = cvt_pk_bf16(v[8], v[9]); w1.y = cvt_pk_bf16(v[10], v[11]); w1.z = cvt_pk_bf16(v[12], v[13]); w1.w = cvt_pk_bf16(v[14], v[15]);
                bf16_t* og = OG + (row0 + t1) * DM + h * 128 + c0; *(u32x4*)og = w0; *(u32x4*)(og + 8) = w1;
                __syncthreads();
            }
        }
        if (!FULL) {
            float* sl = SLOC + (size_t)unit * 16384;
#pragma unroll
            for (int kt = 0; kt < 8; ++kt)
#pragma unroll
                for (int r = 0; r < 4; ++r) sl[(kt * 16 + fkq * 4 + r) * 128 + wave * 16 + fi] = S[kt][r];
            if (tq == 3) DSEG[(size_t)unit * 128 + k2] = __expf(lseg);
        }
    }
}

typedef float f32x16 __attribute__((ext_vector_type(16)));
__device__ __forceinline__ void sel_scores(const bf16_t* kp, const bf16x8 (&qf)[4], f32x16 (&S)[2]) {
#pragma unroll
    for (int h = 0; h < 2; ++h) { bf16x8 kf[4];
#pragma unroll
        for (int s = 0; s < 4; ++s) kf[s] = *(const bf16x8*)(kp + h * 2048 + s * 8);
        S[h] = (f32x16){0.f};
#pragma unroll
        for (int s = 0; s < 4; ++s) S[h] = __builtin_amdgcn_mfma_f32_32x32x16_bf16(kf[s], qf[s], S[h], 0, 0, 0); }
}
__device__ __forceinline__ float row_bound(const bf16x8 (&qf)[4], float gmax) {
    float ss = 0.f;
#pragma unroll
    for (int s = 0; s < 4; ++s)
#pragma unroll
        for (int j = 0; j < 8; ++j) { const float v = bf2f((unsigned short)qf[s][j]); ss += v * v; }
    ss += __shfl_xor(ss, 32);
    return sqrtf(ss) * 8.08f * gmax;
}
__device__ __forceinline__ float dpp_quad_sum(float v) {
    v += __int_as_float(__builtin_amdgcn_update_dpp(0, __float_as_int(v), 0xB1, 0xF, 0xF, true));
    v += __int_as_float(__builtin_amdgcn_update_dpp(0, __float_as_int(v), 0x4E, 0xF, 0xF, true));
    return v; }
__device__ __forceinline__ void phase_sel2(PK p, LAS unsigned char* ldsb, int wid_s) {
    const int tid = opaque_tid(wid_s), lane = tid & 63, wave = __builtin_amdgcn_readfirstlane(tid >> 6);
    const bf16_t* Q = (const bf16_t*)(p->ws + WS_Q); const bf16_t* KC = (const bf16_t*)(p->ws + WS_KC); unsigned* SELM = (unsigned*)(p->ws + WS_SELM);
    LAS float* imp = (LAS float*)(ldsb + wave * 8448);
    const int n = lane & 31, hi = lane >> 5, ql = n >> 2, g = n & 3;
    const int pim = (n & ~12) | ((n & 4) << 1) | ((n & 8) >> 1);
    const float gmax0 = wave_max(fabsf(p->in[14][lane]));
    for (int u = blockIdx.x; u < 2048; u += gridDim.x) {
        const int bh = u >> 8, ii = u & 255, qb = (bh & 1) ? 255 - ii : ii, b = bh >> 2, kvh = bh & 3;
        const int tq = qb * 64 + wave * 8 + ql, hd = kvh * 4 + g, row = b * SEQ + tq;
        const int nvq = tq >= 31 ? ((tq - 31) >> 4) + 1 : 0;
        const int tmaxw = qb * 64 + wave * 8 + 7; const int nvmaxw = tmaxw >= 31 ? ((tmaxw - 31) >> 4) + 1 : 0; const int ncb = (qb >= 16) ? (nvmaxw + 63) >> 6 : 0;
        const int tminw = qb * 64 + wave * 8; const int nvminw = tminw >= 31 ? ((tminw - 31) >> 4) + 1 : 0;
        bf16x8 qf[4];
#pragma unroll
        for (int s = 0; s < 4; ++s) qf[s] = *(const bf16x8*)(Q + (size_t)row * DM + hd * 64 + 32 * hi + 8 * s);
        const bf16_t* kbase = KC + (size_t)bh * 65536 + pim * 64 + 32 * hi;
        for (int i = lane; i < 8 * 264; i += 64) imp[i] = 0.f;
        const float mfix = row_bound(qf, gmax0);
        float l = 0.f;
        for (int blk = 0; blk < ncb; ++blk) { f32x16 S[2]; sel_scores(kbase + (size_t)blk * 4096, qf, S);
            f32x2v ls2 = (f32x2v){0.f, 0.f};
#pragma unroll
            for (int h = 0; h < 2; ++h)
#pragma unroll
                for (int r = 0; r < 16; r += 2) { const int kpos = blk * 64 + 32 * h + 16 * (r >> 3) + 8 * hi + (r & 7);
                    f32x2v pv; pv.x = (kpos < nvq) ? __builtin_amdgcn_exp2f(S[h][r] - mfix) : 0.f; pv.y = (kpos + 1 < nvq) ? __builtin_amdgcn_exp2f(S[h][r + 1] - mfix) : 0.f; ls2 += pv; }
            l += ls2.x + ls2.y; }
        l += __shfl_xor(l, 32);
        const float mfn = l > 0.f ? mfix + log2f(l) : INFINITY;
        for (int blk = 0; blk < ncb; ++blk) { f32x16 S[2]; sel_scores(kbase + (size_t)blk * 4096, qf, S);
            const bool interior = (blk * 64 + 63 < nvminw);
#pragma unroll
            for (int h = 0; h < 2; ++h)
#pragma unroll
                for (int rg = 0; rg < 2; ++rg) { float pv[8];
                    if (interior) {
#pragma unroll
                        for (int e = 0; e < 8; ++e) pv[e] = __builtin_amdgcn_exp2f(S[h][8 * rg + e] - mfn);
                    } else {
#pragma unroll
                        for (int e = 0; e < 8; ++e) { const int kpos = blk * 64 + 32 * h + 16 * rg + 8 * hi + e; pv[e] = (kpos < nvq) ? __builtin_amdgcn_exp2f(S[h][8 * rg + e] - mfn) : 0.f; }
                    }
                    float s0 = (pv[0] + pv[1]) + (pv[2] + pv[3]), s1 = pv[3] + (pv[4] + pv[5]) + (pv[6] + pv[7]), s2 = pv[7];
                    s0 = dpp_quad_sum(s0); s1 = dpp_quad_sum(s1); s2 = dpp_quad_sum(s2);
                    if (g == 0) { const int j0 = (blk * 64 + 32 * h + 16 * rg + 8 * hi) >> 2; LAS float* ip = imp + ql * 264 + j0;
                        atomicAdd((float*)ip, s0); atomicAdd((float*)(ip + 1), s1); atomicAdd((float*)(ip + 2), s2); } } }
        const int cur = qb;
#pragma unroll 1
        for (int q = 0; q < 8; ++q) {
            unsigned bits[4]; bool valid[4], sel[4];
#pragma unroll
            for (int i2 = 0; i2 < 4; ++i2) { const int j = lane + 64 * i2; valid[i2] = j <= cur; const float im = imp[q * 264 + j];
                const bool forced = (j == 0) || (j == cur) || (j == cur - 1);
                bits[i2] = valid[i2] ? __float_as_uint(forced ? 1e9f : im) : 0u; sel[i2] = valid[i2]; }
            if (cur + 1 > 16) {
                unsigned T = 0u;
#define TK_SEARCH(NI2) for (int bit = 29; bit >= 0; --bit) {     const unsigned cand = T | (1u << bit); int cnt = 0; \
                    _Pragma("unroll") for (int i2 = 0; i2 < NI2; ++i2) cnt += __popcll(__ballot(bits[i2] >= cand)); \
                    if (cnt >= 16) T = cand; }
                const int ni2 = (cur >> 6) + 1;
                if (ni2 == 1) { TK_SEARCH(1) } else if (ni2 == 2) { TK_SEARCH(2) } else if (ni2 == 3) { TK_SEARCH(3) } else { TK_SEARCH(4) }
#undef TK_SEARCH
                int cgt = 0;
#pragma unroll
                for (int i2 = 0; i2 < 4; ++i2) cgt += __popcll(__ballot(bits[i2] > T));
                int remaining = 16 - cgt;
                const unsigned long long ltmask = (1ull << lane) - 1ull;
#pragma unroll
                for (int i2 = 0; i2 < 4; ++i2) { const bool eq = (bits[i2] == T) && valid[i2]; const unsigned long long ball = __ballot(eq); const int rank = __popcll(ball & ltmask);
                    sel[i2] = valid[i2] && ((bits[i2] > T) || (eq && rank < remaining)); remaining -= min(remaining, (int)__popcll(ball)); }
            }
            const size_t item = (size_t)bh * SEQ + qb * 64 + wave * 8 + q;
#pragma unroll
            for (int i2 = 0; i2 < 4; ++i2) { const unsigned long long ball = __ballot(sel[i2]);
                if (lane == 0) { SELM[item * 8 + 2 * i2] = (unsigned)ball; SELM[item * 8 + 2 * i2 + 1] = (unsigned)(ball >> 32); } }
        }
    }
}

__device__ __forceinline__ void fc_ldk(LAS const unsigned char* tb, int kro, bf16x8 (&kf)[2][4]) {
#pragma unroll
    for (int h = 0; h < 2; ++h)
#pragma unroll
        for (int s = 0; s < 4; ++s) kf[h][s] = *(LAS const bf16x8*)(tb + kro + h * 32 * 144 + s * 16);
}
__device__ __forceinline__ void fc_ldv(LAS const unsigned char* tb, int vro, bf16x8 (&vf)[2][2][2]) {
#pragma unroll
    for (int h = 0; h < 2; ++h)
#pragma unroll
        for (int ks = 0; ks < 2; ++ks)
#pragma unroll
            for (int dh = 0; dh < 2; ++dh) vf[h][ks][dh] = *(LAS const bf16x8*)(tb + vro + dh * 32 * 144 + (h * 32 + ks * 16) * 2);
}
template <int MODE> __device__ __forceinline__ void flash_compute1(LAS const unsigned char* tb, int blk, bool edge, int kro, int vro, bool rowsel, const bf16x8 (&qf)[4], int tq, int nvq, int hi, float mfix, f32x16 (&O)[2], float& l) {
    f32x16 S[2];
    { bf16x8 kf[2][4]; fc_ldk(tb, kro, kf);
#pragma unroll
      for (int h = 0; h < 2; ++h) { S[h] = (f32x16){0.f};
#pragma unroll
          for (int s = 0; s < 4; ++s) S[h] = __builtin_amdgcn_mfma_f32_32x32x16_bf16(kf[h][s], qf[s], S[h], 0, 0, 0); } }
    bf16x8 vf[2][2][2]; fc_ldv(tb, vro, vf);
    if (edge) {
#pragma unroll
        for (int h = 0; h < 2; ++h)
#pragma unroll
            for (int r = 0; r < 16; ++r) { const int kpos = blk * 64 + 32 * h + 16 * (r >> 3) + 8 * hi + (r & 7); bool valid;
                if (MODE == 0) valid = kpos < nvq; else if (MODE == 1) valid = (kpos <= tq); else valid = (kpos <= tq) && (kpos > tq - 512);
                S[h][r] = valid ? S[h][r] : -INFINITY; }
    }
    const float mu = (MODE == 1) ? (rowsel ? mfix : INFINITY) : mfix;
    const f32x2v mu2 = (f32x2v){mu, mu};
    f32x2v ls2 = (f32x2v){0.f, 0.f};
#pragma unroll
    for (int h = 0; h < 2; ++h)
#pragma unroll
        for (int r = 0; r < 16; r += 2) { const f32x2v d = (f32x2v){S[h][r], S[h][r + 1]} - mu2; f32x2v pv; pv.x = __builtin_amdgcn_exp2f(d.x); pv.y = __builtin_amdgcn_exp2f(d.y);
            S[h][r] = pv.x; S[h][r + 1] = pv.y; ls2 += pv; }
    l += ls2.x + ls2.y;
#pragma unroll
    for (int h = 0; h < 2; ++h)
#pragma unroll
        for (int ks = 0; ks < 2; ++ks) { u32x4 w; w.x = cvt_pk_bf16(S[h][8 * ks], S[h][8 * ks + 1]); w.y = cvt_pk_bf16(S[h][8 * ks + 2], S[h][8 * ks + 3]); w.z = cvt_pk_bf16(S[h][8 * ks + 4], S[h][8 * ks + 5]); w.w = cvt_pk_bf16(S[h][8 * ks + 6], S[h][8 * ks + 7]);
            const bf16x8 pf = __builtin_bit_cast(bf16x8, w);
#pragma unroll
            for (int dh = 0; dh < 2; ++dh) O[dh] = __builtin_amdgcn_mfma_f32_32x32x16_bf16(vf[h][ks][dh], pf, O[dh], 0, 0, 0); }
}
constexpr int AL_KV = 0, AL_SLOT = 18432, AL_WU = 55296  , AL_WAVE = 55808  , AL_ACC = 68096  ;
template <int MODE> __device__ __forceinline__ void flash_blocks(const bf16_t* Kb, const bf16_t* Vt, int ldv, int base, int nblk, LAS const int* list, LAS const unsigned* qm, LAS const unsigned* wun,
                                                                LAS unsigned char* ldsb, int tid, const bf16x8 (&qf)[4], int tq, int nvq, int qb, int wave, int ql, int lane, float mfix, f32x16 (&O)[2], float& l) {
    const int m_ = lane & 31, hi = lane >> 5;
    const int pim = (m_ & ~12) | ((m_ & 4) << 1) | ((m_ & 8) >> 1);
    const int kro = pim * 144 + 64 * hi;
    const int vro = 9216 + m_ * 144 + 16 * hi;
    const int srow = tid >> 3, sch = tid & 7;
    const bf16_t* kg = Kb + (size_t)tid * 8;
    const bf16_t* vg = Vt + (size_t)srow * ldv + sch * 8;
    const int sdst = srow * 144 + sch * 16;
    const int tminw = qb * 64 + wave * 8, tmaxw = tminw + 7;
    const int nvminw = tminw >= 31 ? ((tminw - 31) >> 4) + 1 : 0, nvmaxw = tmaxw >= 31 ? ((tmaxw - 31) >> 4) + 1 : 0;
#define FB_BLK(i) ((MODE == 1) ? list[(i)] : base + (i))
    u32x4 ra[3], rb[3];
#pragma unroll
    for (int k = 0; k < 3; ++k) { ra[k] = (u32x4){0u, 0u, 0u, 0u}; rb[k] = ra[k]; if (k < nblk) { const int nb = FB_BLK(k); ra[k] = *(const u32x4*)(kg + (size_t)nb * 4096); rb[k] = *(const u32x4*)(vg + (size_t)nb * 64); } }
    for (int i0 = 0; i0 < nblk; i0 += 3) {
        __syncthreads();
#pragma unroll
        for (int k = 0; k < 3; ++k) if (i0 + k < nblk) { LAS unsigned char* sl = ldsb + AL_KV + k * AL_SLOT; *(LAS u32x4*)(sl + sdst) = ra[k]; *(LAS u32x4*)(sl + 9216 + sdst) = rb[k]; }
        __syncthreads();
#pragma unroll
        for (int k = 0; k < 3; ++k) if (i0 + 3 + k < nblk) { const int nb = FB_BLK(i0 + 3 + k); ra[k] = *(const u32x4*)(kg + (size_t)nb * 4096); rb[k] = *(const u32x4*)(vg + (size_t)nb * 64); }
#pragma unroll 1
        for (int k = 0; k < 3; ++k) { if (i0 + k >= nblk) break;
            const int blk = FB_BLK(i0 + k); bool need = true, edge;
            if (MODE == 0) { need = blk * 64 < nvmaxw; edge = !(blk * 64 + 63 < nvminw); }
            else if (MODE == 1) { need = (wun[blk >> 5] >> (blk & 31)) & 1u; edge = (blk == qb); }
            else edge = (blk == qb) || (blk == qb - 8);
            if (need) { bool rs = true; if (MODE == 1) rs = (qm[ql * 8 + (blk >> 5)] >> (blk & 31)) & 1u;
                flash_compute1<MODE>(ldsb + AL_KV + k * AL_SLOT, blk, edge, kro, vro, rs, qf, tq, nvq, hi, mfix, O, l); } }
    }
#undef FB_BLK
}
__device__ __forceinline__ void phase_att(PK p, LAS unsigned char* ldsb, int wid_s) {
    const int tid = opaque_tid(wid_s), lane = tid & 63, wave = __builtin_amdgcn_readfirstlane(tid >> 6);
    const bf16_t* Q = (const bf16_t*)(p->ws + WS_Q); const bf16_t* QR = (const bf16_t*)(p->ws + WS_QR); bf16_t* AO = (bf16_t*)(p->ws + WS_AO);
    const float* GATES = (const float*)(p->ws + WS_GATES); const unsigned* SELM = (const unsigned*)(p->ws + WS_SELM);
    const bf16_t* KC = (const bf16_t*)(p->ws + WS_KC); const bf16_t* VCt = (const bf16_t*)(p->ws + WS_VC);
    const bf16_t* KS = (const bf16_t*)(p->ws + WS_KV + 32 * MiB); const bf16_t* VSt = (const bf16_t*)(p->ws + WS_KV + 48 * MiB);
    const bf16_t* KW = (const bf16_t*)(p->ws + WS_KV + 64 * MiB); const bf16_t* VWt = (const bf16_t*)(p->ws + WS_KV + 80 * MiB);
    LAS unsigned* wu = (LAS unsigned*)(ldsb + AL_WU);
    LAS unsigned* qm = (LAS unsigned*)(ldsb + AL_WAVE + wave * 1536); LAS unsigned* wun = qm + 64; LAS int* list = (LAS int*)(qm + 128);
    const int n = lane & 31, hi = lane >> 5, ql = n >> 2, g = n & 3;
    const float* kn_ = p->in[14];
    const float gmax0 = wave_max(fabsf(kn_[lane])), gmax12 = wave_max(fmaxf(fabsf(kn_[64 + lane]), fabsf(kn_[128 + lane])));
    for (int u = blockIdx.x; u < 2048; u += gridDim.x) {
        const int bh = u >> 8, ii = u & 255, qb = (bh & 1) ? 255 - ii : ii, b = bh >> 2, kvh = bh & 3;
        const int tq = qb * 64 + wave * 8 + ql, hd = kvh * 4 + g, row = b * SEQ + tq;
        const int nvq = tq >= 31 ? ((tq - 31) >> 4) + 1 : 0;
        const int tmaxw = qb * 64 + wave * 8 + 7; const int nvmaxw = tmaxw >= 31 ? ((tmaxw - 31) >> 4) + 1 : 0;
        { const unsigned mw = SELM[((size_t)bh * SEQ + qb * 64 + wave * 8 + (lane >> 3)) * 8 + (lane & 7)];
          qm[lane] = mw;
          unsigned uw = mw; uw |= __shfl_xor(uw, 8); uw |= __shfl_xor(uw, 16); uw |= __shfl_xor(uw, 32);
          if (lane < 8) { wun[lane] = uw; wu[wave * 8 + lane] = uw; } }
        __syncthreads();
        int nsel = 0;
        { unsigned bu = 0u;
#pragma unroll
          for (int w2 = 0; w2 < 8; ++w2) bu |= wu[w2 * 8 + (lane & 7)];
          const int cnt = __popc(bu); int pre = 0;
#pragma unroll
          for (int w2 = 0; w2 < 8; ++w2) { const int c2 = __shfl(cnt, w2); if (w2 < (lane & 7)) pre += c2; nsel += c2; }
          if (lane < 8) { unsigned ww = bu; int k = pre; while (ww) { const int bpos = __ffs(ww) - 1; list[k++] = lane * 32 + bpos; ww &= ww - 1; } } }
        nsel = __builtin_amdgcn_readfirstlane(nsel);
        float gate[3];
#pragma unroll
        for (int br = 0; br < 3; ++br) gate[br] = GATES[(size_t)row * 48 + br * 16 + hd];
        LAS float* oacc = (LAS float*)(ldsb + AL_ACC + wave * 8192) + lane;
        bf16x8 qf[4];
#pragma unroll
        for (int s = 0; s < 4; ++s) qf[s] = *(const bf16x8*)(Q + (size_t)row * DM + hd * 64 + 32 * hi + 8 * s);
        float mfix = row_bound(qf, gmax0);
        { f32x16 O[2]; O[0] = (f32x16){0.f}; O[1] = (f32x16){0.f}; float l = 0.f;
          const int tmax = qb * 64 + 63; const int nvmax = ((tmax - 31) >> 4) + 1; const int ncb = (nvmax + 63) >> 6;
          flash_blocks<0>(KC + (size_t)bh * 65536, VCt + (size_t)bh * 65536, 1024, 0, ncb, list, qm, wun, ldsb, tid, qf, tq, nvq, qb, wave, ql, lane, mfix, O, l);
          l += __shfl_xor(l, 32); const float sc = l > 0.f ? gate[0] / l : 0.f;
#pragma unroll
          for (int dh = 0; dh < 2; ++dh)
#pragma unroll
              for (int r = 0; r < 16; ++r) oacc[(dh * 16 + r) * 64] = O[dh][r] * sc; }
#pragma unroll
        for (int s = 0; s < 4; ++s) qf[s] = *(const bf16x8*)(QR + (size_t)row * DM + hd * 64 + 32 * hi + 8 * s);
        mfix = row_bound(qf, gmax12);
        { f32x16 O[2]; O[0] = (f32x16){0.f}; O[1] = (f32x16){0.f}; float l = 0.f;
          flash_blocks<1>(KS + (size_t)bh * SEQ * 64, VSt + (size_t)bh * SEQ * 64, SEQ, 0, nsel, list, qm, wun, ldsb, tid, qf, tq, nvq, qb, wave, ql, lane, mfix, O, l);
          l += __shfl_xor(l, 32); const float sc = l > 0.f ? gate[1] / l : 0.f;
#pragma unroll
          for (int dh = 0; dh < 2; ++dh)
#pragma unroll
              for (int r = 0; r < 16; ++r) oacc[(dh * 16 + r) * 64] += O[dh][r] * sc; }
        { f32x16 O[2]; O[0] = (f32x16){0.f}; O[1] = (f32x16){0.f}; float l = 0.f;
          const int b0 = max(0, qb - 8);
          flash_blocks<2>(KW + (size_t)bh * SEQ * 64, VWt + (size_t)bh * SEQ * 64, SEQ, b0, qb - b0 + 1, list, qm, wun, ldsb, tid, qf, tq, nvq, qb, wave, ql, lane, mfix, O, l);
          l += __shfl_xor(l, 32); const float sc = l > 0.f ? gate[2] / l : 0.f;
          bf16_t* op = AO + (size_t)row * DM + hd * 64 + 4 * hi;
#pragma unroll
          for (int dh = 0; dh < 2; ++dh)
#pragma unroll
              for (int rq = 0; rq < 4; ++rq) { float v[4];
#pragma unroll
                  for (int e = 0; e < 4; ++e) v[e] = oacc[(dh * 16 + rq * 4 + e) * 64] + O[dh][rq * 4 + e] * sc;
                  u32x2 w; w.x = cvt_pk_bf16(v[0], v[1]); w.y = cvt_pk_bf16(v[2], v[3]); *(u32x2*)(op + 32 * dh + 8 * rq) = w; } }
    }
}

#define XB_TMO      128
#define XB_XCNT(j)  (256  + 64 * (j))
#define XB_XSUB(j)  (1280 + 64 * (j))
#define XB_XGEN(j)  (2304 + 64 * (j))
#define XB_TOP      3328
#define XB_TOPGEN   3392
#define XCD_BAR_WORDS 3456
#define XB_SPIN_CAP (1u << 18)

__device__ __forceinline__ unsigned xb_ld(unsigned* p)              { return __hip_atomic_load(p, __ATOMIC_RELAXED, __HIP_MEMORY_SCOPE_AGENT); }
__device__ __forceinline__ unsigned xb_add(unsigned* p, unsigned v) { return __hip_atomic_fetch_add(p, v, __ATOMIC_RELAXED, __HIP_MEMORY_SCOPE_AGENT); }
__device__ __forceinline__ unsigned xb_xcc_id() { return (unsigned)__builtin_amdgcn_s_getreg((3 << 11) | 20) & 0xFu; }
#define XB_SPIN(cond, bar) do { unsigned _sp = 0; while (cond) { __builtin_amdgcn_s_sleep(1); \
    if ((++_sp & 255u) == 0u) { if (xb_ld(&(bar)[XB_TMO])) break; if (_sp > XB_SPIN_CAP) { atomicAdd(&(bar)[XB_TMO], 1u); break; } } } } while (0)

struct XcdBarrier {
    unsigned* bar; unsigned x;
    volatile LAS unsigned* st;
};

__device__ __forceinline__ XcdBarrier xcd_barrier_post(unsigned* bar, volatile LAS unsigned* st, bool is0) {
    XcdBarrier b; b.bar = bar; b.x = xb_xcc_id(); b.st = st;
    if (is0) (void)xb_add(&bar[XB_XCNT(b.x)], 1u);
    return b;
}
__device__ __forceinline__ void xcd_barrier_complete(unsigned* bar, unsigned x, unsigned& nloc, unsigned& nx) {
    const unsigned G = gridDim.x * gridDim.y * gridDim.z;
    unsigned sum, cnt, mine, sp = 0u;
    for (;;) {
        sum = 0u; cnt = 0u; mine = 0u;
#pragma unroll
        for (unsigned j = 0; j < 16; ++j) { const unsigned c = xb_ld(&bar[XB_XCNT(j)]); sum += c; cnt += (c > 0u) ? 1u : 0u; mine = (j == x) ? c : mine; }
        if (sum == G) break;
        __builtin_amdgcn_s_sleep(1);
        if ((++sp & 255u) == 0u) { if (xb_ld(&bar[XB_TMO])) break; if (sp > XB_SPIN_CAP) { atomicAdd(&bar[XB_TMO], 1u); break; } }
    }
    nloc = mine > 0u ? mine : 1u; nx = cnt > 0u ? cnt : 1u;
}

__device__ __attribute__((noinline)) void xcd_barrier(const XcdBarrier b, bool is0) {
    asm volatile("s_waitcnt vmcnt(0)" ::: "memory");
    __syncthreads();
    if (is0) {
        unsigned* bar = b.bar;
        __builtin_amdgcn_s_waitcnt(0);
        unsigned nloc = b.st[0], nx = b.st[1];
        if (nloc == 0u) { xcd_barrier_complete(bar, b.x, nloc, nx); b.st[0] = nloc; b.st[1] = nx; }
        const unsigned old = xb_add(&bar[XB_XSUB(b.x)], 1u);
        const unsigned gen = old / nloc;
        if (old + 1u == (gen + 1u) * nloc) {
            __builtin_amdgcn_fence(__ATOMIC_RELEASE, "agent");
            asm volatile("s_waitcnt vmcnt(0)" ::: "memory");
            const unsigned og = xb_add(&bar[XB_TOP], 1u);
            const unsigned tg = og / nx;
            if (og + 1u == (tg + 1u) * nx) xb_add(&bar[XB_TOPGEN], 1u);
            else XB_SPIN(xb_ld(&bar[XB_TOPGEN]) == tg, bar);
            __builtin_amdgcn_fence(__ATOMIC_ACQUIRE, "agent");
            xb_add(&bar[XB_XGEN(b.x)], 1u);
            asm volatile("s_waitcnt vmcnt(0)" ::: "memory");
        } else {
            XB_SPIN(xb_ld(&bar[XB_XGEN(b.x)]) == gen, bar);
            __builtin_amdgcn_fence(__ATOMIC_ACQUIRE, "agent");
            asm volatile("s_waitcnt vmcnt(0)" ::: "memory");
        }
    }
    __syncthreads();
}

__global__ void __launch_bounds__(NTHR, 2) yoco_fwd(Params p_unused) {
    extern __shared__ __attribute__((aligned(16))) unsigned char lds_raw[];
    LAS unsigned char* ldsb = (LAS unsigned char*)lds_raw;
    cg::grid_group grid = cg::this_grid();
    const int wid_s = __builtin_amdgcn_readfirstlane((int)threadIdx.x >> 6);
    volatile LAS unsigned* bst = (volatile LAS unsigned*)(ldsb + LDS_BYTES - 16);
    { const int t0_ = opaque_tid(wid_s); if (t0_ == 0) { bst[0] = 0u; bst[1] = 0u; } __syncthreads(); }
    XcdBarrier xbar; { PK pk = fresh_pk(); xbar = xcd_barrier_post((unsigned*)(pk->ws + WS_BAR), bst, opaque_tid(wid_s) == 0); }
#define GSYNC() xcd_barrier(xbar, opaque_tid(wid_s) == 0)
#define FRESH() PK pk = fresh_pk(); unsigned char* ws = pk->ws; float* mods = (float*)(ws + WS_MODS); float* SS = (float*)(ws + WS_SS); const float* BIAS = (const float*)(ws + WS_BIAS); \
    const f32x2v* cs = (const f32x2v*)(ws + WS_CS); bf16_t* XB = (bf16_t*)(ws + WS_XB); bf16_t* XB2 = (bf16_t*)(ws + WS_XB2); bf16_t* HB = (bf16_t*)(ws + WS_HB); bf16_t* OB = (bf16_t*)(ws + WS_OB); bf16_t* HID = (bf16_t*)(ws + WS_HID); \
    float* xout = pk->out; (void)mods; (void)SS; (void)BIAS; (void)cs; (void)XB; (void)XB2; (void)HB; (void)OB; (void)HID; (void)xout;

    { PK pk = fresh_pk(); phase0(pk, ldsb, wid_s); }
    GSYNC();
    if (fresh_pk()->out == nullptr) grid.sync();
    { PK pk = fresh_pk(); phase1(pk, ldsb, wid_s); }
    GSYNC();

#pragma unroll 1
    for (int layer = 0; layer < 4; ++layer) {
        if (layer < 2) {
            { FRESH(); EpiHin E{HB, SS + (size_t)(2 * layer) * MR, BIAS + BO_HIN + layer * 8192};
              RUN_GEMM(EpiHin, E, XB, ws + WS_WHIN + (size_t)layer * 4096 * 1024 * 2, MR, 4096, 1024, 1024); }
            GSYNC();
            { FRESH(); phase_hgrn<false>(HB, OB, (float*)(ws + WS_SLOC), (float*)(ws + WS_DSEG), pk->in[7], pk->in[8] + layer * 128, layer, ldsb, wid_s); }
            GSYNC();
            { FRESH(); phase_hgrn<true>(HB, OB, (float*)(ws + WS_SLOC), (float*)(ws + WS_DSEG), pk->in[7], pk->in[8] + layer * 128, layer, ldsb, wid_s); }
            GSYNC();
            { FRESH(); const float* xold = (layer == 0) ? pk->in[0] : xout;
              EpiRes<false> E{xold, xout, mods + (2 * layer) * 6144 + 2048, SS + (size_t)(2 * layer + 1) * MR, XB, BIAS + BO_GM + (2 * layer + 1) * 2048, nullptr, nullptr};
              RUN_GEMM(EpiRes<false>, E, OB, ws + WS_WHOUT + (size_t)layer * 1024 * 1024 * 2, MR, 1024, 1024, 1024); }
            GSYNC();
        } else {
            const int bl = layer - 2;
            if (bl == 0) {
                { FRESH(); EpiKV E{(bf16_t*)(ws + WS_KV), SS + (size_t)4 * MR, BIAS + BO_KV, pk->in[14], cs};
                  RUN_GEMM(EpiKV, E, XB2, ws + WS_WKV, MR, 1536, 1024, 1024); }
            }
            { FRESH(); EpiQ E{(bf16_t*)(ws + WS_Q), (bf16_t*)(ws + WS_QR), (float*)(ws + WS_GATES), SS + (size_t)(2 * layer) * MR, BIAS + BO_Q + bl * 2560, pk->in[19] + bl * 64, cs};
              RUN_GEMM(EpiQ, E, XB, ws + WS_WQ + (size_t)bl * 1280 * 1024 * 2, MR, 1280, 1024, 1024); }
            GSYNC();
            if (bl == 0) {
#pragma unroll 1
                for (int j = 0; j < 2; ++j) { FRESH(); EpiC1 E{(bf16_t*)(ws + WS_CHID) + (size_t)j * 8192 * 256, BIAS + BO_C1 + j * 256};
                    RUN_GEMM_AT(EpiC1, E, ws + WS_KV + (size_t)j * 16 * MiB, ws + WS_WC1 + (size_t)j * 256 * 2048 * 2, 8192, 256, 2048, 1024, (gridDim.x >= 64) ? 32 * j : 0); }
                GSYNC();
#pragma unroll 1
                for (int j = 0; j < 2; ++j) { FRESH(); EpiC2 E{(bf16_t*)(ws + (j == 0 ? WS_KC : WS_VC)), j == 0 ? pk->in[14] : nullptr, j};
                    RUN_GEMM_AT(EpiC2, E, ws + WS_CHID + (size_t)j * 8192 * 256 * 2, ws + WS_WC2 + (size_t)j * 256 * 256 * 2, 8192, 256, 256, 256, (gridDim.x >= 64) ? 32 * j : 0); }
                GSYNC();
            }
            { PK pk = fresh_pk(); phase_sel2(pk, ldsb, wid_s); }
            GSYNC();
            { PK pk = fresh_pk(); phase_att(pk, ldsb, wid_s); }
            GSYNC();
            { FRESH(); EpiRes<false> E{xout, xout, mods + (2 * layer) * 6144 + 2048, SS + (size_t)(2 * layer + 1) * MR, XB, BIAS + BO_GM + (2 * layer + 1) * 2048, nullptr, nullptr};
              RUN_GEMM(EpiRes<false>, E, ws + WS_AO, ws + WS_WAO + (size_t)bl * 1024 * 1024 * 2, MR, 1024, 1024, 1024); }
            GSYNC();
        }
        { FRESH(); EpiFin E{HID, SS + (size_t)(2 * layer + 1) * MR, BIAS + BO_FIN + layer * 11264};
          RUN_GEMM(EpiFin, E, XB, ws + WS_WFIN + (size_t)layer * 5632 * 1024 * 2, MR, 5632, 1024, 1024); }
        GSYNC();
        { FRESH(); const bool last = (layer == 3);
          float* sso = last ? SS : SS + (size_t)(2 * layer + 2) * MR; const float* gmn = BIAS + BO_GM + (last ? 0 : (2 * layer + 2) * 2048);
          const bf16_t* Wt = (const bf16_t*)(ws + WS_WFOUT + (size_t)layer * 1024 * 2816 * 2);
          if (layer == 1) { EpiRes<true> E{xout, xout, mods + (2 * layer + 1) * 6144 + 2048, sso, XB, gmn, XB2, BIAS + BO_GM + 8 * 2048};
              RUN_GEMM(EpiRes<true>, E, HID, Wt, MR, 1024, 2816, 2816); }
          else { EpiRes<false> E{xout, xout, mods + (2 * layer + 1) * 6144 + 2048, sso, XB, gmn, nullptr, nullptr};
              RUN_GEMM(EpiRes<false>, E, HID, Wt, MR, 1024, 2816, 2816); } }
        if (layer < 3) GSYNC();
    }
}

extern "C" void kernel_launch(void* const* d_in, const int* in_sizes, int n_in, void* d_out, int out_size, void* d_ws, size_t ws_size, hipStream_t stream) {
    static int grid = 0;
    if (grid == 0) {
        if (n_in != 23 || out_size != MR * DM || ws_size < WS_END) { fprintf(stderr, "kernel_launch: unexpected problem (n_in %d out %d ws %zu)\n", n_in, out_size, ws_size); grid = -1; return; }
        int dev = 0, cus = 0, per_cu = 0;
        hipGetDevice(&dev); hipDeviceGetAttribute(&cus, hipDeviceAttributeMultiprocessorCount, dev);
        hipFuncSetAttribute((const void*)yoco_fwd, hipFuncAttributeMaxDynamicSharedMemorySize, LDS_BYTES);
        hipOccupancyMaxActiveBlocksPerMultiprocessor(&per_cu, (const void*)yoco_fwd, NTHR, LDS_BYTES);
        if (per_cu < 1) per_cu = 1;
        grid = cus * per_cu;
        fprintf(stderr, "kernel_launch: grid %d (cus %d x %d)\n", grid, cus, per_cu);
    }
    if (grid < 0) return;
    (void)hipMemsetAsync((char*)d_ws + WS_BAR, 0, 16384, stream);
    Params p{};
    for (int i = 0; i < 23; ++i) p.in[i] = (const float*)d_in[i];
    p.out = (float*)d_out; p.ws = (unsigned char*)d_ws;
    void* args[] = {&p};
    hipError_t e = hipLaunchCooperativeKernel((const void*)yoco_fwd, dim3(grid), dim3(NTHR), args, LDS_BYTES, stream);
    if (e != hipSuccess) fprintf(stderr, "cooperative launch failed: %s (grid %d)\n", hipGetErrorString(e), grid);
}
```
